# Optimizing an MI355X kernel written in HIP

```python
import math
import jax
import jax.numpy as jnp
from jax import lax
import numpy as np

D_MODEL = 2048
BATCH = 4
SEQ = 2048
DEPTH = 1

MEM_LEN = 256
RWKV_HEAD_DIM = 64
RWKV_WIDTH = D_MODEL // 2
RWKV_HEADS = RWKV_WIDTH // RWKV_HEAD_DIM
DECAY_RANK = 64
A_RANK = 64
GATE_RANK = 160
SB_HEADS = 4
SB_WIDTH = D_MODEL // 4
SB_HEAD_DIM = SB_WIDTH // SB_HEADS
SB_BLOCK = 128
MEM_HEADS = 4
MEM_WIDTH = D_MODEL // 4
MEM_HEAD_DIM = MEM_WIDTH // MEM_HEADS
MIX_WIDTH = RWKV_WIDTH + SB_WIDTH + MEM_WIDTH
RWKV_COLS = 3 * RWKV_WIDTH + DECAY_RANK + A_RANK + GATE_RANK
IN_COLS = RWKV_COLS + 3 * SB_WIDTH + MEM_WIDTH
N_GROUPS = 8
EXPERTS_PER_GROUP = 8
N_EXPERTS = N_GROUPS * EXPERTS_PER_GROUP
TOP_K_INNER = 2
D_EXPERT = D_MODEL // 2
MOE_BLOCK = 128
DEEPNORM_ALPHA = (2.0 * DEPTH) ** 0.25
DEEPNORM_BETA = (8.0 * DEPTH) ** -0.25
LN_EPS = 1e-5
GN_EPS = 64e-5

kernel_name = 'hybrid_rwkv7_stickbreak_memxattn_hmoe_deepnorm'


def layer_norm(x, g, b):
    xf = x.astype(jnp.float32)
    mu = jnp.mean(xf, -1, keepdims=True)
    var = jnp.mean(jnp.square(xf - mu), -1, keepdims=True)
    return ((xf - mu) * lax.rsqrt(var + LN_EPS) * g + b).astype(x.dtype)


def wkv7_step(state, inp):
    r, w, k, v, aa, bb = inp
    sa = jnp.einsum('bhvk,bhk->bhv', state, aa)
    state = state * w[:, :, None, :] + sa[..., None] * bb[:, :, None, :] + v[..., None] * k[:, :, None, :]
    y = jnp.einsum('bhvk,bhk->bhv', state, r)
    return state, y


def rwkv7_group(p, mu, w0, w_decay_up, a0, w_a_up, w_g_up, k_k, k_a, r_k, lnx_g, lnx_b):
    bsz, seq, _ = p.shape
    p = p.astype(jnp.float32)
    prev = jnp.pad(p, ((0, 0), (1, 0), (0, 0)))[:, :-1]
    p = p + (prev - p) * mu
    c = RWKV_WIDTH
    cuts = [c, 2 * c, 3 * c, 3 * c + DECAY_RANK, 3 * c + DECAY_RANK + A_RANK]
    r, k, v, d_low, a_low, g_low = jnp.split(p, cuts, axis=-1)
    w_log = -jax.nn.softplus(-(w0 + jnp.tanh(d_low) @ w_decay_up)) - 0.5
    decay = jnp.exp(-jnp.exp(w_log))
    a = jax.nn.sigmoid(a0 + a_low @ w_a_up)
    g = jax.nn.sigmoid(g_low) @ w_g_up

    def heads(t):
        return t.reshape(bsz, seq, RWKV_HEADS, RWKV_HEAD_DIM)

    kk = heads(k * k_k)
    kk = kk / jnp.maximum(jnp.sqrt(jnp.sum(kk * kk, -1, keepdims=True)), 1e-12)
    k = k * (1.0 + (a - 1.0) * k_a)
    r_h, k_h, v_h, w_h, a_h = heads(r), heads(k), heads(v), heads(decay), heads(a)
    xs = (r_h, w_h, k_h, v_h, -kk, kk * a_h)
    xs = [jnp.swapaxes(t, 0, 1) for t in xs]
    s0 = jnp.zeros((bsz, RWKV_HEADS, RWKV_HEAD_DIM, RWKV_HEAD_DIM), jnp.float32)
    _, y = lax.scan(wkv7_step, s0, xs)
    y = jnp.swapaxes(y, 0, 1)
    mu_y = jnp.mean(y, -1, keepdims=True)
    var_y = jnp.mean(jnp.square(y - mu_y), -1, keepdims=True)
    y = ((y - mu_y) * lax.rsqrt(var_y + GN_EPS)).reshape(bsz, seq, c) * lnx_g + lnx_b
    bonus = jnp.sum(r_h * k_h * r_k, -1, keepdims=True) * v_h
    return (y + bonus.reshape(bsz, seq, c)) * g


def stick_breaking_attention(q, k, v):
    seq = q.shape[1]
    scale = SB_HEAD_DIM ** -0.5
    outs = []
    for q0 in range(0, seq, SB_BLOCK):
        end = q0 + SB_BLOCK
        qb = q[:, q0:end].astype(jnp.float32)
        kb = k[:, :end].astype(jnp.float32)
        vb = v[:, :end].astype(jnp.float32)
        z = jnp.einsum('bqhd,bkhd->bhqk', qb, kb) * scale
        t_pos = q0 + jnp.arange(SB_BLOCK)[:, None]
        s_pos = jnp.arange(end)[None, :]
        causal = s_pos < t_pos
        log_keep = jnp.where(causal, jax.nn.log_sigmoid(-z), 0.0)
        after = lax.cumsum(log_keep, axis=3, reverse=True) - log_keep
        attn = jnp.where(causal, jnp.exp(jax.nn.log_sigmoid(z) + after), 0.0)
        outs.append(jnp.einsum('bhqk,bkhd->bqhd', attn, vb))
    return jnp.concatenate(outs, axis=1)


def memory_attention(q, kv):
    bsz, seq, _ = q.shape
    q = q.reshape(bsz, seq, MEM_HEADS, MEM_HEAD_DIM).astype(jnp.float32)
    k, v = jnp.split(kv.astype(jnp.float32), 2, axis=-1)
    k = k.reshape(bsz, -1, MEM_HEADS, MEM_HEAD_DIM)
    v = v.reshape(bsz, -1, MEM_HEADS, MEM_HEAD_DIM)
    scores = jnp.einsum('bshd,bmhd->bhsm', q, k) * (MEM_HEAD_DIM ** -0.5)
    probs = jax.nn.softmax(scores, axis=-1)
    return jnp.einsum('bhsm,bmhd->bshd', probs, v).reshape(bsz, seq, MEM_WIDTH)


def hybrid_mixer(h, mem, w_in, mu, w0, w_decay_up, a0, w_a_up, w_g_up, k_k, k_a, r_k,
                 lnx_g, lnx_b, w_mem_kv, w_out):
    bsz, seq, _ = h.shape
    proj = h @ w_in
    p_rwkv, p_sb, q_mem = jnp.split(proj, [RWKV_COLS, RWKV_COLS + 3 * SB_WIDTH], axis=-1)
    y_rwkv = rwkv7_group(p_rwkv, mu, w0, w_decay_up, a0, w_a_up, w_g_up, k_k, k_a, r_k, lnx_g, lnx_b)
    q_sb, k_sb, v_sb = [t.reshape(bsz, seq, SB_HEADS, SB_HEAD_DIM) for t in jnp.split(p_sb, 3, axis=-1)]
    y_sb = stick_breaking_attention(q_sb, k_sb, v_sb).reshape(bsz, seq, SB_WIDTH)
    y_mem = memory_attention(q_mem, mem @ w_mem_kv)
    y = jnp.concatenate([y_rwkv, y_sb, y_mem], axis=-1)
    return (y @ w_out).astype(h.dtype)


def hierarchical_moe(h, router_group, router_group_b, router_expert, router_expert_b, w_gate, w_up, w_down):
    bsz, seq, d = h.shape
    tokens = h.reshape(-1, d)
    n_tok = tokens.shape[0]
    group_logits = (tokens @ router_group).astype(jnp.float32) + router_group_b
    group_prob = jax.nn.softmax(group_logits, axis=-1)
    group_w, group_idx = lax.top_k(group_prob, 1)
    expert_logits = ((tokens @ router_expert).astype(jnp.float32) + router_expert_b)
    expert_logits = expert_logits.reshape(n_tok, N_GROUPS, EXPERTS_PER_GROUP)
    in_group = jnp.take_along_axis(expert_logits, group_idx[:, :, None], axis=1)[:, 0]
    top_vals, top_idx = lax.top_k(in_group, TOP_K_INNER)
    top_w = jax.nn.softmax(top_vals, axis=-1) * group_w
    expert_id = group_idx * EXPERTS_PER_GROUP + top_idx
    n_assign = n_tok * TOP_K_INNER
    flat_e = expert_id.reshape(-1)
    flat_tok = jnp.repeat(jnp.arange(n_tok, dtype=jnp.int32), TOP_K_INNER)
    flat_w = top_w.reshape(-1)
    order = jnp.argsort(flat_e)
    sorted_e = flat_e[order]
    counts = jnp.bincount(flat_e, length=N_EXPERTS)
    padded = (counts + MOE_BLOCK - 1) // MOE_BLOCK * MOE_BLOCK
    pad_end = jnp.cumsum(padded)
    pad_start = pad_end - padded
    start = jnp.cumsum(counts) - counts
    dest = pad_start[sorted_e] + jnp.arange(n_assign) - start[sorted_e]
    n_blocks = -(-n_assign // MOE_BLOCK) + N_EXPERTS
    n_slots = n_blocks * MOE_BLOCK
    slot_tok = jnp.full((n_slots,), n_tok, jnp.int32).at[dest].set(flat_tok[order])
    slot_w = jnp.zeros((n_slots,), jnp.float32).at[dest].set(flat_w[order])
    block_expert = jnp.minimum(
        jnp.searchsorted(pad_end, jnp.arange(n_blocks) * MOE_BLOCK, side='right'), N_EXPERTS - 1)
    tokens_pad = jnp.concatenate([tokens, jnp.zeros((1, d), tokens.dtype)], axis=0)

    def expert_block(args):
        tok, e = args
        xb = tokens_pad[tok]
        hid = jax.nn.silu(xb @ w_gate[e]) * (xb @ w_up[e])
        return hid @ w_down[e]

    ys = lax.map(expert_block, (slot_tok.reshape(n_blocks, MOE_BLOCK), block_expert))
    ys = ys.reshape(n_slots, d).astype(jnp.float32) * slot_w[:, None]
    out = jnp.zeros((n_tok + 1, d), jnp.float32).at[slot_tok].add(ys)[:n_tok]
    return out.reshape(bsz, seq, d).astype(h.dtype)


def setup_inputs(seed: int = 0) -> dict:
    key = jax.random.key(seed)
    ks = iter(jax.random.split(key, 40))
    f32 = jnp.float32

    def nrm(shape, scale):
        return jax.random.normal(next(ks), shape, f32) * scale

    L, C = DEPTH, RWKV_WIDTH
    ratio = jnp.linspace(0.0, 1.0, C, dtype=f32)
    return {
        'x': nrm((BATCH, SEQ, D_MODEL), 1.0),
        'mem': nrm((BATCH, MEM_LEN, D_MODEL), 1.0),
        'ln_in_g': 1.0 + nrm((D_MODEL,), 0.02),
        'ln_in_b': nrm((D_MODEL,), 0.02),
        'w_in': nrm((L, D_MODEL, IN_COLS), D_MODEL ** -0.5),
        'tshift_mu': jax.random.uniform(next(ks), (L, RWKV_COLS), f32),
        'w0': -6.0 + 5.0 * ratio ** 0.85 + nrm((L, C), 0.1),
        'w_decay_up': nrm((L, DECAY_RANK, C), 0.5 * DECAY_RANK ** -0.5),
        'a0': nrm((L, C), 0.1),
        'w_a_up': nrm((L, A_RANK, C), 0.5 * A_RANK ** -0.5),
        'w_g_up': nrm((L, GATE_RANK, C), GATE_RANK ** -0.5),
        'k_k': 0.85 + nrm((L, C), 0.02),
        'k_a': 1.0 + nrm((L, C), 0.02),
        'r_k': nrm((L, RWKV_HEADS, RWKV_HEAD_DIM), 0.1),
        'lnx_g': 1.0 + nrm((L, C), 0.02),
        'lnx_b': nrm((L, C), 0.02),
        'w_mem_kv': nrm((L, D_MODEL, 2 * MEM_WIDTH), D_MODEL ** -0.5),
        'w_out': nrm((L, MIX_WIDTH, D_MODEL), DEEPNORM_BETA * MIX_WIDTH ** -0.5),
        'ln1_g': 1.0 + nrm((L, D_MODEL), 0.02),
        'ln1_b': nrm((L, D_MODEL), 0.02),
        'router_group': nrm((L, D_MODEL, N_GROUPS), D_MODEL ** -0.5),
        'router_group_b': nrm((L, N_GROUPS), 0.01),
        'router_expert': nrm((L, D_MODEL, N_EXPERTS), D_MODEL ** -0.5),
        'router_expert_b': nrm((L, N_EXPERTS), 0.01),
        'w_e_gate': nrm((L, N_EXPERTS, D_MODEL, D_EXPERT), D_MODEL ** -0.5),
        'w_e_up': nrm((L, N_EXPERTS, D_MODEL, D_EXPERT), D_MODEL ** -0.5),
        'w_e_down': nrm((L, N_EXPERTS, D_EXPERT, D_MODEL), DEEPNORM_BETA * D_EXPERT ** -0.5),
        'ln2_g': 1.0 + nrm((L, D_MODEL), 0.02),
        'ln2_b': nrm((L, D_MODEL), 0.02),
    }


def reference(x, mem, ln_in_g, ln_in_b, w_in, tshift_mu, w0, w_decay_up, a0, w_a_up, w_g_up,
              k_k, k_a, r_k, lnx_g, lnx_b, w_mem_kv, w_out, ln1_g, ln1_b,
              router_group, router_group_b, router_expert, router_expert_b,
              w_e_gate, w_e_up, w_e_down, ln2_g, ln2_b):
    h = layer_norm(x, ln_in_g, ln_in_b)
    for l in range(DEPTH):
        mix = hybrid_mixer(h, mem, w_in[l], tshift_mu[l], w0[l], w_decay_up[l], a0[l], w_a_up[l],
                           w_g_up[l], k_k[l], k_a[l], r_k[l], lnx_g[l], lnx_b[l], w_mem_kv[l], w_out[l])
        h = layer_norm(DEEPNORM_ALPHA * h + mix, ln1_g[l], ln1_b[l])
        ffn = hierarchical_moe(h, router_group[l], router_group_b[l], router_expert[l], router_expert_b[l],
                               w_e_gate[l], w_e_up[l], w_e_down[l])
        h = layer_norm(DEEPNORM_ALPHA * h + ffn, ln2_g[l], ln2_b[l])
    return h
```

```cpp
#include <hip/hip_runtime.h>
#include <cstdio>
#include <cstdint>

#ifndef MK_N_LAUNCHES
#define MK_N_LAUNCHES 1
#endif

#define LAS __attribute__((address_space(3)))
typedef float f32x4 __attribute__((ext_vector_type(4)));
typedef float f32x2 __attribute__((ext_vector_type(2)));

constexpr int BATCH = 4, SEQ = 2048, T = BATCH * SEQ, D = 2048, C = 1024, NH = 16, HD = 64;
constexpr int DR = 64, AR = 64, GR = 160, LOWR = DR + AR + GR;
constexpr int RWKV_COLS = 3 * C + LOWR;
constexpr int SBW = 512, SBH = 4, SBD = 128, MEMW = 512, MEMH = 4, MEMD = 128, MEML = 256;
constexpr int IN_COLS = RWKV_COLS + 3 * SBW + MEMW;
constexpr int PLD = 5632;
constexpr int COL_R = 0, COL_K = C, COL_V = 2 * C, COL_DL = 3 * C, COL_SBQ = RWKV_COLS, COL_SBK = RWKV_COLS + SBW, COL_SBV = RWKV_COLS + 2 * SBW, COL_QM = RWKV_COLS + 3 * SBW;
constexpr int NG = 8, EPG = 8, NE = 64, DE = 1024;
constexpr float ALPHA = 1.18920711500272f;
constexpr float LN_EPS = 1e-5f, GN_EPS = 64e-5f;
constexpr int NT = 512, NWAVES = 8;
constexpr int LISTCAP = 8192;

constexpr size_t MiB = 1u << 20;
constexpr size_t WS_CTL = 0, CTL_ZERO_BYTES = 1 * MiB;
constexpr size_t WS_H32 = 2 * MiB;
constexpr size_t WS_PROJ = WS_H32 + 64 * MiB;
constexpr size_t WS_MEMKV = WS_PROJ + 176 * MiB;
constexpr size_t WS_RW = WS_MEMKV + 4 * MiB;
constexpr size_t WS_Y = WS_RW + 224 * MiB;
constexpr size_t WS_YCAT = WS_Y + 32 * MiB;
constexpr size_t WS_Z1 = WS_YCAT + 64 * MiB;
constexpr size_t WS_H1 = WS_Z1 + 64 * MiB;
constexpr size_t WS_LIST = WS_H1 + 64 * MiB;
constexpr size_t WS_LISTW = WS_LIST + 2 * MiB;
constexpr size_t WS_HG = WS_LISTW + 2 * MiB;
constexpr size_t WS_HID = WS_HG + 128 * MiB;
constexpr size_t WS_YS = WS_HID + 128 * MiB;
constexpr size_t WS_END = WS_YS + 128 * MiB;
constexpr int CW_CNT = 64;
constexpr int CW_BAR = 4096;

constexpr int LDS_BYTES = 147456;

#define XB_TMO      128
#define XB_XCNT(j)  (256  + 64 * (j))
#define XB_XSUB(j)  (1280 + 64 * (j))
#define XB_XGEN(j)  (2304 + 64 * (j))
#define XB_TOP      3328
#define XB_TOPGEN   3392
#define XCD_BAR_WORDS 3456
#define XB_SPIN_CAP (1u << 18)

__device__ __forceinline__ unsigned xb_ld(unsigned* p)              { return __hip_atomic_load(p, __ATOMIC_RELAXED, __HIP_MEMORY_SCOPE_AGENT); }
__device__ __forceinline__ unsigned xb_add(unsigned* p, unsigned v) { return __hip_atomic_fetch_add(p, v, __ATOMIC_RELAXED, __HIP_MEMORY_SCOPE_AGENT); }
__device__ __forceinline__ unsigned xb_xcc_id() { return (unsigned)__builtin_amdgcn_s_getreg((3 << 11) | 20) & 0xFu; }
#define XB_SPIN(cond, bar) do { unsigned _sp = 0; while (cond) { __builtin_amdgcn_s_sleep(1); \
    if ((++_sp & 255u) == 0u) { if (xb_ld(&(bar)[XB_TMO])) break; if (_sp > XB_SPIN_CAP) { atomicAdd(&(bar)[XB_TMO], 1u); break; } } } } while (0)

struct XcdBarrier { unsigned* bar; unsigned x; volatile LAS unsigned* st; };

__device__ __forceinline__ XcdBarrier xcd_barrier_post(unsigned* bar, volatile LAS unsigned* st) {
    XcdBarrier b; b.bar = bar; b.x = xb_xcc_id(); b.st = st;
    if (threadIdx.x == 0) (void)xb_add(&bar[XB_XCNT(b.x)], 1u);
    return b;
}
__device__ __forceinline__ void xcd_barrier_complete(unsigned* bar, unsigned x, unsigned& nloc, unsigned& nx) {
    const unsigned G = gridDim.x * gridDim.y * gridDim.z;
    unsigned sum, cnt, mine, sp = 0u;
    for (;;) {
        sum = 0u; cnt = 0u; mine = 0u;
#pragma unroll
        for (unsigned j = 0; j < 16; ++j) { const unsigned c = xb_ld(&bar[XB_XCNT(j)]); sum += c; cnt += (c > 0u) ? 1u : 0u; mine = (j == x) ? c : mine; }
        if (sum == G) break;
        __builtin_amdgcn_s_sleep(1);
        if ((++sp & 255u) == 0u) { if (xb_ld(&bar[XB_TMO])) break; if (sp > XB_SPIN_CAP) { atomicAdd(&bar[XB_TMO], 1u); break; } }
    }
    nloc = mine > 0u ? mine : 1u; nx = cnt > 0u ? cnt : 1u;
}
__device__ __forceinline__ void xcd_barrier(const XcdBarrier& b) {
    asm volatile("s_waitcnt vmcnt(0)" ::: "memory");
    __syncthreads();
    if (threadIdx.x == 0) {
        unsigned* bar = b.bar;
        __builtin_amdgcn_s_waitcnt(0);
        unsigned nloc = b.st[0], nx = b.st[1];
        if (nloc == 0u) { xcd_barrier_complete(bar, b.x, nloc, nx); b.st[0] = nloc; b.st[1] = nx; }
        const unsigned old = xb_add(&bar[XB_XSUB(b.x)], 1u);
        const unsigned gen = old / nloc;
        if (old + 1u == (gen + 1u) * nloc) {
            __builtin_amdgcn_fence(__ATOMIC_RELEASE, "agent");
            asm volatile("s_waitcnt vmcnt(0)" ::: "memory");
            const unsigned og = xb_add(&bar[XB_TOP], 1u);
            const unsigned tg = og / nx;
            if (og + 1u == (tg + 1u) * nx) xb_add(&bar[XB_TOPGEN], 1u);
            else XB_SPIN(xb_ld(&bar[XB_TOPGEN]) == tg, bar);
            __builtin_amdgcn_fence(__ATOMIC_ACQUIRE, "agent");
            xb_add(&bar[XB_XGEN(b.x)], 1u);
            asm volatile("s_waitcnt vmcnt(0)" ::: "memory");
        } else {
            XB_SPIN(xb_ld(&bar[XB_XGEN(b.x)]) == gen, bar);
            __builtin_amdgcn_fence(__ATOMIC_ACQUIRE, "agent");
            asm volatile("s_waitcnt vmcnt(0)" ::: "memory");
        }
    }
    __syncthreads();
}

__device__ __forceinline__ float wave_sum(float v) {
#pragma unroll
    for (int o = 1; o < 64; o <<= 1) v += __shfl_xor(v, o);
    return v;
}
__device__ __forceinline__ float wave_max(float v) {
#pragma unroll
    for (int o = 1; o < 64; o <<= 1) v = fmaxf(v, __shfl_xor(v, o));
    return v;
}
__device__ __forceinline__ float softplusf(float x) { return fmaxf(x, 0.f) + log1pf(expf(-fabsf(x))); }
__device__ __forceinline__ float sigmoidf(float x) { return 1.f / (1.f + expf(-x)); }
__device__ __forceinline__ void wave_lds_sync() { asm volatile("s_waitcnt lgkmcnt(0)" ::: "memory"); __builtin_amdgcn_wave_barrier(); }

struct Frame {
    LAS unsigned char* lds;
    int tid, lane, wave, bid, G;
    unsigned* ctl;
    const float* in[29];
    float* out;
    unsigned char* ws;
};
enum { I_X = 0, I_MEM, I_LNIN_G, I_LNIN_B, I_WIN, I_MU, I_W0, I_WDEC, I_A0, I_WA, I_WG, I_KK, I_KA, I_RK, I_LNXG, I_LNXB, I_WMEMKV, I_WOUT, I_LN1G, I_LN1B,
       I_RG, I_RGB, I_RE, I_REB, I_WEG, I_WEU, I_WED, I_LN2G, I_LN2B };

template <class AF, class EF>
__device__ __forceinline__ void gemm_naive(Frame& F, int M, int N, int K, const AF arow, const float* B, int ldb, const EF epi, int tile_base) {
    LAS float* As = (LAS float*)F.lds;
    LAS float* Bs = As + 16 * 132;
    const int tid = F.tid;
    const int tm = (M + 127) / 128, tn = (N + 63) / 64, nt = tm * tn;
    const int ty = tid >> 4, tx = tid & 15;
    const int lr = tid >> 2, lk = (tid & 3) * 4;
    const int bk = (tid >> 4) & 15, bc = (tid & 15) * 4;
    for (int lt = 0; lt < nt; ++lt) {
        if ((tile_base + lt) % F.G != F.bid) continue;
        const int m0 = (lt / tn) * 128, n0 = (lt % tn) * 64;
        const float* ap = (m0 + lr < M) ? arow(m0 + lr) : nullptr;
        const bool bok = (tid < 256) && (n0 + bc < N);
        float acc[4][4];
#pragma unroll
        for (int i = 0; i < 4; ++i)
#pragma unroll
            for (int j = 0; j < 4; ++j) acc[i][j] = 0.f;
        for (int k0 = 0; k0 < K; k0 += 16) {
            f32x4 av = (f32x4){0.f, 0.f, 0.f, 0.f}, bv = (f32x4){0.f, 0.f, 0.f, 0.f};
            if (ap) av = *(const f32x4*)(ap + k0 + lk);
            if (bok) bv = *(const f32x4*)(B + (size_t)(k0 + bk) * ldb + n0 + bc);
            __syncthreads();
            As[(lk + 0) * 132 + lr] = av.x; As[(lk + 1) * 132 + lr] = av.y; As[(lk + 2) * 132 + lr] = av.z; As[(lk + 3) * 132 + lr] = av.w;
            if (tid < 256) *(LAS f32x4*)(Bs + bk * 64 + bc) = bv;
            __syncthreads();
#pragma unroll
            for (int k = 0; k < 16; ++k) {
                const f32x4 a = *(const LAS f32x4*)(As + k * 132 + ty * 4);
                const f32x4 b = *(const LAS f32x4*)(Bs + k * 64 + tx * 4);
#pragma unroll
                for (int i = 0; i < 4; ++i)
#pragma unroll
                    for (int j = 0; j < 4; ++j) acc[i][j] += a[i] * b[j];
            }
        }
#pragma unroll
        for (int i = 0; i < 4; ++i) {
            const int r = m0 + ty * 4 + i, c = n0 + tx * 4;
            if (r < M && c < N) epi(r, c, (f32x4){acc[i][0], acc[i][1], acc[i][2], acc[i][3]});
        }
    }
    __syncthreads();
}
struct ARowPlain { const float* A; int lda; __device__ __forceinline__ const float* operator()(int r) const { return A + (size_t)r * lda; } };
struct ARowList { const float* A; int lda; const int* list; __device__ __forceinline__ const float* operator()(int r) const { return A + (size_t)(list[r] >> 1) * lda; } };
struct ARowOff { const float* A; int lda; __device__ __forceinline__ const float* operator()(int r) const { return A + (size_t)r * lda; } };
struct EpiStore { float* Cm; int ldc; __device__ __forceinline__ void operator()(int r, int c, f32x4 v) const { *(f32x4*)(Cm + (size_t)r * ldc + c) = v; } };
struct EpiResid { float* Cm; const float* R; int ldc; float alpha; __device__ __forceinline__ void operator()(int r, int c, f32x4 v) const {
    const f32x4 h = *(const f32x4*)(R + (size_t)r * ldc + c); *(f32x4*)(Cm + (size_t)r * ldc + c) = h * alpha + v; } };
struct EpiSilu { float* Hd; const float* Gt; int ldc; __device__ __forceinline__ void operator()(int r, int c, f32x4 u) const {
    const f32x4 g = *(const f32x4*)(Gt + (size_t)r * ldc + c); f32x4 o;
#pragma unroll
    for (int i = 0; i < 4; ++i) o[i] = g[i] / (1.f + expf(-g[i])) * u[i];
    *(f32x4*)(Hd + (size_t)r * ldc + c) = o; } };
struct EpiScatter { float* YS; const int* list; const float* lw; __device__ __forceinline__ void operator()(int r, int c, f32x4 v) const {
    const int e = list[r]; const float w = lw[r]; *(f32x4*)(YS + (size_t)e * D + c) = v * w; } };

__device__ __forceinline__ void ln_core(f32x4 (&v)[8], const float* g, const float* b, float* out, int lane) {
    float s = 0.f;
#pragma unroll
    for (int j = 0; j < 8; ++j) s += (v[j].x + v[j].y) + (v[j].z + v[j].w);
    const float mean = wave_sum(s) * (1.f / D);
    float s2 = 0.f;
#pragma unroll
    for (int j = 0; j < 8; ++j) { v[j] = v[j] - mean; s2 += (v[j].x * v[j].x + v[j].y * v[j].y) + (v[j].z * v[j].z + v[j].w * v[j].w); }
    const float rstd = 1.f / sqrtf(wave_sum(s2) * (1.f / D) + LN_EPS);
#pragma unroll
    for (int j = 0; j < 8; ++j) {
        const f32x4 gg = ((const f32x4*)g)[lane + 64 * j], bb = ((const f32x4*)b)[lane + 64 * j];
        v[j] = v[j] * rstd * gg + bb;
        ((f32x4*)out)[lane + 64 * j] = v[j];
    }
}

__device__ __forceinline__ void ph_ln_in(Frame& F) {
    float* H32 = (float*)(F.ws + WS_H32);
    const int gw = F.bid * NWAVES + F.wave, NGW = F.G * NWAVES;
    for (int row = gw; row < T; row += NGW) {
        const f32x4* xr = (const f32x4*)(F.in[I_X] + (size_t)row * D);
        f32x4 v[8];
#pragma unroll
        for (int j = 0; j < 8; ++j) v[j] = xr[F.lane + 64 * j];
        ln_core(v, F.in[I_LNIN_G], F.in[I_LNIN_B], H32 + (size_t)row * D, F.lane);
    }
}
__device__ __forceinline__ void ph_proj(Frame& F) {
    const float* H32 = (const float*)(F.ws + WS_H32);
    float* P = (float*)(F.ws + WS_PROJ);
    float* MKV = (float*)(F.ws + WS_MEMKV);
    gemm_naive(F, T, IN_COLS, D, ARowPlain{H32, D}, F.in[I_WIN], IN_COLS, EpiStore{P, PLD}, 0);
    gemm_naive(F, BATCH * MEML, 2 * MEMW, D, ARowPlain{F.in[I_MEM], D}, F.in[I_WMEMKV], 2 * MEMW, EpiStore{MKV, 2 * MEMW}, 64 * 85);
}
__device__ __forceinline__ void ph_rwkv_prep(Frame& F) {
    constexpr int TOK = 4;
    const float* P = (const float*)(F.ws + WS_PROJ);
    float* RW = (float*)(F.ws + WS_RW);
    const size_t TC = (size_t)T * C;
    const float* mu = F.in[I_MU];
    LAS float* act = (LAS float*)F.lds;
    for (int t0 = F.bid * TOK; t0 < T; t0 += F.G * TOK) {
        __syncthreads();
        for (int i = F.tid; i < TOK * LOWR; i += NT) {
            const int tt = i / LOWR, j = i % LOWR, t = t0 + tt, col = COL_DL + j;
            const float cur = P[(size_t)t * PLD + col];
            const float prev = (t % SEQ) ? P[(size_t)(t - 1) * PLD + col] : 0.f;
            const float xs = cur + (prev - cur) * mu[col];
            float a;
            if (j < DR) a = tanhf(xs); else if (j < DR + AR) a = xs; else a = sigmoidf(xs);
            act[i] = a;
        }
        __syncthreads();
#pragma unroll 1
        for (int cc = 0; cc < 2; ++cc) {
            const int c = F.tid + cc * NT;
            float ad[TOK], aa[TOK], ag[TOK];
#pragma unroll
            for (int tt = 0; tt < TOK; ++tt) { ad[tt] = 0.f; aa[tt] = 0.f; ag[tt] = 0.f; }
            for (int j = 0; j < DR; ++j) {
                const float wd = F.in[I_WDEC][j * C + c], wa = F.in[I_WA][j * C + c];
#pragma unroll
                for (int tt = 0; tt < TOK; ++tt) { ad[tt] += act[tt * LOWR + j] * wd; aa[tt] += act[tt * LOWR + DR + j] * wa; }
            }
            for (int j = 0; j < GR; ++j) {
                const float wg = F.in[I_WG][j * C + c];
#pragma unroll
                for (int tt = 0; tt < TOK; ++tt) ag[tt] += act[tt * LOWR + DR + AR + j] * wg;
            }
            const float w0 = F.in[I_W0][c], a0 = F.in[I_A0][c], kkc = F.in[I_KK][c], kac = F.in[I_KA][c];
            const float mur = mu[COL_R + c], muk = mu[COL_K + c], muv = mu[COL_V + c];
#pragma unroll
            for (int tt = 0; tt < TOK; ++tt) {
                const int t = t0 + tt;
                const float* pc = P + (size_t)t * PLD;
                const bool hp = (t % SEQ) != 0;
                float r = pc[COL_R + c], k = pc[COL_K + c], v = pc[COL_V + c];
                const float rp = hp ? pc[COL_R + c - PLD] : 0.f, kp = hp ? pc[COL_K + c - PLD] : 0.f, vp = hp ? pc[COL_V + c - PLD] : 0.f;
                r = r + (rp - r) * mur; k = k + (kp - k) * muk; v = v + (vp - v) * muv;
                const float wl = w0 + ad[tt];
                const float wlog = -softplusf(-wl) - 0.5f;
                const float decay = expf(-expf(wlog));
                const float a = sigmoidf(a0 + aa[tt]);
                const float g = ag[tt];
                const float kkr = k * kkc;
                const float ss = wave_sum(kkr * kkr);
                const float kk = kkr / fmaxf(sqrtf(ss), 1e-12f);
                const float k2 = k * (1.f + (a - 1.f) * kac);
                const size_t o = (size_t)t * C + c;
                RW[o] = r; RW[TC + o] = decay; RW[2 * TC + o] = k2; RW[3 * TC + o] = v; RW[4 * TC + o] = -kk; RW[5 * TC + o] = kk * a; RW[6 * TC + o] = g;
            }
        }
    }
    __syncthreads();
}
__device__ __forceinline__ void ph_wkv(Frame& F) {
    const float* RW = (const float*)(F.ws + WS_RW);
    float* Y = (float*)(F.ws + WS_Y);
    const size_t TC = (size_t)T * C;
    const int row = F.tid >> 3, cg = F.tid & 7;
    for (int it = F.bid; it < BATCH * NH; it += F.G) {
        const int b = it / NH, h = it % NH;
        float s[8];
#pragma unroll
        for (int j = 0; j < 8; ++j) s[j] = 0.f;
        const float* base = RW + (size_t)(b * SEQ) * C + h * HD + cg * 8;
        f32x4 nr[2], nw[2], nk[2], na[2], nb[2]; float nv;
#pragma unroll
        for (int q = 0; q < 2; ++q) { nr[q] = *(const f32x4*)(base + 4 * q); nw[q] = *(const f32x4*)(base + TC + 4 * q); nk[q] = *(const f32x4*)(base + 2 * TC + 4 * q);
            na[q] = *(const f32x4*)(base + 4 * TC + 4 * q); nb[q] = *(const f32x4*)(base + 5 * TC + 4 * q); }
        nv = RW[3 * TC + (size_t)(b * SEQ) * C + h * HD + row];
        for (int t = 0; t < SEQ; ++t) {
            f32x4 r[2], w[2], k[2], a[2], bb[2]; float v = nv;
#pragma unroll
            for (int q = 0; q < 2; ++q) { r[q] = nr[q]; w[q] = nw[q]; k[q] = nk[q]; a[q] = na[q]; bb[q] = nb[q]; }
            if (t + 1 < SEQ) {
                const float* nbp = base + (size_t)(t + 1) * C;
#pragma unroll
                for (int q = 0; q < 2; ++q) { nr[q] = *(const f32x4*)(nbp + 4 * q); nw[q] = *(const f32x4*)(nbp + TC + 4 * q); nk[q] = *(const f32x4*)(nbp + 2 * TC + 4 * q);
                    na[q] = *(const f32x4*)(nbp + 4 * TC + 4 * q); nb[q] = *(const f32x4*)(nbp + 5 * TC + 4 * q); }
                nv = RW[3 * TC + (size_t)(b * SEQ + t + 1) * C + h * HD + row];
            }
            float sa = 0.f;
#pragma unroll
            for (int j = 0; j < 8; ++j) sa += s[j] * a[j >> 2][j & 3];
            sa += __shfl_xor(sa, 1); sa += __shfl_xor(sa, 2); sa += __shfl_xor(sa, 4);
            float y = 0.f;
#pragma unroll
            for (int j = 0; j < 8; ++j) { s[j] = s[j] * w[j >> 2][j & 3] + sa * bb[j >> 2][j & 3] + v * k[j >> 2][j & 3]; y += s[j] * r[j >> 2][j & 3]; }
            y += __shfl_xor(y, 1); y += __shfl_xor(y, 2); y += __shfl_xor(y, 4);
            if (cg == 0) Y[(size_t)(b * SEQ + t) * C + h * HD + row] = y;
        }
    }
}
__device__ __forceinline__ void ph_wkv_post(Frame& F) {
    const float* RW = (const float*)(F.ws + WS_RW);
    const float* Y = (const float*)(F.ws + WS_Y);
    float* YC = (float*)(F.ws + WS_YCAT);
    const size_t TC = (size_t)T * C;
    const int gw = F.bid * NWAVES + F.wave, NGW = F.G * NWAVES;
    for (int it = gw; it < T * NH; it += NGW) {
        const int t = it / NH, h = it % NH, c = h * HD + F.lane;
        const size_t o = (size_t)t * C + c;
        const float y = Y[o];
        const float mu = wave_sum(y) * (1.f / HD);
        const float dy = y - mu;
        const float var = wave_sum(dy * dy) * (1.f / HD);
        const float yn = dy * (1.f / sqrtf(var + GN_EPS)) * F.in[I_LNXG][c] + F.in[I_LNXB][c];
        const float r = RW[o], k2 = RW[2 * TC + o], v = RW[3 * TC + o], g = RW[6 * TC + o];
        const float bonus = wave_sum(r * k2 * F.in[I_RK][c]) * v;
        YC[(size_t)t * D + c] = (yn + bonus) * g;
    }
}
__device__ __forceinline__ void ph_sb_attn(Frame& F) {
    const float* P = (const float*)(F.ws + WS_PROJ);
    float* YC = (float*)(F.ws + WS_YCAT);
    LAS float* qs = (LAS float*)F.lds + F.wave * 256;
    LAS float* as = qs + 128;
    const int gw = F.bid * NWAVES + F.wave, NGW = F.G * NWAVES, lane = F.lane;
    const float scale = 0.08838834764831845f;
    for (int it = gw; it < T * SBH; it += NGW) {
        const int t = it >> 2, hh = it & 3, b = t / SEQ, tl = t % SEQ;
        const float* qp = P + (size_t)t * PLD + COL_SBQ + hh * SBD;
        wave_lds_sync();
        qs[lane] = qp[lane]; qs[64 + lane] = qp[64 + lane];
        wave_lds_sync();
        float o0 = 0.f, o1 = 0.f, carry = 0.f;
        const int nkb = (tl + 63) >> 6;
        for (int kb = nkb - 1; kb >= 0; --kb) {
            const int s = kb * 64 + lane; const bool valid = s < tl;
            float z = 0.f;
            if (valid) {
                const float* kp = P + (size_t)(b * SEQ + s) * PLD + COL_SBK + hh * SBD;
#pragma unroll 8
                for (int d = 0; d < SBD; d += 4) { const f32x4 kv = *(const f32x4*)(kp + d); const f32x4 qv = *(const LAS f32x4*)(qs + d);
                    z += qv.x * kv.x + qv.y * kv.y + qv.z * kv.z + qv.w * kv.w; }
            }
            z *= scale;
            const float sp = softplusf(z);
            const float lk = valid ? -sp : 0.f;
            float x = lk;
#pragma unroll
            for (int o = 1; o < 64; o <<= 1) { const float y = __shfl_down(x, o); if (lane + o < 64) x += y; }
            const float excl = x - lk;
            const float attn = valid ? expf(z - sp + carry + excl) : 0.f;
            carry += __shfl(x, 0);
            wave_lds_sync();
            as[lane] = attn;
            wave_lds_sync();
            const float* vp = P + (size_t)(b * SEQ + kb * 64) * PLD + COL_SBV + hh * SBD + 2 * lane;
            const int nv = min(64, tl - kb * 64);
            for (int j = 0; j < nv; ++j) { const float a = as[j]; const f32x2 vv = *(const f32x2*)(vp + (size_t)j * PLD); o0 += a * vv.x; o1 += a * vv.y; }
        }
        *(f32x2*)(YC + (size_t)t * D + C + hh * SBD + 2 * lane) = (f32x2){o0, o1};
    }
}
__device__ __forceinline__ void ph_mem_attn(Frame& F) {
    const float* P = (const float*)(F.ws + WS_PROJ);
    const float* MKV = (const float*)(F.ws + WS_MEMKV);
    float* YC = (float*)(F.ws + WS_YCAT);
    LAS float* qs = (LAS float*)F.lds + F.wave * 512;
    LAS float* ps = qs + 128;
    const int gw = F.bid * NWAVES + F.wave, NGW = F.G * NWAVES, lane = F.lane;
    const float scale = 0.08838834764831845f;
    for (int it = gw; it < T * MEMH; it += NGW) {
        const int t = it >> 2, hh = it & 3, b = t / SEQ;
        const float* qp = P + (size_t)t * PLD + COL_QM + hh * MEMD;
        wave_lds_sync();
        qs[lane] = qp[lane]; qs[64 + lane] = qp[64 + lane];
        wave_lds_sync();
        float sc[4]; float mx = -3.0e38f;
#pragma unroll
        for (int q = 0; q < 4; ++q) {
            const int m = lane + 64 * q;
            const float* kp = MKV + (size_t)(b * MEML + m) * (2 * MEMW) + hh * MEMD;
            float z = 0.f;
#pragma unroll 8
            for (int d = 0; d < MEMD; d += 4) { const f32x4 kv = *(const f32x4*)(kp + d); const f32x4 qv = *(const LAS f32x4*)(qs + d);
                z += qv.x * kv.x + qv.y * kv.y + qv.z * kv.z + qv.w * kv.w; }
            sc[q] = z * scale; mx = fmaxf(mx, sc[q]);
        }
        mx = wave_max(mx);
        float sum = 0.f;
#pragma unroll
        for (int q = 0; q < 4; ++q) { sc[q] = expf(sc[q] - mx); sum += sc[q]; }
        sum = wave_sum(sum);
        const float inv = 1.f / sum;
#pragma unroll
        for (int q = 0; q < 4; ++q) ps[lane + 64 * q] = sc[q] * inv;
        wave_lds_sync();
        const float* vp = MKV + (size_t)(b * MEML) * (2 * MEMW) + MEMW + hh * MEMD + 2 * lane;
        float o0 = 0.f, o1 = 0.f;
        for (int m = 0; m < MEML; ++m) { const float p = ps[m]; const f32x2 vv = *(const f32x2*)(vp + (size_t)m * (2 * MEMW)); o0 += p * vv.x; o1 += p * vv.y; }
        *(f32x2*)(YC + (size_t)t * D + C + SBW + hh * MEMD + 2 * lane) = (f32x2){o0, o1};
    }
}
__device__ __forceinline__ void ph_outproj(Frame& F) {
    const float* H32 = (const float*)(F.ws + WS_H32);
    const float* YC = (const float*)(F.ws + WS_YCAT);
    float* Z1 = (float*)(F.ws + WS_Z1);
    gemm_naive(F, T, D, D, ARowPlain{YC, D}, F.in[I_WOUT], D, EpiResid{Z1, H32, D, ALPHA}, 0);
}
__device__ __forceinline__ void ph_ln1_router(Frame& F) {
    const float* Z1 = (const float*)(F.ws + WS_Z1);
    float* H1 = (float*)(F.ws + WS_H1);
    int* LIST = (int*)(F.ws + WS_LIST);
    float* LISTW = (float*)(F.ws + WS_LISTW);
    LAS float* hs = (LAS float*)F.lds;
    LAS float* red = hs + D;
    LAS float* part = red + 16;
    const int tid = F.tid, lane = F.lane, wave = F.wave;
    for (int t = F.bid; t < T; t += F.G) {
        const f32x4 zv = ((const f32x4*)(Z1 + (size_t)t * D))[tid];
        float s = (zv.x + zv.y) + (zv.z + zv.w);
        s = wave_sum(s);
        __syncthreads();
        if (lane == 0) red[wave] = s;
        __syncthreads();
        float tot = 0.f;
#pragma unroll
        for (int w = 0; w < NWAVES; ++w) tot += red[w];
        const float mean = tot * (1.f / D);
        const f32x4 dv = zv - mean;
        float s2 = (dv.x * dv.x + dv.y * dv.y) + (dv.z * dv.z + dv.w * dv.w);
        s2 = wave_sum(s2);
        if (lane == 0) red[8 + wave] = s2;
        __syncthreads();
        float tot2 = 0.f;
#pragma unroll
        for (int w = 0; w < NWAVES; ++w) tot2 += red[8 + w];
        const float rstd = 1.f / sqrtf(tot2 * (1.f / D) + LN_EPS);
        const f32x4 gg = ((const f32x4*)F.in[I_LN1G])[tid], bb = ((const f32x4*)F.in[I_LN1B])[tid];
        const f32x4 hv = dv * rstd * gg + bb;
        ((f32x4*)(H1 + (size_t)t * D))[tid] = hv;
        *(LAS f32x4*)(hs + 4 * tid) = hv;
        __syncthreads();
        const int col = tid & 127, ks = tid >> 7;
        float acc = 0.f;
        if (col < NG + NE) {
            const float* wp; int ld;
            if (col < NG) { wp = F.in[I_RG] + col; ld = NG; } else { wp = F.in[I_RE] + (col - NG); ld = NE; }
            for (int k = ks * 512; k < ks * 512 + 512; ++k) acc += hs[k] * wp[(size_t)k * ld];
        }
        part[ks * 128 + col] = acc;
        __syncthreads();
        if (tid == 0) {
            float gl[NG];
#pragma unroll
            for (int j = 0; j < NG; ++j) gl[j] = ((part[j] + part[128 + j]) + part[256 + j]) + part[384 + j] + F.in[I_RGB][j];
            int gi = 0; float gm = gl[0];
#pragma unroll
            for (int j = 1; j < NG; ++j) if (gl[j] > gm) { gm = gl[j]; gi = j; }
            float gs = 0.f;
#pragma unroll
            for (int j = 0; j < NG; ++j) gs += expf(gl[j] - gm);
            const float gw_ = 1.f / gs;
            float v0 = -3.0e38f, v1 = -3.0e38f; int i0 = 0, i1 = 0;
            for (int j = 0; j < EPG; ++j) {
                const int cc = NG + gi * EPG + j;
                const float l = ((part[cc] + part[128 + cc]) + part[256 + cc]) + part[384 + cc] + F.in[I_REB][gi * EPG + j];
                if (l > v0) { v1 = v0; i1 = i0; v0 = l; i0 = j; } else if (l > v1) { v1 = l; i1 = j; }
            }
            const float e1 = expf(v1 - v0);
            const float w0 = gw_ / (1.f + e1), w1 = gw_ * e1 / (1.f + e1);
            const int ex0 = gi * EPG + i0, ex1 = gi * EPG + i1;
            const unsigned p0 = atomicAdd(F.ctl + CW_CNT + ex0, 1u);
            LIST[ex0 * LISTCAP + p0] = t * 2; LISTW[ex0 * LISTCAP + p0] = w0;
            const unsigned p1 = atomicAdd(F.ctl + CW_CNT + ex1, 1u);
            LIST[ex1 * LISTCAP + p1] = t * 2 + 1; LISTW[ex1 * LISTCAP + p1] = w1;
        }
    }
    __syncthreads();
}
__device__ __forceinline__ void ph_moe_up(Frame& F) {
    const float* H1 = (const float*)(F.ws + WS_H1);
    const int* LIST = (const int*)(F.ws + WS_LIST);
    float* HG = (float*)(F.ws + WS_HG);
    float* HID = (float*)(F.ws + WS_HID);
    int off = 0, tb = 0;
    for (int e = 0; e < NE; ++e) {
        const int n = (int)F.ctl[CW_CNT + e];
        if (n > 0) {
            gemm_naive(F, n, DE, D, ARowList{H1, D, LIST + e * LISTCAP}, F.in[I_WEG] + (size_t)e * D * DE, DE, EpiStore{HG + (size_t)off * DE, DE}, tb);
            gemm_naive(F, n, DE, D, ARowList{H1, D, LIST + e * LISTCAP}, F.in[I_WEU] + (size_t)e * D * DE, DE, EpiSilu{HID + (size_t)off * DE, HG + (size_t)off * DE, DE}, tb);
        }
        tb += ((n + 127) / 128) * (DE / 64);
        off += (n + 255) & ~255;
    }
}
__device__ __forceinline__ void ph_moe_down(Frame& F) {
    const int* LIST = (const int*)(F.ws + WS_LIST);
    const float* LISTW = (const float*)(F.ws + WS_LISTW);
    const float* HID = (const float*)(F.ws + WS_HID);
    float* YS = (float*)(F.ws + WS_YS);
    int off = 0, tb = 0;
    for (int e = 0; e < NE; ++e) {
        const int n = (int)F.ctl[CW_CNT + e];
        if (n > 0)
            gemm_naive(F, n, D, DE, ARowOff{HID + (size_t)off * DE, DE}, F.in[I_WED] + (size_t)e * DE * D, D, EpiScatter{YS, LIST + e * LISTCAP, LISTW + e * LISTCAP}, tb);
        tb += ((n + 127) / 128) * (D / 64);
        off += (n + 255) & ~255;
    }
}
__device__ __forceinline__ void ph_ln2(Frame& F) {
    const float* H1 = (const float*)(F.ws + WS_H1);
    const float* YS = (const float*)(F.ws + WS_YS);
    const int gw = F.bid * NWAVES + F.wave, NGW = F.G * NWAVES;
    for (int row = gw; row < T; row += NGW) {
        const f32x4* hr = (const f32x4*)(H1 + (size_t)row * D);
        const f32x4* y0 = (const f32x4*)(YS + (size_t)row * 2 * D);
        const f32x4* y1 = y0 + D / 4;
        f32x4 v[8];
#pragma unroll
        for (int j = 0; j < 8; ++j) v[j] = hr[F.lane + 64 * j] * ALPHA + (y0[F.lane + 64 * j] + y1[F.lane + 64 * j]);
        ln_core(v, F.in[I_LN2G], F.in[I_LN2B], F.out + (size_t)row * D, F.lane);
    }
}

constexpr int N_PHASES = 12;
struct Args { const float* in[29]; float* out; unsigned char* ws; int ph_lo, ph_hi; };
__global__ void __launch_bounds__(NT, 2) fwd(Args args) {
    extern __shared__ __attribute__((aligned(16))) unsigned char lds[];
    Frame F;
    F.lds = (LAS unsigned char*)lds;
    F.tid = threadIdx.x; F.lane = F.tid & 63; F.wave = __builtin_amdgcn_readfirstlane(F.tid >> 6);
    F.bid = blockIdx.x; F.G = gridDim.x;
    F.ws = args.ws; F.ctl = (unsigned*)(args.ws + WS_CTL); F.out = args.out;
#pragma unroll
    for (int i = 0; i < 29; ++i) F.in[i] = args.in[i];
    volatile LAS unsigned* xbw = (volatile LAS unsigned*)(F.lds + LDS_BYTES - 16);
    if (F.tid == 0) { xbw[0] = 0u; xbw[1] = 0u; xbw[2] = 0u; xbw[3] = 0u; }
    __syncthreads();
    const int lo = args.ph_lo, hi = args.ph_hi;
    XcdBarrier bar; bar.bar = F.ctl + CW_BAR; bar.x = 0; bar.st = xbw;
    if (hi - lo > 1) bar = xcd_barrier_post(F.ctl + CW_BAR, xbw);
#define IN(k) (lo <= (k) && (k) < hi)
#define SEAM(k) do { if (IN(k) && IN((k) + 1)) xcd_barrier(bar); } while (0)
    if (IN(0)) { ph_ln_in(F); } SEAM(0);
    if (IN(1)) { ph_proj(F); } SEAM(1);
    if (IN(2)) { ph_rwkv_prep(F); } SEAM(2);
    if (IN(3)) { ph_wkv(F); } SEAM(3);
    if (IN(4)) { ph_wkv_post(F); __syncthreads(); }
    if (IN(5)) { ph_sb_attn(F); __syncthreads(); }
    if (IN(6)) { ph_mem_attn(F); __syncthreads(); } SEAM(6);
    if (IN(7)) { ph_outproj(F); } SEAM(7);
    if (IN(8)) { ph_ln1_router(F); } SEAM(8);
    if (IN(9)) { ph_moe_up(F); } SEAM(9);
    if (IN(10)) { ph_moe_down(F); } SEAM(10);
    if (IN(11)) { ph_ln2(F); }
#undef IN
#undef SEAM
}

extern "C" void kernel_launch(void* const* d_in, const int* in_sizes, int n_in, void* d_out, int out_size, void* d_ws, size_t ws_size, hipStream_t stream) {
    static int grid = 0;
    if (grid == 0) {
        if (n_in != 29 || out_size != T * D || ws_size < WS_END) { fprintf(stderr, "kernel_launch: unexpected shapes n_in %d out %d ws %zu (need %zu)\n", n_in, out_size, ws_size, (size_t)WS_END); grid = -1; return; }
        int dev = 0, cus = 0;
        if (hipGetDevice(&dev) != hipSuccess || hipDeviceGetAttribute(&cus, hipDeviceAttributeMultiprocessorCount, dev) != hipSuccess) { grid = -1; return; }
        if (hipFuncSetAttribute((const void*)fwd, hipFuncAttributeMaxDynamicSharedMemorySize, LDS_BYTES) != hipSuccess) { fprintf(stderr, "kernel_launch: hipFuncSetAttribute failed\n"); grid = -1; return; }
        int per_cu = 0;
        if (hipOccupancyMaxActiveBlocksPerMultiprocessor(&per_cu, (const void*)fwd, NT, LDS_BYTES) != hipSuccess || per_cu < 1) fprintf(stderr, "kernel_launch: occupancy query says %d\n", per_cu);
        (void)hipGetLastError();
        grid = cus;
    }
    if (grid < 0) return;
    (void)hipMemsetAsync((char*)d_ws + WS_CTL, 0, CTL_ZERO_BYTES, stream);
    Args a{};
    for (int i = 0; i < 29; ++i) a.in[i] = (const float*)d_in[i];
    a.out = (float*)d_out; a.ws = (unsigned char*)d_ws;
#if MK_N_LAUNCHES == 1
    a.ph_lo = 0; a.ph_hi = N_PHASES;
    hipLaunchKernelGGL(fwd, dim3(grid), dim3(NT), LDS_BYTES, stream, a);
#else
    const int cuts[] = {0, 1, 2, 3, 4, 7, 8, 9, 10, 11, 12};
    for (int i = 0; i + 1 < (int)(sizeof(cuts) / sizeof(int)); ++i) {
        a.ph_lo = cuts[i]; a.ph_hi = cuts[i + 1];
        hipLaunchKernelGGL(fwd, dim3(grid), dim3(NT), LDS_BYTES, stream, a);
    }
#endif
    const hipError_t le = hipPeekAtLastError();
    if (le != hipSuccess) fprintf(stderr, "kernel_launch: launch failed: %s\n", hipGetErrorName(le));
}
```

```cpp
#include <hip/hip_runtime.h>
#include <cstdio>
#include <cstdint>

#ifndef DBG
#define DBG 0
#endif
#ifndef MK_N_LAUNCHES
#define MK_N_LAUNCHES 1
#endif

#define LAS __attribute__((address_space(3)))
typedef float f32x4 __attribute__((ext_vector_type(4)));
typedef float f32x2 __attribute__((ext_vector_type(2)));
typedef unsigned short bf16_t;
typedef unsigned v4u __attribute__((ext_vector_type(4)));
typedef unsigned v2u __attribute__((ext_vector_type(2)));

constexpr int BATCH = 4, SEQ = 2048, T = BATCH * SEQ, D = 2048, C = 1024, NH = 16, HD = 64;
constexpr int DR = 64, AR = 64, GR = 160, LOWR = DR + AR + GR;
constexpr int RWKV_COLS = 3 * C + LOWR;
constexpr int SBW = 512, SBH = 4, SBD = 128, MEMW = 512, MEMH = 4, MEMD = 128, MEML = 256;
constexpr int IN_COLS = RWKV_COLS + 3 * SBW + MEMW;
constexpr int PLD = 5632;
constexpr int COL_R = 0, COL_K = C, COL_V = 2 * C, COL_DL = 3 * C, COL_SBQ = RWKV_COLS, COL_SBK = RWKV_COLS + SBW, COL_SBV = RWKV_COLS + 2 * SBW, COL_QM = RWKV_COLS + 3 * SBW;
constexpr int NG = 8, EPG = 8, NE = 64, DE = 1024;
constexpr float ALPHA = 1.18920711500272f;
constexpr float LN_EPS = 1e-5f, GN_EPS = 64e-5f;
constexpr int NT = 512, NWAVES = 8;
constexpr int LISTCAP = 8192;

constexpr size_t MiB = 1u << 20;
constexpr size_t WS_CTL = 0, CTL_ZERO_BYTES = 32768;
constexpr size_t WS_H32 = 2 * MiB;
constexpr size_t WS_HB = WS_H32 + 64 * MiB;
constexpr size_t WS_MEMB = WS_HB + 32 * MiB;
constexpr size_t WS_WINT = WS_MEMB + 4 * MiB;
constexpr size_t WS_WMKVT = WS_WINT + 22 * MiB;
constexpr size_t WS_WOUTT = WS_WMKVT + 4 * MiB;
constexpr size_t WS_PROJ = WS_WOUTT + 8 * MiB;
constexpr size_t WS_MEMKV = WS_PROJ + 88 * MiB;
constexpr size_t WS_PK = WS_MEMKV + 2 * MiB;
constexpr size_t WS_G = WS_PK + 96 * MiB;
constexpr size_t WS_YLOC = WS_G + 16 * MiB;
constexpr size_t WS_QH = WS_YLOC + 32 * MiB;
constexpr size_t WS_WLOWT = WS_QH + 32 * MiB + 48 * MiB;
constexpr size_t WS_WRT = WS_WLOWT + 1 * MiB;
constexpr size_t WS_Y = WS_WLOWT;
constexpr size_t WS_YCAT = WS_Y + 32 * MiB;
constexpr size_t WS_Z1 = WS_YLOC;
constexpr size_t WS_H1 = WS_YCAT + 64 * MiB;
constexpr size_t WS_LIST = WS_H1 + 64 * MiB;
constexpr size_t WS_LISTW = WS_LIST + 2 * MiB;
constexpr size_t WS_H1B_OLD = WS_LISTW + 2 * MiB;
constexpr size_t WS_HID = WS_PROJ;
constexpr size_t WS_YS = WS_PK;
constexpr size_t WS_VTSB = WS_H1B_OLD + 32 * MiB;
constexpr size_t WS_VTMEM = WS_VTSB + 8 * MiB;
constexpr size_t WS_DBG = WS_VTMEM + 2 * MiB;
constexpr int NCH = 32;
constexpr size_t WS_PCH = WS_DBG + 64 * MiB;
constexpr size_t WS_LCH = WS_PCH + 32 * MiB;
constexpr size_t WS_SST = WS_LCH + 32 * MiB;
constexpr size_t WS_H1B = WS_PCH;
constexpr size_t WS_END = WS_SST + 32 * MiB;
constexpr int CW_CNT = 64;
constexpr int CW_Q = 160;
constexpr int CW_Q2 = 161;
constexpr int CW_DBG = 128;
constexpr int CW_BAR = 4096;

constexpr int LDS_BYTES = 147456;

#define XB_TMO      128
#define XB_XCNT(j)  (256  + 64 * (j))
#define XB_XSUB(j)  (1280 + 64 * (j))
#define XB_XGEN(j)  (2304 + 64 * (j))
#define XB_TOP      3328
#define XB_TOPGEN   3392
#define XCD_BAR_WORDS 3456
#define XB_SPIN_CAP (1u << 18)

__device__ __forceinline__ unsigned xb_ld(unsigned* p)              { return __hip_atomic_load(p, __ATOMIC_RELAXED, __HIP_MEMORY_SCOPE_AGENT); }
__device__ __forceinline__ unsigned xb_add(unsigned* p, unsigned v) { return __hip_atomic_fetch_add(p, v, __ATOMIC_RELAXED, __HIP_MEMORY_SCOPE_AGENT); }
__device__ __forceinline__ unsigned xb_xcc_id() { return (unsigned)__builtin_amdgcn_s_getreg((3 << 11) | 20) & 0xFu; }
#define XB_SPIN(cond, bar) do { unsigned _sp = 0; while (cond) { __builtin_amdgcn_s_sleep(1); \
    if ((++_sp & 255u) == 0u) { if (xb_ld(&(bar)[XB_TMO])) break; if (_sp > XB_SPIN_CAP) { atomicAdd(&(bar)[XB_TMO], 1u); break; } } } } while (0)

struct XcdBarrier { unsigned* bar; unsigned x; volatile LAS unsigned* st; };

__device__ __forceinline__ XcdBarrier xcd_barrier_post(unsigned* bar, volatile LAS unsigned* st) {
    XcdBarrier b; b.bar = bar; b.x = xb_xcc_id(); b.st = st;
    if (threadIdx.x == 0) (void)xb_add(&bar[XB_XCNT(b.x)], 1u);
    return b;
}
__device__ __forceinline__ void xcd_barrier_complete(unsigned* bar, unsigned x, unsigned& nloc, unsigned& nx) {
    const unsigned G = gridDim.x * gridDim.y * gridDim.z;
    unsigned sum, cnt, mine, sp = 0u;
    for (;;) {
        sum = 0u; cnt = 0u; mine = 0u;
#pragma unroll
        for (unsigned j = 0; j < 16; ++j) { const unsigned c = xb_ld(&bar[XB_XCNT(j)]); sum += c; cnt += (c > 0u) ? 1u : 0u; mine = (j == x) ? c : mine; }
        if (sum == G) break;
        __builtin_amdgcn_s_sleep(1);
        if ((++sp & 255u) == 0u) { if (xb_ld(&bar[XB_TMO])) break; if (sp > XB_SPIN_CAP) { atomicAdd(&bar[XB_TMO], 1u); break; } }
    }
    nloc = mine > 0u ? mine : 1u; nx = cnt > 0u ? cnt : 1u;
}
__device__ __forceinline__ void xcd_barrier(const XcdBarrier& b) {
    asm volatile("s_waitcnt vmcnt(0)" ::: "memory");
    __syncthreads();
    if (threadIdx.x == 0) {
        unsigned* bar = b.bar;
        __builtin_amdgcn_s_waitcnt(0);
        unsigned nloc = b.st[0], nx = b.st[1];
        if (nloc == 0u) { xcd_barrier_complete(bar, b.x, nloc, nx); b.st[0] = nloc; b.st[1] = nx; }
        const unsigned old = xb_add(&bar[XB_XSUB(b.x)], 1u);
        const unsigned gen = old / nloc;
        if (old + 1u == (gen + 1u) * nloc) {
            __builtin_amdgcn_fence(__ATOMIC_RELEASE, "agent");
            asm volatile("s_waitcnt vmcnt(0)" ::: "memory");
            const unsigned og = xb_add(&bar[XB_TOP], 1u);
            const unsigned tg = og / nx;
            if (og + 1u == (tg + 1u) * nx) xb_add(&bar[XB_TOPGEN], 1u);
            else XB_SPIN(xb_ld(&bar[XB_TOPGEN]) == tg, bar);
            __builtin_amdgcn_fence(__ATOMIC_ACQUIRE, "agent");
            xb_add(&bar[XB_XGEN(b.x)], 1u);
            asm volatile("s_waitcnt vmcnt(0)" ::: "memory");
        } else {
            XB_SPIN(xb_ld(&bar[XB_XGEN(b.x)]) == gen, bar);
            __builtin_amdgcn_fence(__ATOMIC_ACQUIRE, "agent");
            asm volatile("s_waitcnt vmcnt(0)" ::: "memory");
        }
    }
    __syncthreads();
}

__device__ __forceinline__ float wave_sum(float v) {
#pragma unroll
    for (int o = 1; o < 64; o <<= 1) v += __shfl_xor(v, o);
    return v;
}
__device__ __forceinline__ float wave_max(float v) {
#pragma unroll
    for (int o = 1; o < 64; o <<= 1) v = fmaxf(v, __shfl_xor(v, o));
    return v;
}
__device__ __forceinline__ float softplusf(float x) { return fmaxf(x, 0.f) + log1pf(expf(-fabsf(x))); }
__device__ __forceinline__ float sigmoidf(float x) { return 1.f / (1.f + expf(-x)); }
__device__ __forceinline__ float fsigmoid(float x) { return __builtin_amdgcn_rcpf(1.f + __expf(-x)); }
__device__ __forceinline__ float fsoftplus(float x) { return fmaxf(x, 0.f) + __logf(1.f + __expf(-fabsf(x))); }
__device__ __forceinline__ float ftanh(float x) { const float e = __expf(-2.f * fabsf(x)); const float t = (1.f - e) * __builtin_amdgcn_rcpf(1.f + e); return x < 0.f ? -t : t; }
__device__ __forceinline__ void wave_lds_sync() { asm volatile("s_waitcnt lgkmcnt(0)" ::: "memory"); __builtin_amdgcn_wave_barrier(); }

__device__ __forceinline__ unsigned f2bf(float f) { unsigned u = __builtin_bit_cast(unsigned, f); return (u + 0x7fffu + ((u >> 16) & 1u)) >> 16; }
__device__ __forceinline__ unsigned pk2(float lo, float hi) { return f2bf(lo) | (f2bf(hi) << 16); }
__device__ __forceinline__ float bf2f(bf16_t b) { return __builtin_bit_cast(float, (unsigned)b << 16); }
__device__ __forceinline__ float bflo(unsigned w) { return __builtin_bit_cast(float, w << 16); }
__device__ __forceinline__ float bfhi(unsigned w) { return __builtin_bit_cast(float, w & 0xffff0000u); }
#define LDS_WAIT() asm volatile("s_waitcnt lgkmcnt(0)" ::: "memory")

namespace pg8 {
#define PG8_LAS __attribute__((address_space(3)))
typedef unsigned short bf16_t;
typedef short bf16x8 __attribute__((ext_vector_type(8)));
typedef float f32x4 __attribute__((ext_vector_type(4)));
typedef unsigned u32x4 __attribute__((ext_vector_type(4)));
constexpr int BM = 256, BK = 64, HALF = 128, HTB = HALF * BK * 2  , STAGE_BYTES = 8 * HTB, NXCD = 8, WGM = 8;

__host__ __device__ __forceinline__ int lds_byte(int r, int c) { const int st = (r >> 4) * 2 + (c >> 5), rr = r & 15, cc = c & 31, ob = rr * 64 + cc * 2; return st * 1024 + (ob ^ (((ob >> 9) & 1) << 5)); }
__host__ __device__ __forceinline__ void stage_rc(int b, int& R, int& C) { const int st = b / 1024, sb = b % 1024, swz = sb ^ (((sb >> 9) & 1) << 5); R = (st >> 1) * 16 + swz / 64; C = (st & 1) * 32 + (swz % 64) / 2; }
__host__ __device__ __forceinline__ int perm32(int rho) { const int n = rho >> 4, i = rho & 15; return 8 * (i >> 2) + 4 * n + (i & 3); }

struct Unit { int pm, pn; };
struct Gemm { const bf16_t* A; const bf16_t* Bt; int M, N, K; };

struct StaticOrder {
    int nM, nN, nwg, G, c;
    __host__ __device__ void init(int M, int N, int G_, int c_) { nM = M / BM; nN = N / BM; nwg = nM * nN; G = G_; c = c_; }
    __host__ __device__ bool next(int i, Unit& u) const {
        const long L = (long)i * G + c; if (L >= nwg) return false;
        int wgid = (int)L; { const int q = nwg / NXCD, r = nwg % NXCD, xcd = wgid % NXCD, off = wgid / NXCD; wgid = (xcd < r ? xcd * (q + 1) : r * (q + 1) + (xcd - r) * q) + off; }
        const int nig = WGM * nN, gid = wgid / nig, fm = gid * WGM, gsz = (nM - fm) < WGM ? (nM - fm) : WGM;
        u.pm = fm + ((wgid % nig) % gsz); u.pn = (wgid % nig) / gsz; return true;
    }
    __device__ __forceinline__ void a_ready(const Unit&) const {}
    __device__ __forceinline__ void done(const Unit&) const {}
};
typedef __bf16 bf16x2_t __attribute__((ext_vector_type(2))); typedef float cvt_f32x2 __attribute__((ext_vector_type(2)));
__device__ __forceinline__ unsigned cvt_pk_bf16(float lo, float hi) { const cvt_f32x2 v = {lo, hi}; return __builtin_bit_cast(unsigned, __builtin_convertvector(v, bf16x2_t)); }


template <class Epi, class Sched, bool STAMP = false>
__device__ __forceinline__ void gemm_phase(PG8_LAS unsigned char* lds, const Gemm g, const Sched& S, const Epi& E, unsigned long long* stamps) {
    const int tid = threadIdx.x, wid = __builtin_amdgcn_readfirstlane(tid >> 6), lane = tid & 63, wr = wid >> 2, wc = wid & 3, fr = lane & 15, fq = lane >> 4;
    const int K = g.K, nt = K / BK;
    int ts_lo = 0, ts_hi = 0, nts = 0; const unsigned long long rt_entry = STAMP ? (unsigned long long)wall_clock64() : 0ull;
#define PG8_STAMP() do { if (STAMP && wid == 0 && nts < 64) { const unsigned long long _c = (unsigned long long)clock64(); \
        ts_lo = (lane == nts) ? (int)(unsigned)_c : ts_lo; ts_hi = (lane == nts) ? (int)(unsigned)(_c >> 32) : ts_hi; ++nts; } } while (0)
    PG8_STAMP();
    unsigned voffA[2], voffB[2];
#pragma unroll
    for (int i = 0; i < 2; ++i) { int R, C; stage_rc(tid * 16 + i * 8192, R, C); const int Rb = Epi::PERM ? ((R & ~31) + perm32(R & 31)) : R;
        voffA[i] = (unsigned)(R * K + C) * 2u; voffB[i] = (unsigned)(Rb * K + C) * 2u; }
    const size_t kstep = (size_t)(BK * 2);
    const size_t hstep = (size_t)HALF * K * 2;
    const size_t tstep = 2 * hstep;
    const unsigned ldsw = (unsigned)wid * 1024u;
    const int aoff = lds_byte(wr * 64 + fr, fq * 8), boff = lds_byte(wc * 32 + fr, fq * 8);
#define PG8_SA(b, h) (((b) * 2 + (h)) * HTB)
#define PG8_SB(b, h) ((4 + (b) * 2 + (h)) * HTB)
#define PG8_STAGE(bufoff, gbase, voff) do { _Pragma("unroll") for (int _i = 0; _i < 2; ++_i) \
        __builtin_amdgcn_global_load_lds((const unsigned*)((const char*)(gbase) + (voff)[_i]), (PG8_LAS unsigned*)(lds + (bufoff) + ldsw + _i * 8192), 16, 0, 0); } while (0)
#define PG8_LDA(dst, b, h) do { _Pragma("unroll") for (int m = 0; m < 4; ++m) _Pragma("unroll") for (int k = 0; k < 2; ++k) dst[m][k] = *(const PG8_LAS bf16x8*)(lds + PG8_SA(b, h) + aoff + m * 2048 + k * 1024); } while (0)
#define PG8_LDB(dst, b, h) do { _Pragma("unroll") for (int n = 0; n < 2; ++n) _Pragma("unroll") for (int k = 0; k < 2; ++k) dst[n][k] = *(const PG8_LAS bf16x8*)(lds + PG8_SB(b, h) + boff + n * 2048 + k * 1024); } while (0)
#define PG8_MMA(ai, bj, At, Bt) do { __builtin_amdgcn_s_setprio(1); _Pragma("unroll") for (int m = 0; m < 4; ++m) _Pragma("unroll") for (int n = 0; n < 2; ++n) _Pragma("unroll") for (int k = 0; k < 2; ++k) \
        acc[ai][bj][m][n] = __builtin_amdgcn_mfma_f32_16x16x32_bf16(Bt[n][k], At[m][k], acc[ai][bj][m][n], 0, 0, 0); __builtin_amdgcn_s_setprio(0); } while (0)
#define PG8_WAIT_V(n) asm volatile("s_waitcnt vmcnt(" #n ")" ::: "memory")
#define PG8_WAIT_L(n) asm volatile("s_waitcnt lgkmcnt(" #n ")" ::: "memory")
#define PG8_BAR __builtin_amdgcn_s_barrier()
#define PG8_SCHED __builtin_amdgcn_sched_barrier(0)
    Unit cur, nxt; int ui = 0;
    if (!S.next(0, cur)) return;
    f32x4 acc[2][2][4][2];
#pragma unroll
    for (int a = 0; a < 2; ++a)
#pragma unroll
        for (int b = 0; b < 2; ++b)
#pragma unroll
            for (int m = 0; m < 4; ++m)
#pragma unroll
                for (int n = 0; n < 2; ++n) acc[a][b][m][n] = (f32x4){0.f, 0.f, 0.f, 0.f};
    bf16x8 At[4][2], B0[2][2], B1[2][2];
    const char* cA = (const char*)g.A + (size_t)cur.pm * tstep; const char* cB = (const char*)g.Bt + (size_t)cur.pn * tstep;
    S.a_ready(cur);
    PG8_STAGE(PG8_SB(0, 0), cB, voffB); PG8_STAGE(PG8_SA(0, 0), cA, voffA); PG8_STAGE(PG8_SB(0, 1), cB + hstep, voffB); PG8_STAGE(PG8_SA(0, 1), cA + hstep, voffA);
    if (wr == 1) PG8_BAR;
    PG8_WAIT_V(4); PG8_BAR;
    PG8_STAGE(PG8_SB(1, 0), cB + kstep, voffB); PG8_STAGE(PG8_SA(1, 0), cA + kstep, voffA); PG8_STAGE(PG8_SB(1, 1), cB + hstep + kstep, voffB);
    PG8_WAIT_V(6); PG8_BAR;
    PG8_STAMP();
    for (;;) {
        const bool has_next = S.next(ui + 1, nxt);
        const char* nA = has_next ? (const char*)g.A + (size_t)nxt.pm * tstep : cA; const char* nB = has_next ? (const char*)g.Bt + (size_t)nxt.pn * tstep : cB;
        for (int t = 0; t < nt; t += 2) {
            const bool last = (t == nt - 2);
            const char* a1 = cA + (size_t)(t + 1) * kstep;
            const char* a2 = last ? nA : cA + (size_t)(t + 2) * kstep; const char* b2 = last ? nB : cB + (size_t)(t + 2) * kstep;
            const char* a3 = a2 + kstep; const char* b3 = b2 + kstep;
            if (last && has_next) S.a_ready(nxt);
            PG8_LDB(B0, 0, 0); PG8_SCHED; PG8_LDA(At, 0, 0); PG8_STAGE(PG8_SA(1, 1), a1 + hstep, voffA);
            PG8_WAIT_L(8); PG8_BAR; PG8_WAIT_L(0); PG8_MMA(0, 0, At, B0); PG8_BAR; PG8_SCHED;
            PG8_LDB(B1, 0, 1); PG8_STAGE(PG8_SB(0, 0), b2, voffB);
            PG8_BAR; PG8_WAIT_L(0); PG8_MMA(0, 1, At, B1); PG8_BAR;
            PG8_LDA(At, 0, 1); PG8_STAGE(PG8_SA(0, 0), a2, voffA);
            PG8_BAR; PG8_WAIT_L(0); PG8_MMA(1, 0, At, B0); PG8_BAR; PG8_SCHED;
            PG8_STAGE(PG8_SB(0, 1), b2 + hstep, voffB);
            PG8_WAIT_V(6); PG8_BAR; PG8_MMA(1, 1, At, B1); PG8_BAR;
            PG8_LDB(B0, 1, 0); PG8_SCHED; PG8_LDA(At, 1, 0); PG8_STAGE(PG8_SA(0, 1), a2 + hstep, voffA);
            PG8_WAIT_L(8); PG8_BAR; PG8_WAIT_L(0); PG8_MMA(0, 0, At, B0); PG8_BAR; PG8_SCHED;
            PG8_LDB(B1, 1, 1); PG8_STAGE(PG8_SB(1, 0), b3, voffB);
            PG8_BAR; PG8_WAIT_L(0); PG8_MMA(0, 1, At, B1); PG8_BAR;
            PG8_LDA(At, 1, 1); PG8_STAGE(PG8_SA(1, 0), a3, voffA);
            PG8_BAR; PG8_WAIT_L(0); PG8_MMA(1, 0, At, B0); PG8_BAR; PG8_SCHED;
            PG8_STAGE(PG8_SB(1, 1), b3 + hstep, voffB);
            PG8_WAIT_V(6); PG8_BAR; PG8_MMA(1, 1, At, B1); PG8_BAR;
        }
        PG8_STAMP();
        if constexpr (!Epi::AFTER_DRAIN) { E(acc, cur, wr, wc, fr, fq); S.done(cur); }
        PG8_STAMP();
        if (!has_next) break;
#pragma unroll
        for (int a = 0; a < 2; ++a)
#pragma unroll
            for (int b = 0; b < 2; ++b)
#pragma unroll
                for (int m = 0; m < 4; ++m)
#pragma unroll
                    for (int n = 0; n < 2; ++n) acc[a][b][m][n] = (f32x4){0.f, 0.f, 0.f, 0.f};
        cur = nxt; cA = nA; cB = nB; ++ui;
    }
    PG8_WAIT_V(0);
    if (wr == 0) PG8_BAR;
    PG8_BAR;
    if constexpr (Epi::AFTER_DRAIN) { E.fused(acc, cur, wr, wc, fr, fq, lds, wid, lane); S.done(cur); }
    PG8_STAMP();
    if (STAMP && wid == 0) { stamps[lane] = lane < nts ? (((unsigned long long)(unsigned)ts_hi << 32) | (unsigned)ts_lo) : 0ull;
        if (lane == 62) stamps[62] = rt_entry; if (lane == 63) stamps[63] = (unsigned long long)wall_clock64(); }
#undef PG8_STAMP
#undef PG8_SA
#undef PG8_SB
#undef PG8_STAGE
#undef PG8_LDA
#undef PG8_LDB
#undef PG8_MMA
#undef PG8_WAIT_V
#undef PG8_WAIT_L
#undef PG8_BAR
#undef PG8_SCHED
}
}


struct Args { const float* in[29]; float* out; unsigned char* ws; int ph_lo, ph_hi; };
struct Frame {
    LAS unsigned char* lds;
    int tid, lane, wave, bid, G;
    unsigned* ctl;
    const Args* a;
    float* out;
    unsigned char* ws;
};
enum { I_X = 0, I_MEM, I_LNIN_G, I_LNIN_B, I_WIN, I_MU, I_W0, I_WDEC, I_A0, I_WA, I_WG, I_KK, I_KA, I_RK, I_LNXG, I_LNXB, I_WMEMKV, I_WOUT, I_LN1G, I_LN1B,
       I_RG, I_RGB, I_RE, I_REB, I_WEG, I_WEU, I_WED, I_LN2G, I_LN2B };

template <class AF, class EF>
__device__ __forceinline__ void gemm_naive(Frame& F, int M, int N, int K, const AF arow, const float* B, int ldb, const EF epi, int tile_base) {
    LAS float* As = (LAS float*)F.lds;
    LAS float* Bs = As + 16 * 132;
    const int tid = F.tid;
    const int tm = (M + 127) / 128, tn = (N + 63) / 64, nt = tm * tn;
    const int ty = tid >> 4, tx = tid & 15;
    const int lr = tid >> 2, lk = (tid & 3) * 4;
    const int bk = (tid >> 4) & 15, bc = (tid & 15) * 4;
    for (int lt = 0; lt < nt; ++lt) {
        if ((tile_base + lt) % F.G != F.bid) continue;
        const int m0 = (lt / tn) * 128, n0 = (lt % tn) * 64;
        const float* ap = (m0 + lr < M) ? arow(m0 + lr) : nullptr;
        const bool bok = (tid < 256) && (n0 + bc < N);
        float acc[4][4];
#pragma unroll
        for (int i = 0; i < 4; ++i)
#pragma unroll
            for (int j = 0; j < 4; ++j) acc[i][j] = 0.f;
        for (int k0 = 0; k0 < K; k0 += 16) {
            f32x4 av = (f32x4){0.f, 0.f, 0.f, 0.f}, bv = (f32x4){0.f, 0.f, 0.f, 0.f};
            if (ap) av = *(const f32x4*)(ap + k0 + lk);
            if (bok) bv = *(const f32x4*)(B + (size_t)(k0 + bk) * ldb + n0 + bc);
            __syncthreads();
            As[(lk + 0) * 132 + lr] = av.x; As[(lk + 1) * 132 + lr] = av.y; As[(lk + 2) * 132 + lr] = av.z; As[(lk + 3) * 132 + lr] = av.w;
            if (tid < 256) *(LAS f32x4*)(Bs + bk * 64 + bc) = bv;
            __syncthreads();
#pragma unroll
            for (int k = 0; k < 16; ++k) {
                const f32x4 a = *(const LAS f32x4*)(As + k * 132 + ty * 4);
                const f32x4 b = *(const LAS f32x4*)(Bs + k * 64 + tx * 4);
#pragma unroll
                for (int i = 0; i < 4; ++i)
#pragma unroll
                    for (int j = 0; j < 4; ++j) acc[i][j] += a[i] * b[j];
            }
        }
#pragma unroll
        for (int i = 0; i < 4; ++i) {
            const int r = m0 + ty * 4 + i, c = n0 + tx * 4;
            if (r < M && c < N) epi(r, c, (f32x4){acc[i][0], acc[i][1], acc[i][2], acc[i][3]});
        }
    }
    __syncthreads();
}
struct ARowPlain { const float* A; int lda; __device__ __forceinline__ const float* operator()(int r) const { return A + (size_t)r * lda; } };
struct ARowList { const float* A; int lda; const int* list; __device__ __forceinline__ const float* operator()(int r) const { return A + (size_t)(list[r] >> 1) * lda; } };
struct ARowOff { const float* A; int lda; __device__ __forceinline__ const float* operator()(int r) const { return A + (size_t)r * lda; } };
struct EpiStore { float* Cm; int ldc; __device__ __forceinline__ void operator()(int r, int c, f32x4 v) const { *(f32x4*)(Cm + (size_t)r * ldc + c) = v; } };
struct EpiResid { float* Cm; const float* R; int ldc; float alpha; __device__ __forceinline__ void operator()(int r, int c, f32x4 v) const {
    const f32x4 h = *(const f32x4*)(R + (size_t)r * ldc + c); *(f32x4*)(Cm + (size_t)r * ldc + c) = h * alpha + v; } };
struct EpiSilu { float* Hd; const float* Gt; int ldc; __device__ __forceinline__ void operator()(int r, int c, f32x4 u) const {
    const f32x4 g = *(const f32x4*)(Gt + (size_t)r * ldc + c); f32x4 o;
#pragma unroll
    for (int i = 0; i < 4; ++i) o[i] = g[i] / (1.f + expf(-g[i])) * u[i];
    *(f32x4*)(Hd + (size_t)r * ldc + c) = o; } };
struct EpiScatter { float* YS; const int* list; const float* lw; __device__ __forceinline__ void operator()(int r, int c, f32x4 v) const {
    const int e = list[r]; const float w = lw[r]; *(f32x4*)(YS + (size_t)e * D + c) = v * w; } };

template <bool STORE = true>
__device__ __forceinline__ void ln_core(f32x4 (&v)[8], const float* g, const float* b, float* out, int lane) {
    float s = 0.f;
#pragma unroll
    for (int j = 0; j < 8; ++j) s += (v[j].x + v[j].y) + (v[j].z + v[j].w);
    const float mean = wave_sum(s) * (1.f / D);
    float s2 = 0.f;
#pragma unroll
    for (int j = 0; j < 8; ++j) { v[j] = v[j] - mean; s2 += (v[j].x * v[j].x + v[j].y * v[j].y) + (v[j].z * v[j].z + v[j].w * v[j].w); }
    const float rstd = 1.f / sqrtf(wave_sum(s2) * (1.f / D) + LN_EPS);
#pragma unroll
    for (int j = 0; j < 8; ++j) {
        const f32x4 gg = ((const f32x4*)g)[lane + 64 * j], bb = ((const f32x4*)b)[lane + 64 * j];
        v[j] = v[j] * rstd * gg + bb;
        if (STORE) ((f32x4*)out)[lane + 64 * j] = v[j];
    }
}

__device__ __forceinline__ void p0_transpose_item(const float* W, int K, int N, bf16_t* WT, LAS float* scr, int item, int lane) {
    const int nblk = N / 32, kb = item / nblk, nb = item % nblk, k0 = 64 * kb, n0 = 32 * nb;
#pragma unroll 8
    for (int i = 0; i < 32; ++i) { const int kk = 2 * i + (lane >> 5); scr[kk * 33 + (lane & 31)] = W[(size_t)(k0 + kk) * N + n0 + (lane & 31)]; }
    LDS_WAIT(); asm volatile("" ::: "memory");
    const int c = lane & 7;
#pragma unroll
    for (int j = 0; j < 4; ++j) { const int n = (lane >> 3) + 8 * j; const LAS float* sp = scr + (8 * c) * 33 + n;
        v4u o; o.x = pk2(sp[0 * 33], sp[1 * 33]); o.y = pk2(sp[2 * 33], sp[3 * 33]); o.z = pk2(sp[4 * 33], sp[5 * 33]); o.w = pk2(sp[6 * 33], sp[7 * 33]);
        *(v4u*)(WT + (size_t)(n0 + n) * K + k0 + 8 * c) = o; }
    LDS_WAIT(); asm volatile("" ::: "memory");
}
__device__ __forceinline__ void ph_prologue(Frame& F) {
    bf16_t* HB = (bf16_t*)(F.ws + WS_HB);
    bf16_t* MEMB = (bf16_t*)(F.ws + WS_MEMB);
    bf16_t* WINT = (bf16_t*)(F.ws + WS_WINT);
    bf16_t* WMKVT = (bf16_t*)(F.ws + WS_WMKVT);
    const int gw = F.bid * NWAVES + F.wave, NGW = F.G * NWAVES;
    LAS float* scr = (LAS float*)(F.lds + F.wave * 16384);
    constexpr int I_IN = (D / 64) * (IN_COLS / 32), I_MKV = (D / 64) * (2 * MEMW / 32);
    for (int it = gw; it < I_IN + I_MKV; it += NGW) {
        int r = it;
        if (r < I_IN) { p0_transpose_item(F.a->in[I_WIN], D, IN_COLS, WINT, scr, r, F.lane); continue; } r -= I_IN;
        p0_transpose_item(F.a->in[I_WMEMKV], D, 2 * MEMW, WMKVT, scr, r, F.lane);
    }
    { bf16_t* WL = (bf16_t*)(F.ws + WS_WLOWT);
      for (int i = F.bid * NT + F.tid; i < C * (LOWR / 8); i += F.G * NT) { const int c = i % C, kc = i / C, k0 = kc * 8;
          const float* src; int kk0;
          if (k0 < DR) { src = F.a->in[I_WDEC]; kk0 = k0; } else if (k0 < DR + AR) { src = F.a->in[I_WA]; kk0 = k0 - DR; } else { src = F.a->in[I_WG]; kk0 = k0 - DR - AR; }
          v4u o; o.x = pk2(src[(size_t)(kk0 + 0) * C + c], src[(size_t)(kk0 + 1) * C + c]); o.y = pk2(src[(size_t)(kk0 + 2) * C + c], src[(size_t)(kk0 + 3) * C + c]);
          o.z = pk2(src[(size_t)(kk0 + 4) * C + c], src[(size_t)(kk0 + 5) * C + c]); o.w = pk2(src[(size_t)(kk0 + 6) * C + c], src[(size_t)(kk0 + 7) * C + c]);
          *(v4u*)(WL + (size_t)c * LOWR + k0) = o; } }
    { bf16_t* WR = (bf16_t*)(F.ws + WS_WRT);
      for (int i = F.bid * NT + F.tid; i < 80 * D; i += F.G * NT) { const int k = i % D, col = i / D;
          const float w = col < NG ? F.a->in[I_RG][(size_t)k * NG + col] : (col < NG + NE ? F.a->in[I_RE][(size_t)k * NE + (col - NG)] : 0.f);
          const unsigned hi = f2bf(w); const float rem = w - __builtin_bit_cast(float, hi << 16);
          const size_t fo = ((size_t)((k >> 5) * 5 + (col >> 4)) * 64 + (col & 15) + 16 * ((k >> 3) & 3)) * 8 + (k & 7);
          WR[fo] = (bf16_t)hi; WR[(size_t)80 * D + fo] = (bf16_t)f2bf(rem); } }
    for (size_t i = (size_t)F.bid * NT + F.tid; i < (size_t)(PLD - IN_COLS) * D / 8; i += (size_t)F.G * NT) ((v4u*)(WINT + (size_t)IN_COLS * D))[i] = (v4u){0u, 0u, 0u, 0u};
    for (size_t i = (size_t)F.bid * NT + F.tid; i < (size_t)BATCH * MEML * D / 4; i += (size_t)F.G * NT) {
        const f32x4 v = ((const f32x4*)F.a->in[I_MEM])[i]; ((v2u*)MEMB)[i] = (v2u){pk2(v.x, v.y), pk2(v.z, v.w)}; }
    f32x4 xn[8];
    { const f32x4* xr = (const f32x4*)(F.a->in[I_X] + (size_t)(gw < T ? gw : T - 1) * D);
#pragma unroll
      for (int j = 0; j < 8; ++j) xn[j] = xr[F.lane + 64 * j]; }
    for (int row = gw; row < T; row += NGW) {
        f32x4 v[8];
#pragma unroll
        for (int j = 0; j < 8; ++j) v[j] = xn[j];
        { const f32x4* xr = (const f32x4*)(F.a->in[I_X] + (size_t)(row + NGW < T ? row + NGW : row) * D);
#pragma unroll
          for (int j = 0; j < 8; ++j) xn[j] = xr[F.lane + 64 * j]; }
        ln_core<false>(v, F.a->in[I_LNIN_G], F.a->in[I_LNIN_B], nullptr, F.lane);
#pragma unroll
        for (int j = 0; j < 8; ++j) ((v2u*)(HB + (size_t)row * D))[F.lane + 64 * j] = (v2u){pk2(v[j].x, v[j].y), pk2(v[j].z, v[j].w)};
    }
    __syncthreads();
}
struct ProjOrder {
    int G, c;
    __device__ __forceinline__ bool next(int i, pg8::Unit& u) const {
        constexpr int nM = T / 256, nN = PLD / 256, nwg = nM * nN;
        const int L = i * G + c;
        if (L >= nwg + 16) return false;
        if (L >= nwg) { const int j = L - nwg; u.pm = nM + (j >> 2); u.pn = nN + (j & 3); return true; }
        int wgid = L; { const int q = nwg / pg8::NXCD, r = nwg % pg8::NXCD, xcd = wgid % pg8::NXCD, off = wgid / pg8::NXCD; wgid = (xcd < r ? xcd * (q + 1) : r * (q + 1) + (xcd - r) * q) + off; }
        const int nig = pg8::WGM * nN, gid = wgid / nig, fm = gid * pg8::WGM, gsz = (nM - fm) < pg8::WGM ? (nM - fm) : pg8::WGM;
        u.pm = fm + ((wgid % nig) % gsz); u.pn = (wgid % nig) / gsz; return true;
    }
    __device__ __forceinline__ void a_ready(const pg8::Unit&) const {}
    __device__ __forceinline__ void done(const pg8::Unit&) const {}
};
struct EpiProj {
    static constexpr bool PERM = true, AFTER_DRAIN = false;
    bf16_t* P; bf16_t* MKV;
    __device__ __forceinline__ void operator()(const pg8::f32x4 (&acc)[2][2][4][2], const pg8::Unit& u, int wr, int wc, int fr, int fq) const {
        bf16_t* base; int ldc, row0, col0;
        if (u.pm < T / 256) { base = P; ldc = PLD; row0 = u.pm * 256 + wr * 64 + fr; col0 = u.pn * 256 + wc * 32 + 8 * fq; }
        else { base = MKV; ldc = 2 * MEMW; row0 = (u.pm - T / 256) * 256 + wr * 64 + fr; col0 = (u.pn - PLD / 256) * 256 + wc * 32 + 8 * fq; }
#pragma unroll
        for (int ai = 0; ai < 2; ++ai)
#pragma unroll
            for (int m = 0; m < 4; ++m) { bf16_t* rowp = base + (size_t)(row0 + ai * 128 + m * 16) * ldc + col0;
#pragma unroll
                for (int bj = 0; bj < 2; ++bj) { const pg8::f32x4 v0 = acc[ai][bj][m][0], v1 = acc[ai][bj][m][1];
                    v4u w; w.x = pg8::cvt_pk_bf16(v0[0], v0[1]); w.y = pg8::cvt_pk_bf16(v0[2], v0[3]); w.z = pg8::cvt_pk_bf16(v1[0], v1[1]); w.w = pg8::cvt_pk_bf16(v1[2], v1[3]);
                    *(v4u*)(rowp + bj * 128) = w; } }
    }
};
__device__ __forceinline__ void ph_proj(Frame& F) {
    pg8::Gemm g{(const bf16_t*)(F.ws + WS_HB), (const bf16_t*)(F.ws + WS_WINT), T + BATCH * MEML, PLD + 2 * MEMW, D};
    ProjOrder S{F.G, F.bid};
    EpiProj E{(bf16_t*)(F.ws + WS_PROJ), (bf16_t*)(F.ws + WS_MEMKV)};
    pg8::gemm_phase<EpiProj, ProjOrder, false>(F.lds, g, S, E, nullptr);
    __syncthreads();
    { constexpr int I_OUT = (D / 64) * (D / 32);
      bf16_t* WOUTT = (bf16_t*)(F.ws + WS_WOUTT);
      LAS float* scr = (LAS float*)(F.lds + F.wave * 16384);
      volatile LAS int* qslot = (volatile LAS int*)(F.lds + 139264);
      for (;;) {
          if (F.tid == 0) *qslot = (int)atomicAdd(F.ctl + CW_Q2, 2u * NWAVES);
          __syncthreads();
          const int base = *qslot;
          __syncthreads();
          if (base >= I_OUT) break;
#pragma unroll 1
          for (int q = 0; q < 2; ++q) { const int itq = base + 2 * F.wave + q; if (itq < I_OUT) p0_transpose_item(F.a->in[I_WOUT], D, D, WOUTT, scr, itq, F.lane); }
      } }
    __syncthreads();
}
__device__ __forceinline__ void ph_rwkv_prep(Frame& F) {
    using pg8::bf16x8;
    typedef float f4 __attribute__((ext_vector_type(4)));
    constexpr int AS = 296;
    constexpr int KSL = 1040;
    const bf16_t* P = (const bf16_t*)(F.ws + WS_PROJ);
    const bf16_t* WL = (const bf16_t*)(F.ws + WS_WLOWT);
    bf16_t* PK = (bf16_t*)(F.ws + WS_PK);
    bf16_t* GB = (bf16_t*)(F.ws + WS_G);
    const float* mu = F.a->in[I_MU];
    LAS bf16_t* act = (LAS bf16_t*)F.lds;
    LAS bf16_t* ksl = (LAS bf16_t*)(F.lds + 20480);
    LAS float* par = (LAS float*)(F.lds + 20480 + 66560);
    const int tid = F.tid, lane = F.lane, wave = F.wave, fr = lane & 15, fq = lane >> 4;
    for (int item = F.bid; item < T / 32; item += F.G) {
        const int t0 = item * 32;
        __syncthreads();
        { const int q = tid >> 8, e = (tid & 255) * 4;
          *(LAS f32x4*)(par + q * 1024 + e) = *(const f32x4*)((q ? F.a->in[I_A0] : F.a->in[I_W0]) + e);
          *(LAS f32x4*)(par + (2 + q) * 1024 + e) = *(const f32x4*)((q ? F.a->in[I_KA] : F.a->in[I_KK]) + e); }
        { v4u cu[3], pv[3]; f32x4 m0[3], m1[3];
#pragma unroll
          for (int i = 0; i < 3; ++i) { int idx = tid + NT * i; idx = idx < 32 * 36 ? idx : 32 * 36 - 1;
              const int tt = idx / 36, ch = idx % 36, t = t0 + tt, col = COL_DL + 8 * ch;
              const bf16_t* pc = P + (size_t)t * PLD + col;
              cu[i] = *(const v4u*)pc; pv[i] = *(const v4u*)((t % SEQ) ? pc - PLD : pc);
              m0[i] = *(const f32x4*)(mu + col); m1[i] = *(const f32x4*)(mu + col + 4); }
#pragma unroll
          for (int i = 0; i < 3; ++i) { const int idx = tid + NT * i, tt = idx / 36, ch = idx % 36, t = t0 + tt;
              const bool hp = (t % SEQ) != 0;
              const float c[8] = {bflo(cu[i].x), bfhi(cu[i].x), bflo(cu[i].y), bfhi(cu[i].y), bflo(cu[i].z), bfhi(cu[i].z), bflo(cu[i].w), bfhi(cu[i].w)};
              const float q[8] = {bflo(pv[i].x), bfhi(pv[i].x), bflo(pv[i].y), bfhi(pv[i].y), bflo(pv[i].z), bfhi(pv[i].z), bflo(pv[i].w), bfhi(pv[i].w)};
              const float mm[8] = {m0[i].x, m0[i].y, m0[i].z, m0[i].w, m1[i].x, m1[i].y, m1[i].z, m1[i].w};
              float a[8];
#pragma unroll
              for (int e = 0; e < 8; ++e) { const float xs = c[e] + ((hp ? q[e] : 0.f) - c[e]) * mm[e];
                  a[e] = ch < DR / 8 ? ftanh(xs) : (ch < (DR + AR) / 8 ? xs : fsigmoid(xs)); }
              if (idx < 32 * 36) *(LAS v4u*)(act + tt * AS + 8 * ch) = (v4u){pg8::cvt_pk_bf16(a[0], a[1]), pg8::cvt_pk_bf16(a[2], a[3]), pg8::cvt_pk_bf16(a[4], a[5]), pg8::cvt_pk_bf16(a[6], a[7])}; } }
#pragma unroll 1
        for (int i0 = 0; i0 < 24; i0 += 4) {
            v4u cu[4], pv[4]; f32x4 m0[4], m1[4];
#pragma unroll
            for (int i = 0; i < 4; ++i) { const int idx = tid + NT * (i0 + i), tt = idx / 384, col = 8 * (idx % 384), t = t0 + tt;
                const bf16_t* pc = P + (size_t)t * PLD + col;
                cu[i] = *(const v4u*)pc; pv[i] = *(const v4u*)((t % SEQ) ? pc - PLD : pc);
                m0[i] = *(const f32x4*)(mu + col); m1[i] = *(const f32x4*)(mu + col + 4); }
#pragma unroll
            for (int i = 0; i < 4; ++i) { const int idx = tid + NT * (i0 + i), tt = idx / 384, col = 8 * (idx % 384), t = t0 + tt, b = t / SEQ, tl = t % SEQ;
                const bool hp = tl != 0;
                const float c[8] = {bflo(cu[i].x), bfhi(cu[i].x), bflo(cu[i].y), bfhi(cu[i].y), bflo(cu[i].z), bfhi(cu[i].z), bflo(cu[i].w), bfhi(cu[i].w)};
                const float q[8] = {bflo(pv[i].x), bfhi(pv[i].x), bflo(pv[i].y), bfhi(pv[i].y), bflo(pv[i].z), bfhi(pv[i].z), bflo(pv[i].w), bfhi(pv[i].w)};
                const float mm[8] = {m0[i].x, m0[i].y, m0[i].z, m0[i].w, m1[i].x, m1[i].y, m1[i].z, m1[i].w};
                float o[8];
#pragma unroll
                for (int e = 0; e < 8; ++e) o[e] = c[e] + ((hp ? q[e] : 0.f) - c[e]) * mm[e];
                const v4u w = (v4u){pg8::cvt_pk_bf16(o[0], o[1]), pg8::cvt_pk_bf16(o[2], o[3]), pg8::cvt_pk_bf16(o[4], o[5]), pg8::cvt_pk_bf16(o[6], o[7])};
                const int reg = col >> 10, ch = col & 1023;
                if (reg == 1) *(LAS v4u*)(ksl + tt * KSL + ch) = w;
                else *(v4u*)(PK + ((size_t)(b * NH + (ch >> 6)) * SEQ + tl) * 384 + (reg ? 320 : 0) + (ch & 63)) = w; }
        }
        __syncthreads();
#pragma unroll 1
        for (int hd = 0; hd < 2; ++hd) {
            const int h = 2 * wave + hd;
            f4 ad[2][4], aa[2][4], ag[2][4];
#pragma unroll
            for (int m = 0; m < 2; ++m)
#pragma unroll
                for (int n = 0; n < 4; ++n) { ad[m][n] = (f4){0.f, 0.f, 0.f, 0.f}; aa[m][n] = ad[m][n]; ag[m][n] = ad[m][n]; }
            const LAS bf16_t* arow = act + fr * AS + 8 * fq;
            const bf16_t* wrow = WL + (size_t)(64 * h + fr) * LOWR + 8 * fq;
#pragma unroll
            for (int ks = 0; ks < 9; ++ks) {
                const bf16x8 b0 = *(const LAS bf16x8*)(arow + 32 * ks), b1 = *(const LAS bf16x8*)(arow + 16 * AS + 32 * ks);
#pragma unroll
                for (int n = 0; n < 4; ++n) { const bf16x8 af = *(const bf16x8*)(wrow + (size_t)(16 * n) * LOWR + 32 * ks);
                    if (ks < 2) { ad[0][n] = __builtin_amdgcn_mfma_f32_16x16x32_bf16(af, b0, ad[0][n], 0, 0, 0); ad[1][n] = __builtin_amdgcn_mfma_f32_16x16x32_bf16(af, b1, ad[1][n], 0, 0, 0); }
                    else if (ks < 4) { aa[0][n] = __builtin_amdgcn_mfma_f32_16x16x32_bf16(af, b0, aa[0][n], 0, 0, 0); aa[1][n] = __builtin_amdgcn_mfma_f32_16x16x32_bf16(af, b1, aa[1][n], 0, 0, 0); }
                    else { ag[0][n] = __builtin_amdgcn_mfma_f32_16x16x32_bf16(af, b0, ag[0][n], 0, 0, 0); ag[1][n] = __builtin_amdgcn_mfma_f32_16x16x32_bf16(af, b1, ag[1][n], 0, 0, 0); } }
                if (ks % 3 == 2) __builtin_amdgcn_sched_barrier(0);
            }
#pragma unroll
            for (int m = 0; m < 2; ++m)
#pragma unroll
                for (int n = 0; n < 4; ++n) *(v2u*)(GB + (size_t)(t0 + 16 * m + fr) * C + 64 * h + 16 * n + 4 * fq) = (v2u){pg8::cvt_pk_bf16(ag[m][n][0], ag[m][n][1]), pg8::cvt_pk_bf16(ag[m][n][2], ag[m][n][3])};
            __builtin_amdgcn_sched_barrier(0);
#pragma unroll
            for (int m = 0; m < 2; ++m) {
                const int t = t0 + 16 * m + fr, b = t / SEQ, tl = t % SEQ;
                bf16_t* pk = PK + ((size_t)(b * NH + h) * SEQ + tl) * 384 + 4 * fq;
                const LAS bf16_t* kr = ksl + (16 * m + fr) * KSL + 64 * h + 4 * fq;
                float ks_[4][4], av[4][4], kkr[4][4];
                float ss = 0.f;
#pragma unroll
                for (int n = 0; n < 4; ++n) {
                    const int c0 = 64 * h + 16 * n + 4 * fq;
                    const v2u kc = *(const LAS v2u*)(kr + 16 * n);
                    const f32x4 w0 = *(const LAS f32x4*)(par + c0), a0 = *(const LAS f32x4*)(par + 1024 + c0), kkc = *(const LAS f32x4*)(par + 2048 + c0);
                    const float kcv[4] = {bflo(kc.x), bfhi(kc.x), bflo(kc.y), bfhi(kc.y)};
                    float lw[4];
#pragma unroll
                    for (int r = 0; r < 4; ++r) {
                        ks_[n][r] = kcv[r];
                        const float wl = w0[r] + ad[m][n][r];
                        const float wlog = -fsoftplus(-wl) - 0.5f;
                        lw[r] = -__expf(wlog);
                        av[n][r] = fsigmoid(a0[r] + aa[m][n][r]);
                        kkr[n][r] = ks_[n][r] * kkc[r];
                        ss += kkr[n][r] * kkr[n][r];
                    }
                    *(v2u*)(pk + 16 * n + 64) = (v2u){pg8::cvt_pk_bf16(lw[0], lw[1]), pg8::cvt_pk_bf16(lw[2], lw[3])};
                }
                ss += __shfl_xor(ss, 16); ss += __shfl_xor(ss, 32);
                const float inv = 1.f / fmaxf(sqrtf(ss), 1e-12f);
#pragma unroll
                for (int n = 0; n < 4; ++n) {
                    const int c0 = 64 * h + 16 * n + 4 * fq;
                    const f32x4 kac = *(const LAS f32x4*)(par + 3072 + c0);
                    float kk[4], k2[4], bb[4];
#pragma unroll
                    for (int r = 0; r < 4; ++r) { kk[r] = kkr[n][r] * inv; k2[r] = ks_[n][r] * (1.f + (av[n][r] - 1.f) * kac[r]); bb[r] = kk[r] * av[n][r]; }
                    bf16_t* pn = pk + 16 * n;
                    *(v2u*)(pn + 128) = (v2u){pg8::cvt_pk_bf16(k2[0], k2[1]), pg8::cvt_pk_bf16(k2[2], k2[3])};
                    *(v2u*)(pn + 192) = (v2u){pg8::cvt_pk_bf16(-kk[0], -kk[1]), pg8::cvt_pk_bf16(-kk[2], -kk[3])};
                    *(v2u*)(pn + 256) = (v2u){pg8::cvt_pk_bf16(bb[0], bb[1]), pg8::cvt_pk_bf16(bb[2], bb[3])};
                }
            }
        }
    }
    __syncthreads();
}
__device__ __forceinline__ float dpp_sum8(float x) {
    x += __builtin_bit_cast(float, __builtin_amdgcn_update_dpp(0, __builtin_bit_cast(int, x), 0xB1, 0xF, 0xF, false));
    x += __builtin_bit_cast(float, __builtin_amdgcn_update_dpp(0, __builtin_bit_cast(int, x), 0x4E, 0xF, 0xF, false));
    x += __builtin_bit_cast(float, __builtin_amdgcn_update_dpp(0, __builtin_bit_cast(int, x), 0x141, 0xF, 0xF, false));
    return x;
}
template <bool IDENT>
__device__ __forceinline__ void wkv_steps8(f32x2 (&s)[4][8], const LAS float* buf, float* yout, const int vg, const int kg) {
#pragma unroll 1
    for (int st = 0; st < 8; ++st) {
        const LAS float* vb = buf + st * 384 + kg * 16;
        float sa[4], y[4];
        {
            f32x2 aa[8];
#pragma unroll
            for (int q = 0; q < 4; ++q) { const f32x4 t3 = *(const LAS f32x4*)(vb + 192 + 4 * q); aa[2 * q] = (f32x2){t3.x, t3.y}; aa[2 * q + 1] = (f32x2){t3.z, t3.w}; }
#pragma unroll
            for (int i = 0; i < 4; ++i) {
                f32x2 sa2 = s[i][0] * aa[0];
#pragma unroll
                for (int jp = 1; jp < 8; ++jp) sa2 = s[i][jp] * aa[jp] + sa2;
                sa[i] = sa2.x + sa2.y;
            }
        }
#pragma unroll
        for (int i = 0; i < 4; ++i) sa[i] += __builtin_bit_cast(float, __builtin_amdgcn_update_dpp(0, __builtin_bit_cast(int, sa[i]), 0xB1, 0xF, 0xF, false));
#pragma unroll
        for (int i = 0; i < 4; ++i) sa[i] += __builtin_bit_cast(float, __builtin_amdgcn_update_dpp(0, __builtin_bit_cast(int, sa[i]), 0x4E, 0xF, 0xF, false));
        f32x4 vv;
        if (!IDENT) vv = *(const LAS f32x4*)(buf + st * 384 + 320 + vg * 4);
        f32x2 y2[4];
#pragma unroll
        for (int hf = 0; hf < 2; ++hf) {
            f32x2 rr[4], ww[4], kk2[4], bb[4];
#pragma unroll
            for (int q = 0; q < 2; ++q) {
                const f32x4 t0 = *(const LAS f32x4*)(vb + 8 * hf + 4 * q), t1 = *(const LAS f32x4*)(vb + 64 + 8 * hf + 4 * q), t2 = *(const LAS f32x4*)(vb + 128 + 8 * hf + 4 * q), t4 = *(const LAS f32x4*)(vb + 256 + 8 * hf + 4 * q);
                rr[2 * q] = (f32x2){t0.x, t0.y}; rr[2 * q + 1] = (f32x2){t0.z, t0.w}; ww[2 * q] = (f32x2){t1.x, t1.y}; ww[2 * q + 1] = (f32x2){t1.z, t1.w};
                kk2[2 * q] = (f32x2){t2.x, t2.y}; kk2[2 * q + 1] = (f32x2){t2.z, t2.w}; bb[2 * q] = (f32x2){t4.x, t4.y}; bb[2 * q + 1] = (f32x2){t4.z, t4.w};
            }
#pragma unroll
            for (int i = 0; i < 4; ++i) {
                const f32x2 sav = (f32x2){sa[i], sa[i]};
#pragma unroll
                for (int jq = 0; jq < 4; ++jq) { const int jp = 4 * hf + jq;
                    f32x2 u = sav * bb[jq];
                    if (!IDENT) { const float vi = vv[i]; u = (f32x2){vi, vi} * kk2[jq] + u; }
                    s[i][jp] = s[i][jp] * ww[jq] + u;
                    y2[i] = (jp == 0) ? s[i][jp] * rr[jq] : s[i][jp] * rr[jq] + y2[i];
                }
            }
        }
#pragma unroll
        for (int i = 0; i < 4; ++i) y[i] = y2[i].x + y2[i].y;
#pragma unroll
        for (int i = 0; i < 4; ++i) y[i] += __builtin_bit_cast(float, __builtin_amdgcn_update_dpp(0, __builtin_bit_cast(int, y[i]), 0xB1, 0xF, 0xF, false));
#pragma unroll
        for (int i = 0; i < 4; ++i) y[i] += __builtin_bit_cast(float, __builtin_amdgcn_update_dpp(0, __builtin_bit_cast(int, y[i]), 0x4E, 0xF, 0xF, false));
        if (kg == 0) *(f32x4*)(yout + st * 64) = (f32x4){y[0], y[1], y[2], y[3]};
    }
}
__device__ __forceinline__ void ph_wkv_scan(Frame& F) {
    const bf16_t* PK = (const bf16_t*)(F.ws + WS_PK);
    const int lane = F.lane, wave = F.wave, pr = wave >> 1, role = (wave ^ (wave >> 2)) & 1, vg = lane >> 2, kg = lane & 3, l128 = role * 64 + lane;
    LAS float* pbuf = (LAS float*)(F.lds + pr * 24576);
    int woff[3]; bool isw[3];
#pragma unroll
    for (int j = 0; j < 3; ++j) { const int pi = l128 + 128 * j, stp = pi / 48, rem = pi % 48, vec = rem >> 3, c8 = rem & 7; woff[j] = (stp * 6 + vec) * 64 + c8 * 8; isw[j] = (vec == 1); }
    const int nround = (BATCH * NH * 16 + F.G * 4 - 1) / (F.G * 4);
    for (int rd = 0; rd < nround; ++rd) {
        const int item = (rd * F.G + F.bid) * 4 + pr;
        const bool act = item < BATCH * NH * 16;
        const int bh = item >> 4, ch = item & 15;
        const bf16_t* src = PK + ((size_t)bh * SEQ + ch * 128) * 384;
        f32x2 s[4][8];
#pragma unroll
        for (int i = 0; i < 4; ++i)
#pragma unroll
            for (int jp = 0; jp < 8; ++jp) s[i][jp] = (f32x2){(role && (4 * vg + i == 16 * kg + 2 * jp)) ? 1.f : 0.f, (role && (4 * vg + i == 16 * kg + 2 * jp + 1)) ? 1.f : 0.f};
        v4u rg[3];
#define WK_LOAD(sg) do { _Pragma("unroll") for (int j = 0; j < 3; ++j) rg[j] = *(const v4u*)(src + (size_t)(sg) * 8 * 384 + (size_t)(l128 + 128 * j) * 8); } while (0)
#define WK_WRITE(bf) do { _Pragma("unroll") for (int j = 0; j < 3; ++j) { float f[8]; f[0] = bflo(rg[j].x); f[1] = bfhi(rg[j].x); f[2] = bflo(rg[j].y); f[3] = bfhi(rg[j].y); f[4] = bflo(rg[j].z); f[5] = bfhi(rg[j].z); f[6] = bflo(rg[j].w); f[7] = bfhi(rg[j].w); \
            if (isw[j]) { _Pragma("unroll") for (int e = 0; e < 8; ++e) f[e] = __expf(f[e]); } \
            LAS float* d_ = pbuf + (bf) * 3072 + woff[j]; *(LAS f32x4*)d_ = (f32x4){f[0], f[1], f[2], f[3]}; *(LAS f32x4*)(d_ + 4) = (f32x4){f[4], f[5], f[6], f[7]}; } } while (0)
        __syncthreads();
        if (act) { WK_LOAD(0); WK_WRITE(0); WK_LOAD(1); }
        __syncthreads();
        float* yout = (float*)(F.ws + (role ? WS_QH : WS_YLOC)) + ((size_t)bh * SEQ + ch * 128) * 64 + vg * 4;
        for (int sg = 0; sg < 16; ++sg) {
            if (act) {
                if (role) wkv_steps8<true>(s, pbuf + (sg & 1) * 3072, yout + (size_t)sg * 8 * 64, vg, kg);
                else wkv_steps8<false>(s, pbuf + (sg & 1) * 3072, yout + (size_t)sg * 8 * 64, vg, kg);
                if (sg + 1 < 16) WK_WRITE((sg + 1) & 1);
                if (sg + 2 < 16) WK_LOAD(sg + 2);
            }
            __syncthreads();
        }
#undef WK_LOAD
#undef WK_WRITE
        if (act) { float* so = (float*)(F.ws + (role ? WS_PCH : WS_LCH)) + (size_t)item * 4096 + (size_t)(4 * vg) * 64 + 16 * kg;
#pragma unroll
            for (int i = 0; i < 4; ++i)
#pragma unroll
                for (int q = 0; q < 4; ++q) *(f32x4*)(so + i * 64 + 4 * q) = (f32x4){s[i][2 * q].x, s[i][2 * q].y, s[i][2 * q + 1].x, s[i][2 * q + 1].y}; }
    }
    __syncthreads();
}
namespace wk {
using pg8::bf16x8; using pg8::lds_byte;
typedef float f4 __attribute__((ext_vector_type(4)));
constexpr int AB = 8192;
constexpr int O_At = 0, O_Bt = AB, O_Kt = 2 * AB, O_Rt = 3 * AB, O_ATr = 4 * AB, O_BH = 5 * AB, O_KH = 6 * AB, O_VT = 7 * AB, O_N = 8 * AB, O_NT = 9 * AB, O_T0 = 10 * AB,
              O_Aak = 11 * AB, O_Arb = 12 * AB, O_Ark = 13 * AB, O_Z1T = 14 * AB, O_UT = 15 * AB, O_GT = 16 * AB, O_SEG = 17 * AB, O_WL = O_SEG + 4096, O_RAW = O_N;
struct Ctx { LAS unsigned char* lds; int am, fbase, d0, d1, ai, b0i; };
__device__ __forceinline__ void mm2(const Ctx& c, const int offA, const int offB, f4 (&acc)[2]) {
    const LAS unsigned char* pa = c.lds + offA + c.am * 2048 + c.fbase;
    const LAS unsigned char* pb = c.lds + offB + (c.b0i >> 4) * 2048 + c.fbase;
    const bf16x8 a0 = *(const LAS bf16x8*)pa, a1 = *(const LAS bf16x8*)(pa + 1024);
#pragma unroll
    for (int n = 0; n < 2; ++n) { const bf16x8 b0 = *(const LAS bf16x8*)(pb + n * 2048), b1 = *(const LAS bf16x8*)(pb + n * 2048 + 1024);
        acc[n] = __builtin_amdgcn_mfma_f32_16x16x32_bf16(a0, b0, acc[n], 0, 0, 0); acc[n] = __builtin_amdgcn_mfma_f32_16x16x32_bf16(a1, b1, acc[n], 0, 0, 0); }
}
__device__ __forceinline__ void zero2(f4 (&acc)[2]) { acc[0] = (f4){0.f, 0.f, 0.f, 0.f}; acc[1] = acc[0]; }
__device__ __forceinline__ void st_d(const Ctx& c, const int off, const int n, const f4 d) {
    *(LAS v2u*)(c.lds + off + (n ? c.d1 : c.d0)) = (v2u){pg8::cvt_pk_bf16(d[0], d[1]), pg8::cvt_pk_bf16(d[2], d[3])}; }
__device__ __forceinline__ f4 ld_d(const Ctx& c, const int off, const int n) {
    const v2u w = *(const LAS v2u*)(c.lds + off + (n ? c.d1 : c.d0)); return (f4){bflo(w.x), bfhi(w.x), bflo(w.y), bfhi(w.y)}; }
template <int MODE> __device__ __forceinline__ f4 tri(const Ctx& c, const int n, const f4 d) {
    const int b = c.b0i + 16 * n; f4 o;
#pragma unroll
    for (int r = 0; r < 4; ++r) { const int a = c.ai + r; const bool keep = MODE == 0 ? a < b : (MODE == 1 ? a <= b : a > b); o[r] = keep ? d[r] : 0.f; }
    return o; }
struct FA { bf16x8 v[2]; };
struct FB { bf16x8 v[2][2]; };
__device__ __forceinline__ FA lda(const Ctx& c, const int off) { const LAS unsigned char* p = c.lds + off + c.am * 2048 + c.fbase; FA f; f.v[0] = *(const LAS bf16x8*)p; f.v[1] = *(const LAS bf16x8*)(p + 1024); return f; }
__device__ __forceinline__ FB ldb(const Ctx& c, const int off) { const LAS unsigned char* p = c.lds + off + (c.b0i >> 4) * 2048 + c.fbase; FB f;
#pragma unroll
    for (int n = 0; n < 2; ++n) { f.v[n][0] = *(const LAS bf16x8*)(p + n * 2048); f.v[n][1] = *(const LAS bf16x8*)(p + n * 2048 + 1024); }
    return f; }
__device__ __forceinline__ void mmf(f4 (&acc)[2], const FA& a, const FB& b) {
#pragma unroll
    for (int n = 0; n < 2; ++n) acc[n] = __builtin_amdgcn_mfma_f32_16x16x32_bf16(a.v[0], b.v[n][0], acc[n], 0, 0, 0);
#pragma unroll
    for (int n = 0; n < 2; ++n) acc[n] = __builtin_amdgcn_mfma_f32_16x16x32_bf16(a.v[1], b.v[n][1], acc[n], 0, 0, 0); }
__device__ __forceinline__ void st2(const Ctx& c, const int off, const f4 (&d)[2]) { st_d(c, off, 0, d[0]); st_d(c, off, 1, d[1]); }
template <int MODE> __device__ __forceinline__ void st2tri(const Ctx& c, const int off, const f4 (&d)[2]) { st_d(c, off, 0, tri<MODE>(c, 0, d[0])); st_d(c, off, 1, tri<MODE>(c, 1, d[1])); }
__device__ __forceinline__ void chain_stage(const Ctx& c, const int Pin, const int PTin, const int Pout, const int PTout, const int Tin, const int Tout) {
    const FA aPT = lda(c, PTin), aP = lda(c, Pin); const FB bT = ldb(c, Tin), bP = ldb(c, Pin), bPT = ldb(c, PTin);
    f4 t[2], p[2], pt[2]; t[0] = ld_d(c, Tin, 0); t[1] = ld_d(c, Tin, 1); zero2(p); zero2(pt);
    __builtin_amdgcn_sched_barrier(0);
    mmf(t, aPT, bT); mmf(p, aPT, bP); mmf(pt, aP, bPT);
    st2(c, Tout, t); st2(c, Pout, p); st2(c, PTout, pt); }
}
__device__ __forceinline__ void ph_wkv_chunk(Frame& F) {
    using namespace wk;
    const bf16_t* PK = (const bf16_t*)(F.ws + WS_PK);
    bf16_t* YLOC = (bf16_t*)(F.ws + WS_YLOC); bf16_t* QH = (bf16_t*)(F.ws + WS_QH); bf16_t* PCH = (bf16_t*)(F.ws + WS_PCH); bf16_t* LCH = (bf16_t*)(F.ws + WS_LCH);
    LAS unsigned char* lds = F.lds;
    const int tid = F.tid, lane = F.lane, wave = F.wave, fr = lane & 15, fq = lane >> 4;
    Ctx c; c.lds = lds; c.am = wave >> 1; c.fbase = lds_byte(fr, 8 * fq); c.ai = 16 * (wave >> 1) + 4 * fq; c.b0i = 32 * (wave & 1) + fr;
    c.d0 = lds_byte(c.b0i, c.ai); c.d1 = lds_byte(c.b0i + 16, c.ai);
    constexpr int NIT = BATCH * NH * NCH;
    const LAS unsigned* raw32 = (const LAS unsigned*)(lds + O_RAW);
    LAS f32x2* segs2 = (LAS f32x2*)(lds + O_SEG);
    LAS float* wl = (LAS float*)(lds + O_WL);
    const int jp = tid & 31, sg = tid >> 5;
    v4u rg[6];
#define WC_LOAD(it_) do { const v4u* src_ = (const v4u*)(PK + (size_t)(it_) * 64 * 384); _Pragma("unroll") for (int q = 0; q < 6; ++q) rg[q] = src_[tid + NT * q]; } while (0)
    { const int i0 = F.bid < NIT ? F.bid : NIT - 1; WC_LOAD(i0); }
    __syncthreads();
#pragma unroll
    for (int q = 0; q < 6; ++q) *(LAS v4u*)(lds + O_RAW + (tid + NT * q) * 16) = rg[q];
    __syncthreads();
    for (int it = F.bid; it < NIT; it += F.G) {
        { const int nx = it + F.G < NIT ? it + F.G : it; WC_LOAD(nx); }
        f32x2 cs[4];
        { f32x2 run = (f32x2){0.f, 0.f};
#pragma unroll
          for (int i = 0; i < 4; ++i) { const unsigned w = raw32[(4 * sg + i) * 192 + 32 + jp]; run += (f32x2){bflo(w), bfhi(w)}; cs[i] = run; }
          segs2[sg * 32 + jp] = run; }
        __syncthreads();
        { unsigned rw[4], kw[4], aw[4], bw[4], vw[4];
#pragma unroll
          for (int i = 0; i < 4; ++i) { const LAS unsigned* rp = raw32 + (4 * sg + i) * 192 + jp; rw[i] = rp[0]; kw[i] = rp[64]; aw[i] = rp[96]; bw[i] = rp[128]; vw[i] = rp[160]; }
          f32x2 off = (f32x2){0.f, 0.f}, cl = off;
#pragma unroll
          for (int sgi = 0; sgi < 16; ++sgi) { const f32x2 v = segs2[sgi * 32 + jp]; cl += v; if (sgi < sg) off += v; }
          const f32x2 ecl = (f32x2){__expf(cl.x), __expf(cl.y)};
          if (sg == 0) *(LAS f32x2*)(wl + 2 * jp) = ecl;
          f32x2 ep = (f32x2){__expf(off.x), __expf(off.y)};
          f32x2 atv[4], bhv[4], khv[4];
          const int o0 = lds_byte(4 * sg, 2 * jp);
#pragma unroll
          for (int i = 0; i < 4; ++i) {
              const f32x2 cum = off + cs[i];
              const f32x2 eo = (f32x2){__expf(cum.x), __expf(cum.y)}, en = (f32x2){__builtin_amdgcn_rcpf(eo.x), __builtin_amdgcn_rcpf(eo.y)}, eh = ecl * en;
              const f32x2 r2 = (f32x2){bflo(rw[i]), bfhi(rw[i])}, k2 = (f32x2){bflo(kw[i]), bfhi(kw[i])}, a2 = (f32x2){bflo(aw[i]), bfhi(aw[i])}, b2 = (f32x2){bflo(bw[i]), bfhi(bw[i])};
              atv[i] = a2 * ep; bhv[i] = b2 * eh; khv[i] = k2 * eh; ep = eo;
              const f32x2 bt = b2 * en, kt = k2 * en, rt = r2 * eo;
              *(LAS unsigned*)(lds + O_At + o0 + 64 * i) = pg8::cvt_pk_bf16(atv[i].x, atv[i].y); *(LAS unsigned*)(lds + O_Bt + o0 + 64 * i) = pg8::cvt_pk_bf16(bt.x, bt.y);
              *(LAS unsigned*)(lds + O_Kt + o0 + 64 * i) = pg8::cvt_pk_bf16(kt.x, kt.y); *(LAS unsigned*)(lds + O_Rt + o0 + 64 * i) = pg8::cvt_pk_bf16(rt.x, rt.y); }
          const int ot = lds_byte(2 * jp, 4 * sg);
          *(LAS v2u*)(lds + O_ATr + ot) = (v2u){pg8::cvt_pk_bf16(atv[0].x, atv[1].x), pg8::cvt_pk_bf16(atv[2].x, atv[3].x)}; *(LAS v2u*)(lds + O_ATr + ot + 64) = (v2u){pg8::cvt_pk_bf16(atv[0].y, atv[1].y), pg8::cvt_pk_bf16(atv[2].y, atv[3].y)};
          *(LAS v2u*)(lds + O_BH + ot) = (v2u){pg8::cvt_pk_bf16(bhv[0].x, bhv[1].x), pg8::cvt_pk_bf16(bhv[2].x, bhv[3].x)}; *(LAS v2u*)(lds + O_BH + ot + 64) = (v2u){pg8::cvt_pk_bf16(bhv[0].y, bhv[1].y), pg8::cvt_pk_bf16(bhv[2].y, bhv[3].y)};
          *(LAS v2u*)(lds + O_KH + ot) = (v2u){pg8::cvt_pk_bf16(khv[0].x, khv[1].x), pg8::cvt_pk_bf16(khv[2].x, khv[3].x)}; *(LAS v2u*)(lds + O_KH + ot + 64) = (v2u){pg8::cvt_pk_bf16(khv[0].y, khv[1].y), pg8::cvt_pk_bf16(khv[2].y, khv[3].y)};
          *(LAS v2u*)(lds + O_VT + ot) = (v2u){(vw[0] & 0xffffu) | (vw[1] << 16), (vw[2] & 0xffffu) | (vw[3] << 16)}; *(LAS v2u*)(lds + O_VT + ot + 64) = (v2u){(vw[0] >> 16) | (vw[1] & 0xffff0000u), (vw[2] >> 16) | (vw[3] & 0xffff0000u)}; }
        __syncthreads();
        { const FA aB = lda(c, O_Bt), aA = lda(c, O_At), aK = lda(c, O_Kt); const FB bA = ldb(c, O_At), bB = ldb(c, O_Bt), bR = ldb(c, O_Rt);
          __builtin_amdgcn_sched_barrier(0);
          f4 nn[2], nt[2], ak[2], rb[2], rk[2]; zero2(nn); zero2(nt); zero2(ak); zero2(rb); zero2(rk);
          mmf(nn, aB, bA); mmf(nt, aA, bB); mmf(ak, aK, bA); mmf(rb, aB, bR); mmf(rk, aK, bR);
#pragma unroll
          for (int n = 0; n < 2; ++n) { const f4 m = tri<0>(c, n, nn[n]); st_d(c, O_N, n, m);
              const int b = c.b0i + 16 * n; f4 t1;
#pragma unroll
              for (int r = 0; r < 4; ++r) t1[r] = (c.ai + r == b) ? 1.f : m[r];
              st_d(c, O_T0, n, t1); }
          st2tri<2>(c, O_NT, nt); st2tri<0>(c, O_Aak, ak); st2tri<1>(c, O_Arb, rb); st2tri<1>(c, O_Ark, rk); }
        __syncthreads();
        { const FA aNT = lda(c, O_NT), aN = lda(c, O_N), aAk = lda(c, O_Aak); const FB bN = ldb(c, O_N), bNT = ldb(c, O_NT), bV = ldb(c, O_VT);
          __builtin_amdgcn_sched_barrier(0);
          f4 p[2], pt[2], z[2]; zero2(p); zero2(pt); zero2(z);
          mmf(p, aNT, bN); mmf(pt, aN, bNT); mmf(z, aAk, bV);
          st2(c, O_At, p); st2(c, O_Bt, pt); st2(c, O_Z1T, z); }
        __syncthreads();
        chain_stage(c, O_At, O_Bt, O_N, O_NT, O_T0, O_Kt);
        __syncthreads();
        chain_stage(c, O_N, O_NT, O_At, O_Bt, O_Kt, O_T0);
        __syncthreads();
        chain_stage(c, O_At, O_Bt, O_N, O_NT, O_T0, O_Kt);
        __syncthreads();
        { const FA aPT = lda(c, O_NT), aP = lda(c, O_N); const FB bT = ldb(c, O_Kt), bPT = ldb(c, O_NT);
          f4 t[2], pt[2]; t[0] = ld_d(c, O_Kt, 0); t[1] = ld_d(c, O_Kt, 1); zero2(pt);
          __builtin_amdgcn_sched_barrier(0);
          mmf(t, aPT, bT); mmf(pt, aP, bPT);
          st2(c, O_T0, t); st2(c, O_Bt, pt); }
        __syncthreads();
        { const FA aPT = lda(c, O_Bt); const FB bT = ldb(c, O_T0); f4 t[2]; t[0] = ld_d(c, O_T0, 0); t[1] = ld_d(c, O_T0, 1);
          mmf(t, aPT, bT); st2(c, O_Kt, t); }
        __syncthreads();
        { const FA aT = lda(c, O_Kt); const FB bZ = ldb(c, O_Z1T), bAT = ldb(c, O_ATr);
          f4 u[2], g[2]; zero2(u); zero2(g);
          mmf(u, aT, bZ); mmf(g, aT, bAT);
          st2(c, O_UT, u); st2(c, O_GT, g); }
        __syncthreads();
        { const int bh = it >> 5, ch = it & 31;
          const size_t row0 = (size_t)bh * SEQ + ch * 64;
          const FA aG = lda(c, O_GT), aU = lda(c, O_UT), aV = lda(c, O_VT), aBH = lda(c, O_BH), aKH = lda(c, O_KH);
          const FB bRb = ldb(c, O_Arb), bRk = ldb(c, O_Ark), bBH = ldb(c, O_BH), bU = ldb(c, O_UT), bV = ldb(c, O_VT);
          f4 q[2], y[2], pm[2], lc[2]; q[0] = ld_d(c, O_Rt, 0); q[1] = ld_d(c, O_Rt, 1); zero2(y); zero2(pm); zero2(lc);
          const float w0 = wl[c.b0i], w1 = wl[c.b0i + 16];
          __builtin_amdgcn_sched_barrier(0);
          mmf(q, aG, bRb);
          mmf(y, aU, bRb); mmf(y, aV, bRk);
          mmf(pm, aG, bBH);
          mmf(lc, aBH, bU); mmf(lc, aKH, bV);
#pragma unroll
          for (int n = 0; n < 2; ++n) { const int b = c.b0i + 16 * n;
              *(v2u*)(QH + (row0 + b) * 64 + c.ai) = (v2u){pg8::cvt_pk_bf16(q[n][0], q[n][1]), pg8::cvt_pk_bf16(q[n][2], q[n][3])};
              *(v2u*)(YLOC + (row0 + b) * 64 + c.ai) = (v2u){pg8::cvt_pk_bf16(y[n][0], y[n][1]), pg8::cvt_pk_bf16(y[n][2], y[n][3])};
              f4 o = pm[n]; const float wd = n ? w1 : w0;
#pragma unroll
              for (int r = 0; r < 4; ++r) o[r] += (c.ai + r == b) ? wd : 0.f;
              *(v2u*)(PCH + (size_t)it * 4096 + b * 64 + c.ai) = (v2u){pg8::cvt_pk_bf16(o[0], o[1]), pg8::cvt_pk_bf16(o[2], o[3])};
              *(v2u*)(LCH + (size_t)it * 4096 + b * 64 + c.ai) = (v2u){pg8::cvt_pk_bf16(lc[n][0], lc[n][1]), pg8::cvt_pk_bf16(lc[n][2], lc[n][3])}; } }
        __syncthreads();
#pragma unroll
        for (int q = 0; q < 6; ++q) *(LAS v4u*)(lds + O_RAW + (tid + NT * q) * 16) = rg[q];
        __syncthreads();
    }
#undef WC_LOAD
    __syncthreads();
}
__device__ __forceinline__ void wkv_carry_bh(Frame& F, const int bh) {
    using namespace wk;
    const bf16_t* PT = (const bf16_t*)(F.ws + WS_PCH) + (size_t)bh * NCH * 4096;
    const bf16_t* LC = (const bf16_t*)(F.ws + WS_LCH) + (size_t)bh * NCH * 4096;
    bf16_t* SST = (bf16_t*)(F.ws + WS_SST) + (size_t)bh * NCH * 4096;
    const int lane = F.lane, wave = F.wave, fr = lane & 15, fq = lane >> 4;
    Ctx c; c.lds = F.lds; c.am = wave >> 1; c.fbase = lds_byte(fr, 8 * fq); c.ai = 16 * (wave >> 1) + 4 * fq; c.b0i = 32 * (wave & 1) + fr;
    c.d0 = lds_byte(c.b0i, c.ai); c.d1 = lds_byte(c.b0i + 16, c.ai);
    __syncthreads();
    { const f4 z = (f4){0.f, 0.f, 0.f, 0.f};
#pragma unroll
      for (int n = 0; n < 2; ++n) { st_d(c, 0, n, z); st_d(c, AB, n, z); *(v2u*)(SST + (c.b0i + 16 * n) * 64 + c.ai) = (v2u){0u, 0u}; } }
    const int pofs = (16 * c.am + fr) * 64 + 8 * fq;
    bf16x8 pa0 = *(const bf16x8*)(PT + pofs), pa1 = *(const bf16x8*)(PT + pofs + 32);
    v2u lv0 = *(const v2u*)(LC + c.b0i * 64 + c.ai), lv1 = *(const v2u*)(LC + (c.b0i + 16) * 64 + c.ai);
    __syncthreads();
    for (int ch = 0; ch < NCH - 1; ++ch) {
        const int cur = (ch & 1) * 2 * AB, nxt = 2 * AB - cur;
        const FB sh = ldb(c, cur), sl = ldb(c, cur + AB);
        FA a; a.v[0] = pa0; a.v[1] = pa1;
        f4 acc[2]; acc[0] = (f4){bflo(lv0.x), bfhi(lv0.x), bflo(lv0.y), bfhi(lv0.y)}; acc[1] = (f4){bflo(lv1.x), bfhi(lv1.x), bflo(lv1.y), bfhi(lv1.y)};
        { const int cn = ch + 1 < NCH - 1 ? ch + 1 : NCH - 2;
          const bf16_t* pn = PT + (size_t)cn * 4096; const bf16_t* ln = LC + (size_t)cn * 4096;
          pa0 = *(const bf16x8*)(pn + pofs); pa1 = *(const bf16x8*)(pn + pofs + 32);
          lv0 = *(const v2u*)(ln + c.b0i * 64 + c.ai); lv1 = *(const v2u*)(ln + (c.b0i + 16) * 64 + c.ai); }
        mmf(acc, a, sh); mmf(acc, a, sl);
        bf16_t* so = SST + (size_t)(ch + 1) * 4096;
#pragma unroll
        for (int n = 0; n < 2; ++n) { const f4 d = acc[n];
            const v2u hi = (v2u){pg8::cvt_pk_bf16(d[0], d[1]), pg8::cvt_pk_bf16(d[2], d[3])};
            const f4 lo = (f4){d[0] - bflo(hi.x), d[1] - bfhi(hi.x), d[2] - bflo(hi.y), d[3] - bfhi(hi.y)};
            *(LAS v2u*)(c.lds + nxt + (n ? c.d1 : c.d0)) = hi; st_d(c, nxt + AB, n, lo);
            *(v2u*)(so + (c.b0i + 16 * n) * 64 + c.ai) = hi; }
        __syncthreads();
    }
    __syncthreads();
}
struct PostIn { pg8::bf16x8 qf[2], sf[4][2]; v2u yw[4], rr[4], kk[4], vv[4], gg[4]; };
__device__ __forceinline__ void ph_wkv_post(Frame& F) {
    using pg8::bf16x8;
    typedef float f4 __attribute__((ext_vector_type(4)));
    const bf16_t* PK = (const bf16_t*)(F.ws + WS_PK);
    const bf16_t* GB = (const bf16_t*)(F.ws + WS_G);
    const bf16_t* YLOC = (const bf16_t*)(F.ws + WS_YLOC);
    const bf16_t* QH = (const bf16_t*)(F.ws + WS_QH);
    const bf16_t* SST = (const bf16_t*)(F.ws + WS_SST);
    bf16_t* YC = (bf16_t*)(F.ws + WS_YCAT);
    const int lane = F.lane, wave = F.wave, fr = lane & 15, fq = lane >> 4;
    constexpr int NI = BATCH * NH * 16;
#define POST_LOAD(R, item_) do { const int it_ = (item_); const int bh_ = it_ >> 4, ch_ = it_ & 15, b_ = bh_ / NH, h_ = bh_ % NH; const int tl_ = ch_ * 128 + 16 * wave + fr; \
        const size_t ro_ = (size_t)bh_ * SEQ + tl_, tg_ = (size_t)b_ * SEQ + tl_; const bf16_t* pk_ = PK + ro_ * 384 + 4 * fq; \
        _Pragma("unroll") for (int ks = 0; ks < 2; ++ks) R.qf[ks] = *(const bf16x8*)(QH + ro_ * 64 + 32 * ks + 8 * fq); \
        _Pragma("unroll") for (int m = 0; m < 4; ++m) { \
            _Pragma("unroll") for (int ks = 0; ks < 2; ++ks) R.sf[m][ks] = *(const bf16x8*)(SST + ((size_t)it_ * 2 + (wave >> 2)) * 4096 + (16 * m + fr) * 64 + 32 * ks + 8 * fq); \
            R.yw[m] = *(const v2u*)(YLOC + ro_ * 64 + 16 * m + 4 * fq); R.rr[m] = *(const v2u*)(pk_ + 16 * m); R.kk[m] = *(const v2u*)(pk_ + 128 + 16 * m); R.vv[m] = *(const v2u*)(pk_ + 320 + 16 * m); \
            R.gg[m] = *(const v2u*)(GB + tg_ * C + h_ * HD + 16 * m + 4 * fq); } } while (0)
    PostIn cur;
    { const int i0 = F.bid < NI ? F.bid : NI - 1; POST_LOAD(cur, i0); }
    for (int item = F.bid; item < NI; item += F.G) {
        const int bh = item >> 4, ch = item & 15, b = bh / NH, h = bh % NH;
        const int tl = ch * 128 + 16 * wave + fr;
        const size_t tg = (size_t)b * SEQ + tl;
        PostIn nx;
        { const int nxi = item + F.G < NI ? item + F.G : item; POST_LOAD(nx, nxi); }
        f4 yv[4], lg[4], lb[4], rkv[4];
#pragma unroll
        for (int m = 0; m < 4; ++m) { const int c0 = h * HD + 16 * m + 4 * fq;
            yv[m] = (f4){bflo(cur.yw[m].x), bfhi(cur.yw[m].x), bflo(cur.yw[m].y), bfhi(cur.yw[m].y)};
            lg[m] = *(const f4*)(F.a->in[I_LNXG] + c0); lb[m] = *(const f4*)(F.a->in[I_LNXB] + c0); rkv[m] = *(const f4*)(F.a->in[I_RK] + c0); }
#pragma unroll
        for (int m = 0; m < 4; ++m) { f4 acc = (f4){0.f, 0.f, 0.f, 0.f};
#pragma unroll
            for (int ks = 0; ks < 2; ++ks) acc = __builtin_amdgcn_mfma_f32_16x16x32_bf16(cur.sf[m][ks], cur.qf[ks], acc, 0, 0, 0);
            yv[m] += acc; }
        float sm = 0.f;
#pragma unroll
        for (int m = 0; m < 4; ++m) sm += (yv[m].x + yv[m].y) + (yv[m].z + yv[m].w);
        sm += __shfl_xor(sm, 16); sm += __shfl_xor(sm, 32);
        const float mu = sm * (1.f / HD);
        float s2 = 0.f, bn = 0.f;
#pragma unroll
        for (int m = 0; m < 4; ++m) { yv[m] = yv[m] - mu; s2 += (yv[m].x * yv[m].x + yv[m].y * yv[m].y) + (yv[m].z * yv[m].z + yv[m].w * yv[m].w);
            bn += bflo(cur.rr[m].x) * bflo(cur.kk[m].x) * rkv[m].x + bfhi(cur.rr[m].x) * bfhi(cur.kk[m].x) * rkv[m].y + bflo(cur.rr[m].y) * bflo(cur.kk[m].y) * rkv[m].z + bfhi(cur.rr[m].y) * bfhi(cur.kk[m].y) * rkv[m].w; }
        s2 += __shfl_xor(s2, 16); s2 += __shfl_xor(s2, 32);
        bn += __shfl_xor(bn, 16); bn += __shfl_xor(bn, 32);
        const float rstd = 1.f / sqrtf(s2 * (1.f / HD) + GN_EPS);
#pragma unroll
        for (int m = 0; m < 4; ++m) { const int c0 = h * HD + 16 * m + 4 * fq;
            const float o0 = (yv[m].x * rstd * lg[m].x + lb[m].x + bn * bflo(cur.vv[m].x)) * bflo(cur.gg[m].x), o1 = (yv[m].y * rstd * lg[m].y + lb[m].y + bn * bfhi(cur.vv[m].x)) * bfhi(cur.gg[m].x);
            const float o2 = (yv[m].z * rstd * lg[m].z + lb[m].z + bn * bflo(cur.vv[m].y)) * bflo(cur.gg[m].y), o3 = (yv[m].w * rstd * lg[m].w + lb[m].w + bn * bfhi(cur.vv[m].y)) * bfhi(cur.gg[m].y);
            *(v2u*)(YC + tg * D + c0) = (v2u){pg8::cvt_pk_bf16(o0, o1), pg8::cvt_pk_bf16(o2, o3)}; }
        cur = nx;
    }
#undef POST_LOAD
    __syncthreads();
}
__device__ __forceinline__ void ph_sb_attn_naive(Frame& F) {
    const bf16_t* P = (const bf16_t*)(F.ws + WS_PROJ);
    bf16_t* YC = (bf16_t*)(F.ws + WS_YCAT);
    LAS float* qs = (LAS float*)F.lds + F.wave * 256;
    LAS float* as = qs + 128;
    const int gw = F.bid * NWAVES + F.wave, NGW = F.G * NWAVES, lane = F.lane;
    const float scale = 0.08838834764831845f;
    for (int it = gw; it < T * SBH; it += NGW) {
        const int t = it >> 2, hh = it & 3, b = t / SEQ, tl = t % SEQ;
        const bf16_t* qp = P + (size_t)t * PLD + COL_SBQ + hh * SBD;
        wave_lds_sync();
        qs[lane] = bf2f(qp[lane]); qs[64 + lane] = bf2f(qp[64 + lane]);
        wave_lds_sync();
        float o0 = 0.f, o1 = 0.f, carry = 0.f;
        const int nkb = (tl + 63) >> 6;
        for (int kb = nkb - 1; kb >= 0; --kb) {
            const int s = kb * 64 + lane; const bool valid = s < tl;
            float z = 0.f;
            if (valid) {
                const bf16_t* kp = P + (size_t)(b * SEQ + s) * PLD + COL_SBK + hh * SBD;
#pragma unroll 4
                for (int d = 0; d < SBD; d += 8) { const v4u kv = *(const v4u*)(kp + d); const f32x4 q0 = *(const LAS f32x4*)(qs + d), q1 = *(const LAS f32x4*)(qs + d + 4);
                    z += q0.x * bflo(kv.x) + q0.y * bfhi(kv.x) + q0.z * bflo(kv.y) + q0.w * bfhi(kv.y) + q1.x * bflo(kv.z) + q1.y * bfhi(kv.z) + q1.z * bflo(kv.w) + q1.w * bfhi(kv.w); }
            }
            z *= scale;
            const float sp = softplusf(z);
            const float lk = valid ? -sp : 0.f;
            float x = lk;
#pragma unroll
            for (int o = 1; o < 64; o <<= 1) { const float y = __shfl_down(x, o); if (lane + o < 64) x += y; }
            const float excl = x - lk;
            const float attn = valid ? expf(z - sp + carry + excl) : 0.f;
            carry += __shfl(x, 0);
            wave_lds_sync();
            as[lane] = attn;
            wave_lds_sync();
            const bf16_t* vp = P + (size_t)(b * SEQ + kb * 64) * PLD + COL_SBV + hh * SBD + 2 * lane;
            const int nv = min(64, tl - kb * 64);
            for (int j = 0; j < nv; ++j) { const float a = as[j]; const unsigned vv = *(const unsigned*)(vp + (size_t)j * PLD); o0 += a * bflo(vv); o1 += a * bfhi(vv); }
        }
        *(unsigned*)(YC + (size_t)t * D + C + hh * SBD + 2 * lane) = pk2(o0, o1);
    }
}
__device__ __forceinline__ void vt_tile(const bf16_t* src, int ld, bf16_t* dst, int dld, LAS bf16_t* tl, int lane) {
    constexpr int RS = 136;
#pragma unroll 4
    for (int i = 0; i < 16; ++i) { const int row = i * 4 + (lane >> 4), ch = lane & 15;
        *(LAS v4u*)(tl + row * RS + ch * 8) = *(const v4u*)(src + (size_t)row * ld + ch * 8); }
    wave_lds_sync();
#pragma unroll 4
    for (int it = 0; it < 16; ++it) { const int o = it * 64 + lane, d = o >> 3, ch = o & 7, sgrp = ch >> 2, fqq = ch & 3;
        const LAS bf16_t* c0 = tl + (32 * sgrp + 4 * fqq) * RS + d;
        v4u w;
        w.x = (unsigned)c0[0 * RS] | ((unsigned)c0[1 * RS] << 16); w.y = (unsigned)c0[2 * RS] | ((unsigned)c0[3 * RS] << 16);
        w.z = (unsigned)c0[16 * RS] | ((unsigned)c0[17 * RS] << 16); w.w = (unsigned)c0[18 * RS] | ((unsigned)c0[19 * RS] << 16);
        *(v4u*)(dst + (size_t)d * dld + 8 * ch) = w; }
    wave_lds_sync();
}
__device__ __forceinline__ void ph_vt(Frame& F) {
    const bf16_t* P = (const bf16_t*)(F.ws + WS_PROJ);
    const bf16_t* MKV = (const bf16_t*)(F.ws + WS_MEMKV);
    bf16_t* VTSB = (bf16_t*)(F.ws + WS_VTSB);
    bf16_t* VTMEM = (bf16_t*)(F.ws + WS_VTMEM);
    LAS bf16_t* tl = (LAS bf16_t*)(F.lds + F.wave * 17408);
    const int gw = F.bid * NWAVES + F.wave, NGW = F.G * NWAVES;
    constexpr int N_SB = BATCH * SBH * (SEQ / 64), N_MEM = BATCH * MEMH * (MEML / 64);
    for (int it = gw; it < N_SB + N_MEM; it += NGW) {
        if (it < N_SB) { const int kt = it % (SEQ / 64), bh = it / (SEQ / 64), b = bh / SBH, h = bh % SBH;
            vt_tile(P + (size_t)(b * SEQ + kt * 64) * PLD + COL_SBV + h * SBD, PLD, VTSB + (size_t)bh * SBD * SEQ + kt * 64, SEQ, tl, F.lane); }
        else { const int j = it - N_SB, kt = j % (MEML / 64), bh = j / (MEML / 64), b = bh / MEMH, h = bh % MEMH;
            vt_tile(MKV + (size_t)(b * MEML + kt * 64) * (2 * MEMW) + MEMW + h * MEMD, 2 * MEMW, VTMEM + (size_t)bh * MEMD * MEML + kt * 64, MEML, tl, F.lane); }
    }
    __syncthreads();
}
__device__ __forceinline__ void sb_item(Frame& F, const int b, const int h, const int jq, bf16_t* OUT, const int old_, const int ocol) {
    using pg8::bf16x8; using pg8::lds_byte;
    typedef float f4 __attribute__((ext_vector_type(4)));
    const bf16_t* P = (const bf16_t*)(F.ws + WS_PROJ);
    const bf16_t* VT = (const bf16_t*)(F.ws + WS_VTSB) + (size_t)(b * SBH + h) * SBD * SEQ;
    LAS unsigned char* lds = F.lds;
    const int tid = F.tid, lane = F.lane, wave = F.wave, hf = wave >> 2, qg = wave & 3, fr = lane & 15, fq = lane >> 4, ht = tid & 255;
    const int nt = jq + 1, nh = (nt + 1) >> 1, nl = nt - nh;
    const int my_n = hf ? nl : nh, kt0 = hf ? (jq - nh) : jq;
    const float scale = 0.08838834764831845f * 1.4426950408889634f;
    const bf16_t* kbase = P + (size_t)(b * SEQ) * PLD + COL_SBK + h * SBD;
    int kwoff[4], vwoff[4]; size_t ksrc[4], vsrc[4];
#pragma unroll
    for (int i = 0; i < 4; ++i) { const int pp = ht + 256 * i, r = pp >> 4, c = pp & 15;
        kwoff[i] = (c >> 3) * 8192 + lds_byte(r, (c & 7) * 8); ksrc[i] = (size_t)r * PLD + 8 * c;
        const int d = pp >> 3, c2 = pp & 7;
        vwoff[i] = lds_byte(d, 8 * c2); vsrc[i] = (size_t)d * SEQ + 8 * c2; }
    const int fbase = lds_byte(fr, 8 * fq);
    bf16x8 qf[4];
    { const bf16_t* qp = P + (size_t)(b * SEQ + 64 * jq + 16 * qg + fr) * PLD + COL_SBQ + h * SBD + 8 * fq;
#pragma unroll
      for (int kk = 0; kk < 4; ++kk) qf[kk] = *(const bf16x8*)(qp + 32 * kk); }
    f4 acc_o[8];
#pragma unroll
    for (int i = 0; i < 8; ++i) acc_o[i] = (f4){0.f, 0.f, 0.f, 0.f};
    float carry = 0.f;
    v4u rk[4], rv[4];
#define SB_LOAD(stp) do { const int _kt = kt0 - (stp); _Pragma("unroll") for (int i = 0; i < 4; ++i) { rk[i] = *(const v4u*)(kbase + (size_t)_kt * 64 * PLD + ksrc[i]); rv[i] = *(const v4u*)(VT + (size_t)_kt * 64 + vsrc[i]); } } while (0)
#define SB_WRITE(stg) do { LAS unsigned char* _b = lds + ((stg) * 2 + hf) * 32768; _Pragma("unroll") for (int i = 0; i < 4; ++i) { *(LAS v4u*)(_b + kwoff[i]) = rk[i]; *(LAS v4u*)(_b + 16384 + vwoff[i]) = rv[i]; } } while (0)
    if (0 < my_n) { SB_LOAD(0); SB_WRITE(0); }
    if (1 < my_n) SB_LOAD(1);
    __syncthreads();
    for (int st = 0; st < nh; ++st) {
        if (st < my_n) {
            const LAS unsigned char* kb = lds + ((st & 1) * 2 + hf) * 32768;
            const LAS unsigned char* vb = kb + 16384;
            f4 sc[4];
#pragma unroll
            for (int i = 0; i < 4; ++i) { sc[i] = (f4){0.f, 0.f, 0.f, 0.f};
#pragma unroll
                for (int kk = 0; kk < 4; ++kk) { const bf16x8 kf = *(const LAS bf16x8*)(kb + fbase + i * 2048 + (kk & 1) * 1024 + (kk >> 1) * 8192);
                    sc[i] = __builtin_amdgcn_mfma_f32_16x16x32_bf16(kf, qf[kk], sc[i], 0, 0, 0); } }
            const bool diag = (hf == 0) && (st == 0);
            float av[4][4], tt[4], xx[4];
#pragma unroll
            for (int i = 0; i < 4; ++i) {
                float lk[4];
#pragma unroll
                for (int r = 0; r < 4; ++r) { float z = sc[i][r] * scale; const float e = __builtin_amdgcn_exp2f(-fabsf(z)); float l = -(fmaxf(z, 0.f) + __builtin_amdgcn_logf(1.f + e));
                    if (diag && !((16 * i + 4 * fq + r) < (16 * qg + fr))) { l = 0.f; z = -1.0e30f; }
                    lk[r] = l; sc[i][r] = z; }
                av[i][3] = lk[3]; av[i][2] = lk[2] + av[i][3]; av[i][1] = lk[1] + av[i][2]; av[i][0] = lk[0] + av[i][1];
                const float tot = av[i][0], u = __shfl_xor(tot, 16), t1 = tot + u, v = __shfl_xor(t1, 32);
                tt[i] = t1 + v; xx[i] = ((fq & 1) ? 0.f : u) + ((fq & 2) ? 0.f : v);
            }
            const float y2 = tt[3], y1 = y2 + tt[2], y0 = y1 + tt[1], total = y0 + tt[0];
            xx[0] += y0 + carry; xx[1] += y1 + carry; xx[2] += y2 + carry; xx[3] += carry;
            carry += total;
            bf16x8 pf[2];
#pragma unroll
            for (int sg2 = 0; sg2 < 2; ++sg2) {
                float pv[8];
#pragma unroll
                for (int a = 0; a < 2; ++a)
#pragma unroll
                    for (int r = 0; r < 4; ++r) pv[4 * a + r] = __builtin_amdgcn_exp2f(sc[2 * sg2 + a][r] + av[2 * sg2 + a][r] + xx[2 * sg2 + a]);
                v4u w; w.x = pg8::cvt_pk_bf16(pv[0], pv[1]); w.y = pg8::cvt_pk_bf16(pv[2], pv[3]); w.z = pg8::cvt_pk_bf16(pv[4], pv[5]); w.w = pg8::cvt_pk_bf16(pv[6], pv[7]);
                pf[sg2] = __builtin_bit_cast(bf16x8, w);
            }
#pragma unroll
            for (int ds = 0; ds < 8; ++ds)
#pragma unroll
                for (int sg2 = 0; sg2 < 2; ++sg2) { const bf16x8 vf = *(const LAS bf16x8*)(vb + fbase + ds * 2048 + sg2 * 1024);
                    acc_o[ds] = __builtin_amdgcn_mfma_f32_16x16x32_bf16(vf, pf[sg2], acc_o[ds], 0, 0, 0); }
        }
        if (st + 1 < my_n) SB_WRITE((st + 1) & 1);
        if (st + 2 < my_n) SB_LOAD(st + 2);
        __syncthreads();
    }
#undef SB_LOAD
#undef SB_WRITE
    LAS float* xb = (LAS float*)lds + qg * 2048;
    if (hf) {
#pragma unroll
        for (int ds = 0; ds < 8; ++ds)
#pragma unroll
            for (int r = 0; r < 4; ++r) xb[(ds * 4 + r) * 64 + lane] = acc_o[ds][r];
    }
    __syncthreads();
    if (!hf) {
        const float ec = __builtin_amdgcn_exp2f(carry);
        bf16_t* op = OUT + (size_t)(b * SEQ + 64 * jq + 16 * qg + fr) * old_ + ocol + h * SBD + 4 * fq;
#pragma unroll
        for (int ds = 0; ds < 8; ++ds) { float o[4];
#pragma unroll
            for (int r = 0; r < 4; ++r) o[r] = acc_o[ds][r] + ec * xb[(ds * 4 + r) * 64 + lane];
            *(v2u*)(op + 16 * ds) = (v2u){pg8::cvt_pk_bf16(o[0], o[1]), pg8::cvt_pk_bf16(o[2], o[3])}; }
    }
    __syncthreads();
}
#if DBG
__device__ __forceinline__ void dbg_max(Frame& F, int slot, float v) { if (v > 0.f) atomicMax(F.ctl + CW_DBG + slot, __builtin_bit_cast(unsigned, v)); }
__device__ __forceinline__ void ph_dbg_check(Frame& F) {
    const bf16_t* P = (const bf16_t*)(F.ws + WS_PROJ);
    const bf16_t* VTSB = (const bf16_t*)(F.ws + WS_VTSB);
    const bf16_t* YC = (const bf16_t*)(F.ws + WS_YCAT);
    const bf16_t* DB = (const bf16_t*)(F.ws + WS_DBG);
    const size_t gt = (size_t)F.bid * NT + F.tid, GT = (size_t)F.G * NT;
    float ea = 0.f;
    for (size_t i = gt; i < (size_t)BATCH * SBH * SBD * SEQ; i += GT) {
        const int pos = (int)(i % SEQ), d = (int)((i / SEQ) % SBD), bh = (int)(i / ((size_t)SEQ * SBD)), b = bh / SBH, h = bh % SBH;
        const int s32 = pos >> 5, q = pos & 31, fqq = q >> 3, a = (q >> 2) & 1, r = q & 3, key = 32 * s32 + 16 * a + 4 * fqq + r;
        const float e = fabsf(bf2f(VTSB[i]) - bf2f(P[(size_t)(b * SEQ + key) * PLD + COL_SBV + h * SBD + d]));
        ea = fmaxf(ea, e);
    }
    dbg_max(F, 0, ea);
    float eb = 0.f, ec = 0.f, ed = 0.f, ee = 0.f;
    for (size_t i = gt; i < (size_t)T * SBW; i += GT) {
        const int t = (int)(i / SBW), c = (int)(i % SBW), jq = (t % SEQ) >> 6;
        const float e = fabsf(bf2f(DB[i]) - bf2f(YC[(size_t)t * D + C + c]));
        if (jq == 0) eb = fmaxf(eb, e); else if (jq == 1) ec = fmaxf(ec, e); else if (jq < 4) ed = fmaxf(ed, e); else ee = fmaxf(ee, e);
    }
    dbg_max(F, 1, eb); dbg_max(F, 2, ec); dbg_max(F, 3, ed); dbg_max(F, 4, ee);
}
#endif
__device__ __forceinline__ void mem_item(Frame& F, const int it) {
    using pg8::bf16x8; using pg8::lds_byte;
    typedef float f4 __attribute__((ext_vector_type(4)));
    const bf16_t* P = (const bf16_t*)(F.ws + WS_PROJ);
    const bf16_t* MKV = (const bf16_t*)(F.ws + WS_MEMKV);
    const bf16_t* VTM = (const bf16_t*)(F.ws + WS_VTMEM);
    bf16_t* YC = (bf16_t*)(F.ws + WS_YCAT);
    LAS unsigned char* lds = F.lds;
    const int tid = F.tid, lane = F.lane, wave = F.wave, fr = lane & 15, fq = lane >> 4;
    const float scale = 0.08838834764831845f;
    const int fbase = lds_byte(fr, 8 * fq);
    {
        const int qt = it & 15, bh = it >> 4, b = bh / MEMH, h = bh % MEMH;
        __syncthreads();
#pragma unroll
        for (int t = 0; t < 4; ++t)
#pragma unroll
            for (int i = 0; i < 2; ++i) { const int pp = tid + 512 * i, r = pp >> 4, c = pp & 15, d = pp >> 3, c2 = pp & 7;
                const v4u kv = *(const v4u*)(MKV + (size_t)(b * MEML + 64 * t + r) * (2 * MEMW) + h * MEMD + 8 * c);
                const v4u vv = *(const v4u*)(VTM + ((size_t)bh * MEMD + d) * MEML + 64 * t + 8 * c2);
                *(LAS v4u*)(lds + t * 16384 + (c >> 3) * 8192 + lds_byte(r, (c & 7) * 8)) = kv;
                *(LAS v4u*)(lds + 65536 + t * 16384 + lds_byte(d, 8 * c2)) = vv; }
        bf16x8 qf[4];
        const int q = b * SEQ + 128 * qt + 16 * wave + fr;
        { const bf16_t* qp = P + (size_t)q * PLD + COL_QM + h * MEMD + 8 * fq;
#pragma unroll
          for (int kk = 0; kk < 4; ++kk) qf[kk] = *(const bf16x8*)(qp + 32 * kk); }
        __syncthreads();
        f4 sc[16];
#pragma unroll
        for (int ti = 0; ti < 16; ++ti) { sc[ti] = (f4){0.f, 0.f, 0.f, 0.f};
#pragma unroll
            for (int kk = 0; kk < 4; ++kk) { const bf16x8 kf = *(const LAS bf16x8*)(lds + (ti >> 2) * 16384 + fbase + (ti & 3) * 2048 + (kk & 1) * 1024 + (kk >> 1) * 8192);
                sc[ti] = __builtin_amdgcn_mfma_f32_16x16x32_bf16(kf, qf[kk], sc[ti], 0, 0, 0); } }
        float mx = -3.0e38f;
#pragma unroll
        for (int ti = 0; ti < 16; ++ti)
#pragma unroll
            for (int r = 0; r < 4; ++r) { sc[ti][r] *= scale * 1.4426950408889634f; mx = fmaxf(mx, sc[ti][r]); }
        mx = fmaxf(mx, __shfl_xor(mx, 16)); mx = fmaxf(mx, __shfl_xor(mx, 32));
        float sum = 0.f;
#pragma unroll
        for (int ti = 0; ti < 16; ++ti)
#pragma unroll
            for (int r = 0; r < 4; ++r) { sc[ti][r] = __builtin_amdgcn_exp2f(sc[ti][r] - mx); sum += sc[ti][r]; }
        sum += __shfl_xor(sum, 16); sum += __shfl_xor(sum, 32);
        const float inv = 1.f / sum;
        f4 acc_o[8];
#pragma unroll
        for (int ds = 0; ds < 8; ++ds) acc_o[ds] = (f4){0.f, 0.f, 0.f, 0.f};
#pragma unroll
        for (int ks = 0; ks < 8; ++ks) {
            v4u w; w.x = pg8::cvt_pk_bf16(sc[2 * ks][0], sc[2 * ks][1]); w.y = pg8::cvt_pk_bf16(sc[2 * ks][2], sc[2 * ks][3]);
            w.z = pg8::cvt_pk_bf16(sc[2 * ks + 1][0], sc[2 * ks + 1][1]); w.w = pg8::cvt_pk_bf16(sc[2 * ks + 1][2], sc[2 * ks + 1][3]);
            const bf16x8 pf = __builtin_bit_cast(bf16x8, w);
#pragma unroll
            for (int ds = 0; ds < 8; ++ds) { const bf16x8 vf = *(const LAS bf16x8*)(lds + 65536 + (ks >> 1) * 16384 + fbase + ds * 2048 + (ks & 1) * 1024);
                acc_o[ds] = __builtin_amdgcn_mfma_f32_16x16x32_bf16(vf, pf, acc_o[ds], 0, 0, 0); }
        }
        bf16_t* op = YC + (size_t)q * D + C + SBW + h * MEMD + 4 * fq;
#pragma unroll
        for (int ds = 0; ds < 8; ++ds)
            *(v2u*)(op + 16 * ds) = (v2u){pg8::cvt_pk_bf16(acc_o[ds][0] * inv, acc_o[ds][1] * inv), pg8::cvt_pk_bf16(acc_o[ds][2] * inv, acc_o[ds][3] * inv)};
    }
    __syncthreads();
}
__device__ __forceinline__ void sb128_item(Frame& F, const int b, const int h, const int jt) {
    using pg8::bf16x8; using pg8::lds_byte;
    typedef float f4 __attribute__((ext_vector_type(4)));
    const bf16_t* P = (const bf16_t*)(F.ws + WS_PROJ);
    const bf16_t* VT = (const bf16_t*)(F.ws + WS_VTSB) + (size_t)(b * SBH + h) * SBD * SEQ;
    bf16_t* YC = (bf16_t*)(F.ws + WS_YCAT);
    LAS unsigned char* lds = F.lds;
    volatile LAS float* cmax = (volatile LAS float*)(lds + 65536);
    const int tid = F.tid, lane = F.lane, wave = F.wave, fr = lane & 15, fq = lane >> 4;
    const float scale = 0.08838834764831845f * 1.4426950408889634f;
    const bf16_t* kbase = P + (size_t)(b * SEQ) * PLD + COL_SBK + h * SBD;
    int kwoff[2], vwoff[2]; size_t ksrc[2], vsrc[2];
#pragma unroll
    for (int i = 0; i < 2; ++i) { const int pp = tid + 512 * i, r = pp >> 4, c = pp & 15;
        kwoff[i] = (c >> 3) * 8192 + lds_byte(r, (c & 7) * 8); ksrc[i] = (size_t)r * PLD + 8 * c;
        const int d = pp >> 3, c2 = pp & 7;
        vwoff[i] = lds_byte(d, 8 * c2); vsrc[i] = (size_t)d * SEQ + 8 * c2; }
    const int fbase = lds_byte(fr, 8 * fq);
    bf16x8 qf[4];
    { const bf16_t* qp = P + (size_t)(b * SEQ + 128 * jt + 16 * wave + fr) * PLD + COL_SBQ + h * SBD + 8 * fq;
#pragma unroll
      for (int kk = 0; kk < 4; ++kk) qf[kk] = *(const bf16x8*)(qp + 32 * kk); }
    f4 acc_o[8];
#pragma unroll
    for (int i = 0; i < 8; ++i) acc_o[i] = (f4){0.f, 0.f, 0.f, 0.f};
    float carry = 0.f;
    v4u rk[2], rv[2];
    const int ktop = 2 * jt + 1;
#define S8_LOAD(kt_) do { const int _kt = (kt_) > 0 ? (kt_) : 0; _Pragma("unroll") for (int i = 0; i < 2; ++i) { rk[i] = *(const v4u*)(kbase + (size_t)_kt * 64 * PLD + ksrc[i]); rv[i] = *(const v4u*)(VT + (size_t)_kt * 64 + vsrc[i]); } } while (0)
#define S8_WRITE(stg) do { LAS unsigned char* _b = lds + (stg) * 32768; _Pragma("unroll") for (int i = 0; i < 2; ++i) { *(LAS v4u*)(_b + kwoff[i]) = rk[i]; *(LAS v4u*)(_b + 16384 + vwoff[i]) = rv[i]; } } while (0)
    __syncthreads();
    S8_LOAD(ktop); S8_WRITE(0); S8_LOAD(ktop - 1);
    __syncthreads();
    for (int st = 0; st <= ktop; ++st) {
        const int kt = ktop - st;
        const int rel = kt - 2 * jt;
        const bool active = !(rel == 1 && wave < 4);
        if (active) {
            const LAS unsigned char* kb = lds + (st & 1) * 32768;
            const LAS unsigned char* vb = kb + 16384;
            f4 sc[4];
#pragma unroll
            for (int i = 0; i < 4; ++i) { sc[i] = (f4){0.f, 0.f, 0.f, 0.f};
#pragma unroll
                for (int kk = 0; kk < 4; ++kk) { const bf16x8 kf = *(const LAS bf16x8*)(kb + fbase + i * 2048 + (kk & 1) * 1024 + (kk >> 1) * 8192);
                    sc[i] = __builtin_amdgcn_mfma_f32_16x16x32_bf16(kf, qf[kk], sc[i], 0, 0, 0); } }
            const bool diag = rel >= 0;
            float av[4][4], tt[4], xx[4];
#pragma unroll
            for (int i = 0; i < 4; ++i) {
                float lk[4];
#pragma unroll
                for (int r = 0; r < 4; ++r) { float z = sc[i][r] * scale; const float e = __builtin_amdgcn_exp2f(-fabsf(z)); float l = -(fmaxf(z, 0.f) + __builtin_amdgcn_logf(1.f + e));
                    if (diag && !((64 * rel + 16 * i + 4 * fq + r) < (16 * wave + fr))) { l = 0.f; z = -1.0e30f; }
                    lk[r] = l; sc[i][r] = z; }
                av[i][3] = lk[3]; av[i][2] = lk[2] + av[i][3]; av[i][1] = lk[1] + av[i][2]; av[i][0] = lk[0] + av[i][1];
                const float tot = av[i][0], u = __shfl_xor(tot, 16), t1 = tot + u, v = __shfl_xor(t1, 32);
                tt[i] = t1 + v; xx[i] = ((fq & 1) ? 0.f : u) + ((fq & 2) ? 0.f : v);
            }
            const float y2 = tt[3], y1 = y2 + tt[2], y0 = y1 + tt[1], total = y0 + tt[0];
            xx[0] += y0 + carry; xx[1] += y1 + carry; xx[2] += y2 + carry; xx[3] += carry;
            carry += total;
            bf16x8 pf[2];
#pragma unroll
            for (int sg2 = 0; sg2 < 2; ++sg2) {
                float pv[8];
#pragma unroll
                for (int a = 0; a < 2; ++a)
#pragma unroll
                    for (int r = 0; r < 4; ++r) pv[4 * a + r] = __builtin_amdgcn_exp2f(sc[2 * sg2 + a][r] + av[2 * sg2 + a][r] + xx[2 * sg2 + a]);
                v4u w; w.x = pg8::cvt_pk_bf16(pv[0], pv[1]); w.y = pg8::cvt_pk_bf16(pv[2], pv[3]); w.z = pg8::cvt_pk_bf16(pv[4], pv[5]); w.w = pg8::cvt_pk_bf16(pv[6], pv[7]);
                pf[sg2] = __builtin_bit_cast(bf16x8, w);
            }
#pragma unroll
            for (int ds = 0; ds < 8; ++ds)
#pragma unroll
                for (int sg2 = 0; sg2 < 2; ++sg2) { const bf16x8 vf = *(const LAS bf16x8*)(vb + fbase + ds * 2048 + sg2 * 1024);
                    acc_o[ds] = __builtin_amdgcn_mfma_f32_16x16x32_bf16(vf, pf[sg2], acc_o[ds], 0, 0, 0); }
        }
        { float cm = (128 * jt + 16 * wave + fr == 0) ? -1.0e30f : carry;
          cm = wave_max(cm);
          if (lane == 0) cmax[(st & 1) * 8 + wave] = cm; }
        S8_WRITE((st + 1) & 1);
        S8_LOAD(kt - 2);
        __syncthreads();
        float gm = cmax[(st & 1) * 8];
#pragma unroll
        for (int w = 1; w < 8; ++w) gm = fmaxf(gm, cmax[(st & 1) * 8 + w]);
        if (gm <= -140.f) break;
    }
#undef S8_LOAD
#undef S8_WRITE
    bf16_t* op = YC + (size_t)(b * SEQ + 128 * jt + 16 * wave + fr) * D + C + h * SBD + 4 * fq;
#pragma unroll
    for (int ds = 0; ds < 8; ++ds)
        *(v2u*)(op + 16 * ds) = (v2u){pg8::cvt_pk_bf16(acc_o[ds][0], acc_o[ds][1]), pg8::cvt_pk_bf16(acc_o[ds][2], acc_o[ds][3])};
}
__device__ __forceinline__ void ph_mix(Frame& F) {
    for (int bh = F.bid; bh < BATCH * NH; bh += F.G) wkv_carry_bh(F, bh);
    volatile LAS int* qslot = (volatile LAS int*)(F.lds + 139264);
    constexpr int N_SB = BATCH * SBH * 16, N_MEM = BATCH * MEMH * (SEQ / 128);
    int nxt = 0;
    if (F.tid == 0) nxt = (int)atomicAdd(F.ctl + CW_Q, 1u);
    for (;;) {
        __syncthreads();
        if (F.tid == 0) *qslot = nxt;
        __syncthreads();
        const int i = *qslot;
        if (i >= N_SB + N_MEM) break;
        if (F.tid == 0) nxt = (int)atomicAdd(F.ctl + CW_Q, 1u);
        if (i < N_SB) { const int jt = 15 - (i >> 4), bh = i & 15;
            sb128_item(F, bh / SBH, bh % SBH, jt); }
        else mem_item(F, i - N_SB);
    }
    __syncthreads();
}
struct EpiOut {
    static constexpr bool PERM = false, AFTER_DRAIN = false;
    bf16_t* Z; const bf16_t* H;
    __device__ __forceinline__ void operator()(const pg8::f32x4 (&acc)[2][2][4][2], const pg8::Unit& u, int wr, int wc, int fr, int fq) const {
        const int row0 = u.pm * 256 + wr * 64 + fr, col0 = u.pn * 256 + wc * 32 + 4 * fq;
#pragma unroll
        for (int ai = 0; ai < 2; ++ai)
#pragma unroll
            for (int m = 0; m < 4; ++m) { const size_t ro = (size_t)(row0 + ai * 128 + m * 16) * D + col0;
#pragma unroll
                for (int bj = 0; bj < 2; ++bj)
#pragma unroll
                    for (int n = 0; n < 2; ++n) { const v2u hb = *(const v2u*)(H + ro + bj * 128 + n * 16); const f32x4 h = (f32x4){bflo(hb.x), bfhi(hb.x), bflo(hb.y), bfhi(hb.y)}; const f32x4 z = h * ALPHA + acc[ai][bj][m][n]; *(v2u*)(Z + ro + bj * 128 + n * 16) = (v2u){pg8::cvt_pk_bf16(z[0], z[1]), pg8::cvt_pk_bf16(z[2], z[3])}; } }
    }
};
__device__ __forceinline__ void ph_outproj(Frame& F) {
    pg8::Gemm g{(const bf16_t*)(F.ws + WS_YCAT), (const bf16_t*)(F.ws + WS_WOUTT), T, D, D};
    pg8::StaticOrder S; S.init(T, D, F.G, F.bid);
    EpiOut E{(bf16_t*)(F.ws + WS_Z1), (const bf16_t*)(F.ws + WS_HB)};
    pg8::gemm_phase<EpiOut, pg8::StaticOrder, false>(F.lds, g, S, E, nullptr);
    __syncthreads();
}
__device__ __forceinline__ void ph_ln1_router(Frame& F) {
    using pg8::bf16x8;
    typedef float f4 __attribute__((ext_vector_type(4)));
    constexpr int TI = 32, RS2 = 1024 + 8;
    const bf16_t* Z1 = (const bf16_t*)(F.ws + WS_Z1);
    bf16_t* H1B = (bf16_t*)(F.ws + WS_H1B);
    const bf16_t* WR = (const bf16_t*)(F.ws + WS_WRT);
    int* LIST = (int*)(F.ws + WS_LIST);
    float* LISTW = (float*)(F.ws + WS_LISTW);
    LAS bf16_t* Ahi = (LAS bf16_t*)F.lds;
    LAS bf16_t* Alo = Ahi + TI * RS2;
    LAS float* red = (LAS float*)F.lds;
    LAS float* lg = red + 8 * 5 * 2 * 4 * 64;
    const int tid = F.tid, lane = F.lane, wave = F.wave, fr = lane & 15, fq = lane >> 4;
    const float* G1 = F.a->in[I_LN1G]; const float* B1 = F.a->in[I_LN1B];
    for (int item = F.bid; item < T / TI; item += F.G) {
        const int t0 = item * TI;
        __syncthreads();
        bf16x8 wq[2][10];
        const char* wb = (const char*)WR + (size_t)__builtin_amdgcn_readfirstlane(wave) * (4 * 5 * 1024);
        int lz = lane; asm volatile("" : "+v"(lz));
        const unsigned lo16 = (unsigned)lz * 16u;
        const unsigned lo8 = (unsigned)lz * 8u;
        const size_t rowb = (size_t)(t0 + 4 * __builtin_amdgcn_readfirstlane(wave)) * (D * 2);
        const char* zb = (const char*)Z1 + rowb; char* hb = (char*)H1B + rowb;
#define RT_WLOAD(slot, s_) do { _Pragma("unroll") for (int n = 0; n < 5; ++n) { const int co_ = ((32 * ((s_) >> 2) + ((s_) & 3)) * 5 + n) * 1024; \
            wq[slot][2 * n] = *(const bf16x8*)(wb + co_ + lo16); wq[slot][2 * n + 1] = *(const bf16x8*)(wb + 80 * D * 2 + co_ + lo16); } } while (0)
        float mean[4], rstd[4]; v2u zh[4][4];
        {   v2u zc[4][8];
#pragma unroll
            for (int rr = 0; rr < 4; ++rr)
#pragma unroll
                for (int j = 0; j < 8; ++j) zc[rr][j] = *(const v2u*)(zb + rr * (D * 2) + j * 512 + lo8);
#pragma unroll
            for (int rr = 0; rr < 4; ++rr) { float sm = 0.f;
#pragma unroll
                for (int j = 0; j < 8; ++j) sm += (bflo(zc[rr][j].x) + bfhi(zc[rr][j].x)) + (bflo(zc[rr][j].y) + bfhi(zc[rr][j].y));
                mean[rr] = wave_sum(sm) * (1.f / D);
                float s2 = 0.f;
#pragma unroll
                for (int j = 0; j < 8; ++j) { const float a0 = bflo(zc[rr][j].x) - mean[rr], a1 = bfhi(zc[rr][j].x) - mean[rr], a2 = bflo(zc[rr][j].y) - mean[rr], a3 = bfhi(zc[rr][j].y) - mean[rr]; s2 += (a0 * a0 + a1 * a1) + (a2 * a2 + a3 * a3); }
                rstd[rr] = 1.f / sqrtf(wave_sum(s2) * (1.f / D) + LN_EPS);
#pragma unroll
                for (int j = 0; j < 4; ++j) zh[rr][j] = zc[rr][j]; }
        }
        __builtin_amdgcn_sched_barrier(0);
        RT_WLOAD(0, 0); RT_WLOAD(1, 1);
        f4 acc[5][2];
#pragma unroll
        for (int hf = 0; hf < 2; ++hf) {
            if (hf) {
#pragma unroll
                for (int rr = 0; rr < 4; ++rr)
#pragma unroll
                    for (int j = 0; j < 4; ++j) zh[rr][j] = *(const v2u*)(zb + rr * (D * 2) + 2048 + j * 512 + lo8);
                __syncthreads();
            }
#pragma unroll
            for (int j = 0; j < 4; ++j) {
                const f32x4 gg = *(const f32x4*)((const char*)G1 + (4 * hf + j) * 1024 + lo16), bb = *(const f32x4*)((const char*)B1 + (4 * hf + j) * 1024 + lo16);
#pragma unroll
                for (int rr = 0; rr < 4; ++rr) { const int row = 4 * wave + rr; const v2u z = zh[rr][j];
                    const f32x4 v = ((f32x4){bflo(z.x), bfhi(z.x), bflo(z.y), bfhi(z.y)} - mean[rr]) * rstd[rr] * gg + bb;
                    const v2u hi = (v2u){pg8::cvt_pk_bf16(v.x, v.y), pg8::cvt_pk_bf16(v.z, v.w)};
                    const v2u lo = (v2u){pg8::cvt_pk_bf16(v.x - bflo(hi.x), v.y - bfhi(hi.x)), pg8::cvt_pk_bf16(v.z - bflo(hi.y), v.w - bfhi(hi.y))};
                    *(v2u*)(hb + rr * (D * 2) + (4 * hf + j) * 512 + lo8) = hi;
                    *(LAS v2u*)(Ahi + row * RS2 + 4 * (lane + 64 * j)) = hi;
                    *(LAS v2u*)(Alo + row * RS2 + 4 * (lane + 64 * j)) = lo; }
            }
            __syncthreads();
            if (hf == 0) {
#pragma unroll
                for (int n = 0; n < 5; ++n) { acc[n][0] = (f4){0.f, 0.f, 0.f, 0.f}; acc[n][1] = acc[n][0]; } }
#pragma unroll
            for (int ks = 0; ks < 4; ++ks) {
                const int s_ = 4 * hf + ks, k = 128 * wave + 32 * ks + 8 * fq;
                bf16x8 bh[2], bl[2];
#pragma unroll
                for (int tt = 0; tt < 2; ++tt) { bh[tt] = *(const LAS bf16x8*)(Ahi + (16 * tt + fr) * RS2 + k); bl[tt] = *(const LAS bf16x8*)(Alo + (16 * tt + fr) * RS2 + k); }
#pragma unroll
                for (int n = 0; n < 5; ++n) { const bf16x8 wh = wq[s_ & 1][2 * n], wl = wq[s_ & 1][2 * n + 1];
#pragma unroll
                    for (int tt = 0; tt < 2; ++tt) {
                        acc[n][tt] = __builtin_amdgcn_mfma_f32_16x16x32_bf16(wh, bh[tt], acc[n][tt], 0, 0, 0);
                        acc[n][tt] = __builtin_amdgcn_mfma_f32_16x16x32_bf16(wl, bh[tt], acc[n][tt], 0, 0, 0);
                        acc[n][tt] = __builtin_amdgcn_mfma_f32_16x16x32_bf16(wh, bl[tt], acc[n][tt], 0, 0, 0); } }
                __builtin_amdgcn_sched_barrier(0);
                if (s_ + 2 < 8) { if ((s_ & 1) == 0) RT_WLOAD(0, s_ + 2); else RT_WLOAD(1, s_ + 2); }
                __builtin_amdgcn_sched_barrier(0);
            }
        }
#undef RT_WLOAD
        __syncthreads();
#pragma unroll
        for (int n = 0; n < 5; ++n)
#pragma unroll
            for (int tt = 0; tt < 2; ++tt)
#pragma unroll
                for (int r = 0; r < 4; ++r) red[(((wave * 5 + n) * 2 + tt) * 4 + r) * 64 + lane] = acc[n][tt][r];
        __syncthreads();
        for (int idx = tid; idx < 5 * 2 * 4 * 64; idx += NT) {
            const int l = idx & 63, q = idx >> 6, r = q & 3, tt = (q >> 2) & 1, n = q >> 3;
            float sm = 0.f;
#pragma unroll
            for (int w = 0; w < 8; ++w) sm += red[(((w * 5 + n) * 2 + tt) * 4 + r) * 64 + l];
            lg[(16 * tt + (l & 15)) * 80 + 16 * n + 4 * (l >> 4) + r] = sm;
        }
        __syncthreads();
        if (tid < TI) {
            const int t = t0 + tid;
            const LAS float* lp = lg + tid * 80;
            float gl[NG];
            { const f32x4 g0 = *(const f32x4*)(F.a->in[I_RGB]), g1 = *(const f32x4*)(F.a->in[I_RGB] + 4);
              const float gb[NG] = {g0.x, g0.y, g0.z, g0.w, g1.x, g1.y, g1.z, g1.w};
#pragma unroll
              for (int j = 0; j < NG; ++j) gl[j] = lp[j] + gb[j]; }
            int gi = 0; float gm = gl[0];
#pragma unroll
            for (int j = 1; j < NG; ++j) if (gl[j] > gm) { gm = gl[j]; gi = j; }
            float gs = 0.f;
#pragma unroll
            for (int j = 0; j < NG; ++j) gs += expf(gl[j] - gm);
            const float gw_ = 1.f / gs;
            float v0 = -3.0e38f, v1 = -3.0e38f; int i0 = 0, i1 = 0;
            const f32x4 e0 = *(const f32x4*)(F.a->in[I_REB] + gi * EPG), e1v = *(const f32x4*)(F.a->in[I_REB] + gi * EPG + 4);
            const float eb[EPG] = {e0.x, e0.y, e0.z, e0.w, e1v.x, e1v.y, e1v.z, e1v.w};
#pragma unroll
            for (int j = 0; j < EPG; ++j) {
                const float l = lp[NG + gi * EPG + j] + eb[j];
                if (l > v0) { v1 = v0; i1 = i0; v0 = l; i0 = j; } else if (l > v1) { v1 = l; i1 = j; }
            }
            const float e1 = expf(v1 - v0);
            const float w0 = gw_ / (1.f + e1), w1 = gw_ * e1 / (1.f + e1);
            const int ex0 = gi * EPG + i0, ex1 = gi * EPG + i1;
            const unsigned p0 = atomicAdd(F.ctl + CW_CNT + ex0, 1u);
            LIST[ex0 * LISTCAP + p0] = t * 2; LISTW[ex0 * LISTCAP + p0] = w0;
            const unsigned p1 = atomicAdd(F.ctl + CW_CNT + ex1, 1u);
            LIST[ex1 * LISTCAP + p1] = t * 2 + 1; LISTW[ex1 * LISTCAP + p1] = w1;
        }
    }
    __syncthreads();
}
namespace sg {
using pg8::bf16x8; using pg8::lds_byte;
typedef float acc_t __attribute__((ext_vector_type(4)));
constexpr int MT = 5;
constexpr int A_BUF = 4 * MT * 2048, B_BUF = 16384, A_OFF = 0, B_OFF = 2 * A_BUF;

template <class Maker, int LDB>
__device__ __forceinline__ void run_units(LAS unsigned char* lds, const Maker& mk, const int nk, const int nrounds, const int tid) {
    typedef typename Maker::AP AP; typedef typename Maker::BP BP; typedef typename Maker::Epi Epi;
    AP ap; BP bp; Epi ep;
    int r = 0;
    bool has = false;
    while (r < nrounds && !(has = mk(r, ap, bp, ep))) ++r;
    if (!has) return;
    const int wid = __builtin_amdgcn_readfirstlane(tid >> 6), lane = tid & 63, wr = wid >> 1, wc = wid & 1, fr = lane & 15, fq = lane >> 4;
    const int awoff = (tid >> 7) * 2048 + lds_byte((tid >> 3) & 15, 8 * (tid & 7));
    const int kq = tid >> 5, nq = tid & 31;
    const int bwoff0 = lds_byte(bp.rho(4 * nq), 4 * kq);
    const int aoff = wr * 2048 + lds_byte(fr, fq * 8);
    const int boff = lds_byte(wc * 64 + fr, fq * 8);
    unsigned aoffs[MT];
    const bf16_t* abase; const float* bsrc; constexpr size_t ldb = LDB;
#define SG_SETUP(ap_, bp_) do { _Pragma("unroll") for (int i = 0; i < MT; ++i) aoffs[i] = (ap_).row((tid >> 3) + 64 * i) + 8 * (tid & 7); \
        abase = (ap_).base(); bsrc = (bp_).ptr(4 * nq) + (size_t)(4 * kq) * ldb; } while (0)
    SG_SETUP(ap, bp);
    acc_t acc[MT][4];
#pragma unroll
    for (int m = 0; m < MT; ++m)
#pragma unroll
        for (int n = 0; n < 4; ++n) acc[m][n] = (acc_t){0.f, 0.f, 0.f, 0.f};
    v4u ra0[MT]; f32x4 rb0[4], rb1[4];
#define SG_LOADA(ra, kt) do { _Pragma("unroll") for (int i = 0; i < MT; ++i) ra[i] = *(const v4u*)(abase + aoffs[i] + (size_t)(kt) * 64); } while (0)
#define SG_LOADB(rb, kt) do { _Pragma("unroll") for (int j = 0; j < 4; ++j) rb[j] = *(const f32x4*)(bsrc + ((size_t)(kt) * 64 + j) * ldb); } while (0)
#define SG_WRITEA(ra, buf, w5) do { _Pragma("unroll") for (int i = 0; i < MT - 1; ++i) *(LAS v4u*)(lds + A_OFF + (buf) * A_BUF + i * 8192 + awoff) = ra[i]; \
        if (w5) *(LAS v4u*)(lds + A_OFF + (buf) * A_BUF + (MT - 1) * 8192 + awoff) = ra[MT - 1]; } while (0)
#define SG_WRITEB(rb, buf) do { _Pragma("unroll") for (int c = 0; c < 4; ++c) { v2u w; w.x = pg8::cvt_pk_bf16(rb[0][c], rb[1][c]); w.y = pg8::cvt_pk_bf16(rb[2][c], rb[3][c]); \
            *(LAS v2u*)(lds + B_OFF + (buf) * B_BUF + bwoff0 + 64 * c) = w; } } while (0)
#define SG_COMPUTE(buf) do { _Pragma("unroll") for (int k = 0; k < 2; ++k) { bf16x8 bfr[4]; \
        _Pragma("unroll") for (int n = 0; n < 4; ++n) bfr[n] = *(const LAS bf16x8*)(lds + B_OFF + (buf) * B_BUF + boff + n * 2048 + k * 1024); \
        _Pragma("unroll") for (int m = 0; m < MT - 1; ++m) { const bf16x8 af = *(const LAS bf16x8*)(lds + A_OFF + (buf) * A_BUF + aoff + m * 8192 + k * 1024); \
            _Pragma("unroll") for (int n = 0; n < 4; ++n) acc[m][n] = __builtin_amdgcn_mfma_f32_16x16x32_bf16(bfr[n], af, acc[m][n], 0, 0, 0); } \
        if (h5) { const bf16x8 af = *(const LAS bf16x8*)(lds + A_OFF + (buf) * A_BUF + aoff + (MT - 1) * 8192 + k * 1024); \
            _Pragma("unroll") for (int n = 0; n < 4; ++n) acc[MT - 1][n] = __builtin_amdgcn_mfma_f32_16x16x32_bf16(bfr[n], af, acc[MT - 1][n], 0, 0, 0); } \
        __builtin_amdgcn_sched_barrier(0); } } while (0)
#define SG_FLAGS(ap_, w5_, h5_) do { const int nv_ = __builtin_amdgcn_readfirstlane((ap_).nvalid); w5_ = nv_ > 64 * (MT - 1); h5_ = nv_ > 16 * (wr + 4 * (MT - 1)); } while (0)
    bool w5, h5; SG_FLAGS(ap, w5, h5);
    SG_LOADA(ra0, 0); SG_LOADB(rb0, 0); SG_LOADB(rb1, 1);
    SG_WRITEA(ra0, 0, w5); SG_WRITEB(rb0, 0);
    SG_LOADA(ra0, 1);
    __syncthreads();
    for (;;) {
        int kt = 0;
        for (; kt + 4 < nk; kt += 2) {
            SG_LOADB(rb0, kt + 2); SG_COMPUTE(0); SG_WRITEA(ra0, 1, w5); SG_WRITEB(rb1, 1); SG_LOADA(ra0, kt + 2); __syncthreads();
            SG_LOADB(rb1, kt + 3); SG_COMPUTE(1); SG_WRITEA(ra0, 0, w5); SG_WRITEB(rb0, 0); SG_LOADA(ra0, kt + 3); __syncthreads();
        }
        SG_LOADB(rb0, kt + 2); SG_COMPUTE(0); SG_WRITEA(ra0, 1, w5); SG_WRITEB(rb1, 1); SG_LOADA(ra0, kt + 2); __syncthreads();
        SG_LOADB(rb1, kt + 3); SG_COMPUTE(1); SG_WRITEA(ra0, 0, w5); SG_WRITEB(rb0, 0); SG_LOADA(ra0, kt + 3); __syncthreads();
        AP apn; BP bpn; Epi epn; int rn = r + 1; bool hasn = false;
        while (rn < nrounds && !(hasn = mk(rn, apn, bpn, epn))) ++rn;
        if (!hasn) { apn = ap; bpn = bp; }
        bool w5n, h5n; SG_FLAGS(apn, w5n, h5n);
        unsigned nrow[MT];
#pragma unroll
        for (int i = 0; i < MT; ++i) nrow[i] = apn.row((tid >> 3) + 64 * i);
        int pe[MT]; float pw[MT];
        { int tz = tid; asm volatile("" : "+v"(tz)); ep.pre(pe, pw, __builtin_amdgcn_readfirstlane(tz >> 7), tz & 15); }
        __builtin_amdgcn_sched_barrier(0);
        SG_COMPUTE(0); SG_WRITEA(ra0, 1, w5); SG_WRITEB(rb1, 1);
        __builtin_amdgcn_sched_barrier(0);
#pragma unroll
        for (int i = 0; i < MT; ++i) aoffs[i] = nrow[i] + 8 * (tid & 7);
        abase = apn.base(); bsrc = bpn.ptr(4 * nq) + (size_t)(4 * kq) * ldb;
        __builtin_amdgcn_sched_barrier(0);
        SG_LOADA(ra0, 0); SG_LOADB(rb0, 0); __syncthreads();
        SG_LOADB(rb1, 1); SG_COMPUTE(1); SG_WRITEA(ra0, 0, w5n); SG_WRITEB(rb0, 0); SG_LOADA(ra0, 1);
        { int tz = tid; asm volatile("" : "+v"(tz));
          const int wz = __builtin_amdgcn_readfirstlane(tz >> 6), lz = tz & 63;
          ep.fin(acc, pe, pw, wz >> 1, wz & 1, lz & 15, lz >> 4); }
        __syncthreads();
        if (!hasn) break;
#pragma unroll
        for (int m = 0; m < MT; ++m)
#pragma unroll
            for (int n = 0; n < 4; ++n) acc[m][n] = (acc_t){0.f, 0.f, 0.f, 0.f};
        ap = apn; bp = bpn; ep = epn; r = rn; w5 = w5n; h5 = h5n;
    }
#undef SG_FLAGS
#undef SG_SETUP
#undef SG_LOADA
#undef SG_LOADB
#undef SG_WRITEA
#undef SG_WRITEB
#undef SG_COMPUTE
}
}

constexpr int MT_ROWS = 64 * sg::MT;
__device__ __forceinline__ void moe_build_tab(Frame& F, LAS int* tab) {
    __syncthreads();
    if (F.wave == 0) {
        const int e = F.lane, n = (int)F.ctl[CW_CNT + e], ns = (n + MT_ROWS - 1) / MT_ROWS;
        int off = n, so = ns;
#pragma unroll
        for (int d = 1; d < 64; d <<= 1) { const int a = __shfl_up(off, d), b = __shfl_up(so, d); if (e >= d) { off += a; so += b; } }
        tab[e] = n; tab[NE + e] = off - n;
        for (int mt = 0; mt < ns; ++mt) tab[129 + so - ns + mt] = e | (mt << 8);
        if (e == 63) tab[128] = so;
    }
    __syncthreads();
}
__device__ __forceinline__ bool moe_unit(const int G, const int bid, const LAS int* tab, int r, int& e, int& mt, int& nt) {
    int slot;
    if (G == 256) { const int x = bid & 7, j = bid >> 3; slot = r * 16 + (j >> 4) * 8 + x; nt = j & 15; }
    else { const int u = r * G + bid; slot = u >> 4; nt = u & 15; }
    if (slot >= tab[128]) return false;
    const int sv = tab[129 + slot]; e = sv & 255; mt = sv >> 8; return true;
}
struct APGather { const bf16_t* X; const int* list; int nvalid;
    __device__ __forceinline__ const bf16_t* base() const { return X; }
    __device__ __forceinline__ unsigned row(int r) const { const int rr = r < nvalid ? r : nvalid - 1; return (unsigned)(list[rr] >> 1) * (unsigned)D; } };
struct APPlain { const bf16_t* X; int ld; int nvalid;
    __device__ __forceinline__ const bf16_t* base() const { return X; }
    __device__ __forceinline__ unsigned row(int r) const { const int rr = r < nvalid ? r : nvalid - 1; return (unsigned)rr * (unsigned)ld; } };
struct BPUp { const float* Wg; const float* Wu; int ldb;
    __device__ __forceinline__ const float* ptr(int nu4) const { return nu4 < 64 ? Wg + nu4 : Wu + (nu4 - 64); }
    __device__ __forceinline__ int rho(int nu) const { const int j = nu & 63, h = nu >> 6; return 64 * (j >> 5) + 32 * h + (j & 31); } };
struct BPDown { const float* W; int ldb;
    __device__ __forceinline__ const float* ptr(int nu4) const { return W + nu4; }
    __device__ __forceinline__ int rho(int nu) const { return nu; } };
struct EpiUp { bf16_t* H; int nvalid;
    __device__ __forceinline__ void pre(int (&)[sg::MT], float (&)[sg::MT], int, int) const {}
    __device__ __forceinline__ void fin(const sg::acc_t (&acc)[sg::MT][4], const int (&)[sg::MT], const float (&)[sg::MT], int wr, int wc, int fr, int fq) const { (*this)(acc, wr, wc, fr, fq); }
    template <int NM> __device__ __forceinline__ void runi(const sg::acc_t (&acc)[sg::MT][4], int wr, int wc, int fr, int fq) const {
#pragma unroll
        for (int m = 0; m < NM; ++m) { const int row = 16 * (wr + 4 * m) + fr;
            if (row < nvalid) {
#pragma unroll
                for (int n = 0; n < 2; ++n) { const sg::acc_t g = acc[m][n], u = acc[m][n + 2]; float h[4];
#pragma unroll
                    for (int j = 0; j < 4; ++j) h[j] = g[j] * __builtin_amdgcn_rcpf(1.f + __expf(-g[j])) * u[j];
                    *(v2u*)(H + (size_t)row * DE + 32 * wc + 16 * n + 4 * fq) = (v2u){pg8::cvt_pk_bf16(h[0], h[1]), pg8::cvt_pk_bf16(h[2], h[3])}; } } }
    }
    __device__ __forceinline__ void operator()(const sg::acc_t (&acc)[sg::MT][4], int wr, int wc, int fr, int fq) const {
#pragma unroll
        for (int m = 0; m < sg::MT; ++m) { const int row = 16 * (wr + 4 * m) + fr;
            if (row < nvalid) {
#pragma unroll
                for (int n = 0; n < 2; ++n) { const sg::acc_t g = acc[m][n], u = acc[m][n + 2]; float h[4];
#pragma unroll
                    for (int j = 0; j < 4; ++j) h[j] = g[j] * __builtin_amdgcn_rcpf(1.f + __expf(-g[j])) * u[j];
                    *(v2u*)(H + (size_t)row * DE + 32 * wc + 16 * n + 4 * fq) = (v2u){pg8::cvt_pk_bf16(h[0], h[1]), pg8::cvt_pk_bf16(h[2], h[3])}; } } }
    }
};
struct EpiDown { bf16_t* YS; const int* list; const float* lw; int nvalid, n0;
    template <int NM> __device__ __forceinline__ void runi(const sg::acc_t (&acc)[sg::MT][4], int wr, int wc, int fr, int fq) const {
#pragma unroll
        for (int m = 0; m < NM; ++m) { const int row = 16 * (wr + 4 * m) + fr;
            if (row < nvalid) { const int e = list[row]; const float w = lw[row]; bf16_t* dst = YS + (size_t)e * D + n0 + 64 * wc + 4 * fq;
#pragma unroll
                for (int n = 0; n < 4; ++n) *(v2u*)(dst + 16 * n) = (v2u){pg8::cvt_pk_bf16(acc[m][n][0] * w, acc[m][n][1] * w), pg8::cvt_pk_bf16(acc[m][n][2] * w, acc[m][n][3] * w)}; } }
    }
    __device__ __forceinline__ void pre(int (&pe)[sg::MT], float (&pw)[sg::MT], int wr, int fr) const {
#pragma unroll
        for (int m = 0; m < sg::MT; ++m) { const int row = 16 * (wr + 4 * m) + fr, rr = row < nvalid ? row : nvalid - 1; pe[m] = list[rr]; pw[m] = lw[rr]; } }
    __device__ __forceinline__ void fin(const sg::acc_t (&acc)[sg::MT][4], const int (&pe)[sg::MT], const float (&pw)[sg::MT], int wr, int wc, int fr, int fq) const {
#pragma unroll
        for (int m = 0; m < sg::MT; ++m) { const int row = 16 * (wr + 4 * m) + fr;
            if (row < nvalid) { const float w = pw[m]; bf16_t* dst = YS + (size_t)pe[m] * D + n0 + 64 * wc + 4 * fq;
#pragma unroll
                for (int n = 0; n < 4; ++n) *(v2u*)(dst + 16 * n) = (v2u){pg8::cvt_pk_bf16(acc[m][n][0] * w, acc[m][n][1] * w), pg8::cvt_pk_bf16(acc[m][n][2] * w, acc[m][n][3] * w)}; } } }
    __device__ __forceinline__ void operator()(const sg::acc_t (&acc)[sg::MT][4], int wr, int wc, int fr, int fq) const {
#pragma unroll
        for (int m = 0; m < sg::MT; ++m) { const int row = 16 * (wr + 4 * m) + fr;
            if (row < nvalid) { const int e = list[row]; const float w = lw[row]; bf16_t* dst = YS + (size_t)e * D + n0 + 64 * wc + 4 * fq;
#pragma unroll
                for (int n = 0; n < 4; ++n) *(v2u*)(dst + 16 * n) = (v2u){pg8::cvt_pk_bf16(acc[m][n][0] * w, acc[m][n][1] * w), pg8::cvt_pk_bf16(acc[m][n][2] * w, acc[m][n][3] * w)}; } }
    }
};
struct MakerUp { typedef APGather AP; typedef BPUp BP; typedef EpiUp Epi;
    const LAS int* tab; int G, bid; const bf16_t* H1B; const int* LIST; bf16_t* HID; const float* WEG; const float* WEU;
    __device__ __forceinline__ bool operator()(int r, AP& ap, BP& bp, Epi& ep) const {
        int e, mt, nt; if (!moe_unit(G, bid, tab, r, e, mt, nt)) return false;
        const int cnt = tab[e], off = tab[NE + e], nvalid = min(MT_ROWS, cnt - mt * MT_ROWS), n0 = nt * 64;
        ap = AP{H1B, LIST + e * LISTCAP + mt * MT_ROWS, nvalid};
        bp = BP{WEG + (size_t)e * D * DE + n0, WEU + (size_t)e * D * DE + n0, DE};
        ep = Epi{HID + (size_t)(off + mt * MT_ROWS) * DE + n0, nvalid};
        return true; } };
__device__ __forceinline__ void ph_moe_up(Frame& F) {
    LAS int* tab = (LAS int*)(F.lds + 131072);
    moe_build_tab(F, tab);
    const MakerUp mk{tab, F.G, F.bid, (const bf16_t*)(F.ws + WS_H1B), (const int*)(F.ws + WS_LIST), (bf16_t*)(F.ws + WS_HID), F.a->in[I_WEG], F.a->in[I_WEU]};
    sg::run_units<MakerUp, DE>(F.lds, mk, D / 64, (tab[128] * 16 + F.G - 1) / F.G + 1, F.tid);
    __syncthreads();
}
struct MakerDown { typedef APPlain AP; typedef BPDown BP; typedef EpiDown Epi;
    const LAS int* tab; int G, bid; const bf16_t* HID; const int* LIST; const float* LISTW; bf16_t* YS; const float* WED;
    __device__ __forceinline__ bool operator()(int r, AP& ap, BP& bp, Epi& ep) const {
        int e, mt, nt; if (!moe_unit(G, bid, tab, r, e, mt, nt)) return false;
        const int cnt = tab[e], off = tab[NE + e], nvalid = min(MT_ROWS, cnt - mt * MT_ROWS), n0 = nt * 128;
        ap = AP{HID + (size_t)(off + mt * MT_ROWS) * DE, DE, nvalid};
        bp = BP{WED + (size_t)e * DE * D + n0, D};
        ep = Epi{YS, LIST + e * LISTCAP + mt * MT_ROWS, LISTW + e * LISTCAP + mt * MT_ROWS, nvalid, n0};
        return true; } };
__device__ __forceinline__ void ph_moe_down(Frame& F) {
    LAS int* tab = (LAS int*)(F.lds + 131072);
    moe_build_tab(F, tab);
    const MakerDown mk{tab, F.G, F.bid, (const bf16_t*)(F.ws + WS_HID), (const int*)(F.ws + WS_LIST), (const float*)(F.ws + WS_LISTW), (bf16_t*)(F.ws + WS_YS), F.a->in[I_WED]};
    sg::run_units<MakerDown, D>(F.lds, mk, DE / 64, (tab[128] * 16 + F.G - 1) / F.G + 1, F.tid);
    __syncthreads();
}
__device__ __forceinline__ void ph_ln2(Frame& F) {
    const bf16_t* H1B = (const bf16_t*)(F.ws + WS_H1B);
    const bf16_t* YS = (const bf16_t*)(F.ws + WS_YS);
    const int gw = F.bid * NWAVES + F.wave, NGW = F.G * NWAVES;
    v2u hc[8], ac[8], cc[8];
#define LN2_LOAD(row_) do { const v2u* hr_ = (const v2u*)(H1B + (size_t)(row_) * D); const v2u* y0_ = (const v2u*)(YS + (size_t)(row_) * 2 * D); const v2u* y1_ = y0_ + D / 4; \
        _Pragma("unroll") for (int j = 0; j < 8; ++j) { hc[j] = hr_[F.lane + 64 * j]; ac[j] = y0_[F.lane + 64 * j]; cc[j] = y1_[F.lane + 64 * j]; } } while (0)
    { const int r0 = gw < T ? gw : T - 1; LN2_LOAD(r0); }
    for (int row = gw; row < T; row += NGW) {
        f32x4 v[8];
#pragma unroll
        for (int j = 0; j < 8; ++j) { const v2u h = hc[j], a = ac[j], c = cc[j];
            v[j] = (f32x4){bflo(h.x) * ALPHA + (bflo(a.x) + bflo(c.x)), bfhi(h.x) * ALPHA + (bfhi(a.x) + bfhi(c.x)), bflo(h.y) * ALPHA + (bflo(a.y) + bflo(c.y)), bfhi(h.y) * ALPHA + (bfhi(a.y) + bfhi(c.y))}; }
        { const int nr = row + NGW < T ? row + NGW : row; LN2_LOAD(nr); }
        ln_core(v, F.a->in[I_LN2G], F.a->in[I_LN2B], F.out + (size_t)row * D, F.lane);
    }
#undef LN2_LOAD
}

constexpr int N_PHASES = 13;
__global__ void __launch_bounds__(NT, 2) fwd(Args args) {
    extern __shared__ __attribute__((aligned(16))) unsigned char lds[];
    Frame F;
    F.lds = (LAS unsigned char*)lds;
    F.tid = threadIdx.x; F.lane = (int)__builtin_amdgcn_mbcnt_hi(~0u, __builtin_amdgcn_mbcnt_lo(~0u, 0u)); F.wave = __builtin_amdgcn_readfirstlane(F.tid >> 6);
    F.bid = blockIdx.x; F.G = gridDim.x;
    F.ws = args.ws; F.ctl = (unsigned*)(args.ws + WS_CTL); F.out = args.out;
    F.a = &args;
    volatile LAS unsigned* xbw = (volatile LAS unsigned*)(F.lds + LDS_BYTES - 16);
    if (F.tid == 0) { xbw[0] = 0u; xbw[1] = 0u; xbw[2] = 0u; xbw[3] = 0u; }
    __syncthreads();
    const int lo = args.ph_lo, hi = args.ph_hi;
    XcdBarrier bar; bar.bar = F.ctl + CW_BAR; bar.x = 0; bar.st = xbw;
    if (hi - lo > 1) bar = xcd_barrier_post(F.ctl + CW_BAR, xbw);
#define IN(k) (lo <= (k) && (k) < hi)
#define SEAM(k) do { if (IN(k) && IN((k) + 1)) xcd_barrier(bar); } while (0)
    if (IN(0)) { ph_prologue(F); } SEAM(0);
    if (IN(1)) { ph_proj(F); } SEAM(1);
    if (IN(2)) { ph_rwkv_prep(F); ph_vt(F); } SEAM(2);
    if (IN(3)) { ph_wkv_chunk(F); } SEAM(3);
    if (IN(4)) { ph_mix(F); }
    if (IN(5)) { }
    if (IN(6)) { } SEAM(6);
    if (IN(7)) { ph_wkv_post(F); } SEAM(7);
    if (IN(8)) { ph_outproj(F); } SEAM(8);
    if (IN(9)) { ph_ln1_router(F); } SEAM(9);
    if (IN(10)) { ph_moe_up(F); } SEAM(10);
    if (IN(11)) { ph_moe_down(F); } SEAM(11);
    if (IN(12)) { ph_ln2(F); }
#undef IN
#undef SEAM
}

extern "C" void kernel_launch(void* const* d_in, const int* in_sizes, int n_in, void* d_out, int out_size, void* d_ws, size_t ws_size, hipStream_t stream) {
    static int grid = 0;
    if (grid == 0) {
        if (n_in != 29 || out_size != T * D || ws_size < WS_END) { fprintf(stderr, "kernel_launch: unexpected shapes n_in %d out %d ws %zu (need %zu)\n", n_in, out_size, ws_size, (size_t)WS_END); grid = -1; return; }
        int dev = 0, cus = 0;
        if (hipGetDevice(&dev) != hipSuccess || hipDeviceGetAttribute(&cus, hipDeviceAttributeMultiprocessorCount, dev) != hipSuccess) { grid = -1; return; }
        if (hipFuncSetAttribute((const void*)fwd, hipFuncAttributeMaxDynamicSharedMemorySize, LDS_BYTES) != hipSuccess) { fprintf(stderr, "kernel_launch: hipFuncSetAttribute failed\n"); grid = -1; return; }
        int per_cu = 0;
        if (hipOccupancyMaxActiveBlocksPerMultiprocessor(&per_cu, (const void*)fwd, NT, LDS_BYTES) != hipSuccess || per_cu < 1) fprintf(stderr, "kernel_launch: occupancy query says %d\n", per_cu);
        (void)hipGetLastError();
        grid = cus;
    }
    if (grid < 0) return;
    (void)hipMemsetAsync((char*)d_ws + WS_CTL, 0, CTL_ZERO_BYTES, stream);
    Args a{};
    for (int i = 0; i < 29; ++i) a.in[i] = (const float*)d_in[i];
    a.out = (float*)d_out; a.ws = (unsigned char*)d_ws;
#if MK_N_LAUNCHES == 1
    a.ph_lo = 0; a.ph_hi = N_PHASES;
    hipLaunchKernelGGL(fwd, dim3(grid), dim3(NT), LDS_BYTES, stream, a);
#else
    const int cuts[] = {0, 1, 2, 3, 4, 7, 8, 9, 10, 11, 12, 13};
    for (int i = 0; i + 1 < (int)(sizeof(cuts) / sizeof(int)); ++i) {
        a.ph_lo = cuts[i]; a.ph_hi = cuts[i + 1];
        hipLaunchKernelGGL(fwd, dim3(grid), dim3(NT), LDS_BYTES, stream, a);
    }
#endif
    const hipError_t le = hipPeekAtLastError();
    if (le != hipSuccess) fprintf(stderr, "kernel_launch: launch failed: %s\n", hipGetErrorName(le));
}
```

```cpp
#include <hip/hip_runtime.h>
#include <cstdio>
#include <cstdint>

#ifndef DBG
#define DBG 0
#endif
#ifndef MK_N_LAUNCHES
#define MK_N_LAUNCHES 1
#endif

#define LAS __attribute__((address_space(3)))
typedef float f32x4 __attribute__((ext_vector_type(4)));
typedef float f32x2 __attribute__((ext_vector_type(2)));
typedef unsigned short bf16_t;
typedef unsigned v4u __attribute__((ext_vector_type(4)));
typedef unsigned v2u __attribute__((ext_vector_type(2)));

constexpr int BATCH = 4, SEQ = 2048, T = BATCH * SEQ, D = 2048, C = 1024, NH = 16, HD = 64;
constexpr int DR = 64, AR = 64, GR = 160, LOWR = DR + AR + GR;
constexpr int RWKV_COLS = 3 * C + LOWR;
constexpr int SBW = 512, SBH = 4, SBD = 128, MEMW = 512, MEMH = 4, MEMD = 128, MEML = 256;
constexpr int IN_COLS = RWKV_COLS + 3 * SBW + MEMW;
constexpr int PLD = 5632;
constexpr int COL_R = 0, COL_K = C, COL_V = 2 * C, COL_DL = 3 * C, COL_SBQ = RWKV_COLS, COL_SBK = RWKV_COLS + SBW, COL_SBV = RWKV_COLS + 2 * SBW, COL_QM = RWKV_COLS + 3 * SBW;
constexpr int NG = 8, EPG = 8, NE = 64, DE = 1024;
constexpr float ALPHA = 1.18920711500272f;
constexpr float LN_EPS = 1e-5f, GN_EPS = 64e-5f;
constexpr int NT = 512, NWAVES = 8;
constexpr int LISTCAP = 8192;

constexpr size_t MiB = 1u << 20;
constexpr size_t WS_CTL = 0, CTL_ZERO_BYTES = 32768;
constexpr size_t WS_H32 = 2 * MiB;
constexpr size_t WS_HB = WS_H32 + 64 * MiB;
constexpr size_t WS_MEMB = WS_HB + 32 * MiB;
constexpr size_t WS_WINT = WS_MEMB + 4 * MiB;
constexpr size_t WS_WMKVT = WS_WINT + 22 * MiB;
constexpr size_t WS_WOUTT = WS_WMKVT + 4 * MiB;
constexpr size_t WS_PROJ = WS_WOUTT + 8 * MiB;
constexpr size_t WS_MEMKV = WS_PROJ + 88 * MiB;
constexpr size_t WS_PK = WS_MEMKV + 2 * MiB;
constexpr size_t WS_G = WS_PK + 96 * MiB;
constexpr size_t WS_YLOC = WS_G + 16 * MiB;
constexpr size_t WS_QH = WS_YLOC + 32 * MiB;
constexpr size_t WS_WLOWT = WS_QH + 32 * MiB + 48 * MiB;
constexpr size_t WS_WRT = WS_WLOWT + 1 * MiB;
constexpr size_t WS_Y = WS_WLOWT;
constexpr size_t WS_YCAT = WS_Y + 32 * MiB;
constexpr size_t WS_Z1 = WS_YLOC;
constexpr size_t WS_H1 = WS_YCAT + 64 * MiB;
constexpr size_t WS_LIST = WS_H1 + 64 * MiB;
constexpr size_t WS_LISTW = WS_LIST + 2 * MiB;
constexpr size_t WS_H1B_OLD = WS_LISTW + 2 * MiB;
constexpr size_t WS_HID = WS_PROJ;
constexpr size_t WS_YS = WS_PK;
constexpr size_t WS_VTSB = WS_H1B_OLD + 32 * MiB;
constexpr size_t WS_VTMEM = WS_VTSB + 8 * MiB;
constexpr size_t WS_DBG = WS_VTMEM + 2 * MiB;
constexpr int NCH = 32;
constexpr size_t WS_PCH = WS_DBG + 64 * MiB;
constexpr size_t WS_LCH = WS_PCH + 32 * MiB;
constexpr size_t WS_SST = WS_LCH + 32 * MiB;
constexpr size_t WS_H1B = WS_PCH;
constexpr size_t WS_END = WS_SST + 32 * MiB;
constexpr int CW_CNT = 64;
constexpr int CW_Q = 160;
constexpr int CW_Q2 = 161;
constexpr int CW_DBG = 128;
constexpr int CW_BAR = 4096;

constexpr int LDS_BYTES = 147456;

#define XB_TMO      128
#define XB_XCNT(j)  (256  + 64 * (j))
#define XB_XSUB(j)  (1280 + 64 * (j))
#define XB_XGEN(j)  (2304 + 64 * (j))
#define XB_TOP      3328
#define XB_TOPGEN   3392
#define XCD_BAR_WORDS 3456
#define XB_SPIN_CAP (1u << 18)

__device__ __forceinline__ unsigned xb_ld(unsigned* p)              { return __hip_atomic_load(p, __ATOMIC_RELAXED, __HIP_MEMORY_SCOPE_AGENT); }
__device__ __forceinline__ unsigned xb_add(unsigned* p, unsigned v) { return __hip_atomic_fetch_add(p, v, __ATOMIC_RELAXED, __HIP_MEMORY_SCOPE_AGENT); }
__device__ __forceinline__ unsigned xb_xcc_id() { return (unsigned)__builtin_amdgcn_s_getreg((3 << 11) | 20) & 0xFu; }
#define XB_SPIN(cond, bar) do { unsigned _sp = 0; while (cond) { __builtin_amdgcn_s_sleep(1); \
    if ((++_sp & 255u) == 0u) { if (xb_ld(&(bar)[XB_TMO])) break; if (_sp > XB_SPIN_CAP) { atomicAdd(&(bar)[XB_TMO], 1u); break; } } } } while (0)

struct XcdBarrier { unsigned* bar; unsigned x; volatile LAS unsigned* st; };

__device__ __forceinline__ XcdBarrier xcd_barrier_post(unsigned* bar, volatile LAS unsigned* st) {
    XcdBarrier b; b.bar = bar; b.x = xb_xcc_id(); b.st = st;
    if (threadIdx.x == 0) (void)xb_add(&bar[XB_XCNT(b.x)], 1u);
    return b;
}
__device__ __forceinline__ void xcd_barrier_complete(unsigned* bar, unsigned x, unsigned& nloc, unsigned& nx) {
    const unsigned G = gridDim.x * gridDim.y * gridDim.z;
    unsigned sum, cnt, mine, sp = 0u;
    for (;;) {
        sum = 0u; cnt = 0u; mine = 0u;
#pragma unroll
        for (unsigned j = 0; j < 16; ++j) { const unsigned c = xb_ld(&bar[XB_XCNT(j)]); sum += c; cnt += (c > 0u) ? 1u : 0u; mine = (j == x) ? c : mine; }
        if (sum == G) break;
        __builtin_amdgcn_s_sleep(1);
        if ((++sp & 255u) == 0u) { if (xb_ld(&bar[XB_TMO])) break; if (sp > XB_SPIN_CAP) { atomicAdd(&bar[XB_TMO], 1u); break; } }
    }
    nloc = mine > 0u ? mine : 1u; nx = cnt > 0u ? cnt : 1u;
}
__device__ __forceinline__ void xcd_barrier(const XcdBarrier& b) {
    asm volatile("s_waitcnt vmcnt(0)" ::: "memory");
    __syncthreads();
    if (threadIdx.x == 0) {
        unsigned* bar = b.bar;
        __builtin_amdgcn_s_waitcnt(0);
        unsigned nloc = b.st[0], nx = b.st[1];
        if (nloc == 0u) { xcd_barrier_complete(bar, b.x, nloc, nx); b.st[0] = nloc; b.st[1] = nx; }
        const unsigned old = xb_add(&bar[XB_XSUB(b.x)], 1u);
        const unsigned gen = old / nloc;
        if (old + 1u == (gen + 1u) * nloc) {
            __builtin_amdgcn_fence(__ATOMIC_RELEASE, "agent");
            asm volatile("s_waitcnt vmcnt(0)" ::: "memory");
            const unsigned og = xb_add(&bar[XB_TOP], 1u);
            const unsigned tg = og / nx;
            if (og + 1u == (tg + 1u) * nx) xb_add(&bar[XB_TOPGEN], 1u);
            else XB_SPIN(xb_ld(&bar[XB_TOPGEN]) == tg, bar);
            __builtin_amdgcn_fence(__ATOMIC_ACQUIRE, "agent");
            xb_add(&bar[XB_XGEN(b.x)], 1u);
            asm volatile("s_waitcnt vmcnt(0)" ::: "memory");
        } else {
            XB_SPIN(xb_ld(&bar[XB_XGEN(b.x)]) == gen, bar);
            __builtin_amdgcn_fence(__ATOMIC_ACQUIRE, "agent");
            asm volatile("s_waitcnt vmcnt(0)" ::: "memory");
        }
    }
    __syncthreads();
}

__device__ __forceinline__ float wave_sum(float v) {
#pragma unroll
    for (int o = 1; o < 64; o <<= 1) v += __shfl_xor(v, o);
    return v;
}
__device__ __forceinline__ float wave_max(float v) {
#pragma unroll
    for (int o = 1; o < 64; o <<= 1) v = fmaxf(v, __shfl_xor(v, o));
    return v;
}
__device__ __forceinline__ float softplusf(float x) { return fmaxf(x, 0.f) + log1pf(expf(-fabsf(x))); }
__device__ __forceinline__ float sigmoidf(float x) { return 1.f / (1.f + expf(-x)); }
__device__ __forceinline__ float fsigmoid(float x) { return __builtin_amdgcn_rcpf(1.f + __expf(-x)); }
__device__ __forceinline__ float fsoftplus(float x) { return fmaxf(x, 0.f) + __logf(1.f + __expf(-fabsf(x))); }
__device__ __forceinline__ float ftanh(float x) { const float e = __expf(-2.f * fabsf(x)); const float t = (1.f - e) * __builtin_amdgcn_rcpf(1.f + e); return x < 0.f ? -t : t; }
__device__ __forceinline__ void wave_lds_sync() { asm volatile("s_waitcnt lgkmcnt(0)" ::: "memory"); __builtin_amdgcn_wave_barrier(); }

__device__ __forceinline__ unsigned f2bf(float f) { unsigned u = __builtin_bit_cast(unsigned, f); return (u + 0x7fffu + ((u >> 16) & 1u)) >> 16; }
__device__ __forceinline__ unsigned pk2(float lo, float hi) { return f2bf(lo) | (f2bf(hi) << 16); }
__device__ __forceinline__ float bf2f(bf16_t b) { return __builtin_bit_cast(float, (unsigned)b << 16); }
__device__ __forceinline__ float bflo(unsigned w) { return __builtin_bit_cast(float, w << 16); }
__device__ __forceinline__ float bfhi(unsigned w) { return __builtin_bit_cast(float, w & 0xffff0000u); }
#define LDS_WAIT() asm volatile("s_waitcnt lgkmcnt(0)" ::: "memory")

namespace pg8 {
#define PG8_LAS __attribute__((address_space(3)))
typedef unsigned short bf16_t;
typedef short bf16x8 __attribute__((ext_vector_type(8)));
typedef float f32x4 __attribute__((ext_vector_type(4)));
typedef unsigned u32x4 __attribute__((ext_vector_type(4)));
constexpr int BM = 256, BK = 64, HALF = 128, HTB = HALF * BK * 2  , STAGE_BYTES = 8 * HTB, NXCD = 8, WGM = 8;

__host__ __device__ __forceinline__ int lds_byte(int r, int c) { const int st = (r >> 4) * 2 + (c >> 5), rr = r & 15, cc = c & 31, ob = rr * 64 + cc * 2; return st * 1024 + (ob ^ (((ob >> 9) & 1) << 5)); }
__host__ __device__ __forceinline__ void stage_rc(int b, int& R, int& C) { const int st = b / 1024, sb = b % 1024, swz = sb ^ (((sb >> 9) & 1) << 5); R = (st >> 1) * 16 + swz / 64; C = (st & 1) * 32 + (swz % 64) / 2; }
__host__ __device__ __forceinline__ int perm32(int rho) { const int n = rho >> 4, i = rho & 15; return 8 * (i >> 2) + 4 * n + (i & 3); }

struct Unit { int pm, pn; };
struct Gemm { const bf16_t* A; const bf16_t* Bt; int M, N, K; };

struct StaticOrder {
    int nM, nN, nwg, G, c;
    __host__ __device__ void init(int M, int N, int G_, int c_) { nM = M / BM; nN = N / BM; nwg = nM * nN; G = G_; c = c_; }
    __host__ __device__ bool next(int i, Unit& u) const {
        const long L = (long)i * G + c; if (L >= nwg) return false;
        int wgid = (int)L; { const int q = nwg / NXCD, r = nwg % NXCD, xcd = wgid % NXCD, off = wgid / NXCD; wgid = (xcd < r ? xcd * (q + 1) : r * (q + 1) + (xcd - r) * q) + off; }
        const int nig = WGM * nN, gid = wgid / nig, fm = gid * WGM, gsz = (nM - fm) < WGM ? (nM - fm) : WGM;
        u.pm = fm + ((wgid % nig) % gsz); u.pn = (wgid % nig) / gsz; return true;
    }
    __device__ __forceinline__ void a_ready(const Unit&) const {}
    __device__ __forceinline__ void done(const Unit&) const {}
};
typedef __bf16 bf16x2_t __attribute__((ext_vector_type(2))); typedef float cvt_f32x2 __attribute__((ext_vector_type(2)));
__device__ __forceinline__ unsigned cvt_pk_bf16(float lo, float hi) { const cvt_f32x2 v = {lo, hi}; return __builtin_bit_cast(unsigned, __builtin_convertvector(v, bf16x2_t)); }


template <class Epi, class Sched, bool STAMP = false>
__device__ __forceinline__ void gemm_phase(PG8_LAS unsigned char* lds, const Gemm g, const Sched& S, const Epi& E, unsigned long long* stamps) {
    const int tid = threadIdx.x, wid = __builtin_amdgcn_readfirstlane(tid >> 6), lane = tid & 63, wr = wid >> 2, wc = wid & 3, fr = lane & 15, fq = lane >> 4;
    const int K = g.K, nt = K / BK;
    int ts_lo = 0, ts_hi = 0, nts = 0; const unsigned long long rt_entry = STAMP ? (unsigned long long)wall_clock64() : 0ull;
#define PG8_STAMP() do { if (STAMP && wid == 0 && nts < 64) { const unsigned long long _c = (unsigned long long)clock64(); \
        ts_lo = (lane == nts) ? (int)(unsigned)_c : ts_lo; ts_hi = (lane == nts) ? (int)(unsigned)(_c >> 32) : ts_hi; ++nts; } } while (0)
    PG8_STAMP();
    unsigned voffA[2], voffB[2];
#pragma unroll
    for (int i = 0; i < 2; ++i) { int R, C; stage_rc(tid * 16 + i * 8192, R, C); const int Rb = Epi::PERM ? ((R & ~31) + perm32(R & 31)) : R;
        voffA[i] = (unsigned)(R * K + C) * 2u; voffB[i] = (unsigned)(Rb * K + C) * 2u; }
    const size_t kstep = (size_t)(BK * 2);
    const size_t hstep = (size_t)HALF * K * 2;
    const size_t tstep = 2 * hstep;
    const unsigned ldsw = (unsigned)wid * 1024u;
    const int aoff = lds_byte(wr * 64 + fr, fq * 8), boff = lds_byte(wc * 32 + fr, fq * 8);
#define PG8_SA(b, h) (((b) * 2 + (h)) * HTB)
#define PG8_SB(b, h) ((4 + (b) * 2 + (h)) * HTB)
#define PG8_STAGE(bufoff, gbase, voff) do { _Pragma("unroll") for (int _i = 0; _i < 2; ++_i) \
        __builtin_amdgcn_global_load_lds((const unsigned*)((const char*)(gbase) + (voff)[_i]), (PG8_LAS unsigned*)(lds + (bufoff) + ldsw + _i * 8192), 16, 0, 0); } while (0)
#define PG8_LDA(dst, b, h) do { _Pragma("unroll") for (int m = 0; m < 4; ++m) _Pragma("unroll") for (int k = 0; k < 2; ++k) dst[m][k] = *(const PG8_LAS bf16x8*)(lds + PG8_SA(b, h) + aoff + m * 2048 + k * 1024); } while (0)
#define PG8_LDB(dst, b, h) do { _Pragma("unroll") for (int n = 0; n < 2; ++n) _Pragma("unroll") for (int k = 0; k < 2; ++k) dst[n][k] = *(const PG8_LAS bf16x8*)(lds + PG8_SB(b, h) + boff + n * 2048 + k * 1024); } while (0)
#define PG8_MMA(ai, bj, At, Bt) do { __builtin_amdgcn_s_setprio(1); _Pragma("unroll") for (int m = 0; m < 4; ++m) _Pragma("unroll") for (int n = 0; n < 2; ++n) _Pragma("unroll") for (int k = 0; k < 2; ++k) \
        acc[ai][bj][m][n] = __builtin_amdgcn_mfma_f32_16x16x32_bf16(Bt[n][k], At[m][k], acc[ai][bj][m][n], 0, 0, 0); __builtin_amdgcn_s_setprio(0); } while (0)
#define PG8_WAIT_V(n) asm volatile("s_waitcnt vmcnt(" #n ")" ::: "memory")
#define PG8_WAIT_L(n) asm volatile("s_waitcnt lgkmcnt(" #n ")" ::: "memory")
#define PG8_BAR __builtin_amdgcn_s_barrier()
#define PG8_SCHED __builtin_amdgcn_sched_barrier(0)
    Unit cur, nxt; int ui = 0;
    if (!S.next(0, cur)) return;
    f32x4 acc[2][2][4][2];
#pragma unroll
    for (int a = 0; a < 2; ++a)
#pragma unroll
        for (int b = 0; b < 2; ++b)
#pragma unroll
            for (int m = 0; m < 4; ++m)
#pragma unroll
                for (int n = 0; n < 2; ++n) acc[a][b][m][n] = (f32x4){0.f, 0.f, 0.f, 0.f};
    bf16x8 At[4][2], B0[2][2], B1[2][2];
    const char* cA = (const char*)g.A + (size_t)cur.pm * tstep; const char* cB = (const char*)g.Bt + (size_t)cur.pn * tstep;
    S.a_ready(cur);
    PG8_STAGE(PG8_SB(0, 0), cB, voffB); PG8_STAGE(PG8_SA(0, 0), cA, voffA); PG8_STAGE(PG8_SB(0, 1), cB + hstep, voffB); PG8_STAGE(PG8_SA(0, 1), cA + hstep, voffA);
    if (wr == 1) PG8_BAR;
    PG8_WAIT_V(4); PG8_BAR;
    PG8_STAGE(PG8_SB(1, 0), cB + kstep, voffB); PG8_STAGE(PG8_SA(1, 0), cA + kstep, voffA); PG8_STAGE(PG8_SB(1, 1), cB + hstep + kstep, voffB);
    PG8_WAIT_V(6); PG8_BAR;
    PG8_STAMP();
    for (;;) {
        const bool has_next = S.next(ui + 1, nxt);
        const char* nA = has_next ? (const char*)g.A + (size_t)nxt.pm * tstep : cA; const char* nB = has_next ? (const char*)g.Bt + (size_t)nxt.pn * tstep : cB;
        for (int t = 0; t < nt; t += 2) {
            const bool last = (t == nt - 2);
            const char* a1 = cA + (size_t)(t + 1) * kstep;
            const char* a2 = last ? nA : cA + (size_t)(t + 2) * kstep; const char* b2 = last ? nB : cB + (size_t)(t + 2) * kstep;
            const char* a3 = a2 + kstep; const char* b3 = b2 + kstep;
            if (last && has_next) S.a_ready(nxt);
            PG8_LDB(B0, 0, 0); PG8_SCHED; PG8_LDA(At, 0, 0); PG8_STAGE(PG8_SA(1, 1), a1 + hstep, voffA);
            PG8_WAIT_L(8); PG8_BAR; PG8_WAIT_L(0); PG8_MMA(0, 0, At, B0); PG8_BAR; PG8_SCHED;
            PG8_LDB(B1, 0, 1); PG8_STAGE(PG8_SB(0, 0), b2, voffB);
            PG8_BAR; PG8_WAIT_L(0); PG8_MMA(0, 1, At, B1); PG8_BAR;
            PG8_LDA(At, 0, 1); PG8_STAGE(PG8_SA(0, 0), a2, voffA);
            PG8_BAR; PG8_WAIT_L(0); PG8_MMA(1, 0, At, B0); PG8_BAR; PG8_SCHED;
            PG8_STAGE(PG8_SB(0, 1), b2 + hstep, voffB);
            PG8_WAIT_V(6); PG8_BAR; PG8_MMA(1, 1, At, B1); PG8_BAR;
            PG8_LDB(B0, 1, 0); PG8_SCHED; PG8_LDA(At, 1, 0); PG8_STAGE(PG8_SA(0, 1), a2 + hstep, voffA);
            PG8_WAIT_L(8); PG8_BAR; PG8_WAIT_L(0); PG8_MMA(0, 0, At, B0); PG8_BAR; PG8_SCHED;
            PG8_LDB(B1, 1, 1); PG8_STAGE(PG8_SB(1, 0), b3, voffB);
            PG8_BAR; PG8_WAIT_L(0); PG8_MMA(0, 1, At, B1); PG8_BAR;
            PG8_LDA(At, 1, 1); PG8_STAGE(PG8_SA(1, 0), a3, voffA);
            PG8_BAR; PG8_WAIT_L(0); PG8_MMA(1, 0, At, B0); PG8_BAR; PG8_SCHED;
            PG8_STAGE(PG8_SB(1, 1), b3 + hstep, voffB);
            PG8_WAIT_V(6); PG8_BAR; PG8_MMA(1, 1, At, B1); PG8_BAR;
        }
        PG8_STAMP();
        if constexpr (!Epi::AFTER_DRAIN) { E(acc, cur, wr, wc, fr, fq); S.done(cur); }
        PG8_STAMP();
        if (!has_next) break;
#pragma unroll
        for (int a = 0; a < 2; ++a)
#pragma unroll
            for (int b = 0; b < 2; ++b)
#pragma unroll
                for (int m = 0; m < 4; ++m)
#pragma unroll
                    for (int n = 0; n < 2; ++n) acc[a][b][m][n] = (f32x4){0.f, 0.f, 0.f, 0.f};
        cur = nxt; cA = nA; cB = nB; ++ui;
    }
    PG8_WAIT_V(0);
    if (wr == 0) PG8_BAR;
    PG8_BAR;
    if constexpr (Epi::AFTER_DRAIN) { E.fused(acc, cur, wr, wc, fr, fq, lds, wid, lane); S.done(cur); }
    PG8_STAMP();
    if (STAMP && wid == 0) { stamps[lane] = lane < nts ? (((unsigned long long)(unsigned)ts_hi << 32) | (unsigned)ts_lo) : 0ull;
        if (lane == 62) stamps[62] = rt_entry; if (lane == 63) stamps[63] = (unsigned long long)wall_clock64(); }
#undef PG8_STAMP
#undef PG8_SA
#undef PG8_SB
#undef PG8_STAGE
#undef PG8_LDA
#undef PG8_LDB
#undef PG8_MMA
#undef PG8_WAIT_V
#undef PG8_WAIT_L
#undef PG8_BAR
#undef PG8_SCHED
}
}


struct Args { const float* in[29]; float* out; unsigned char* ws; int ph_lo, ph_hi; };
struct Frame {
    LAS unsigned char* lds;
    int tid, lane, wave, bid, G;
    unsigned* ctl;
    const Args* a;
    float* out;
    unsigned char* ws;
};
enum { I_X = 0, I_MEM, I_LNIN_G, I_LNIN_B, I_WIN, I_MU, I_W0, I_WDEC, I_A0, I_WA, I_WG, I_KK, I_KA, I_RK, I_LNXG, I_LNXB, I_WMEMKV, I_WOUT, I_LN1G, I_LN1B,
       I_RG, I_RGB, I_RE, I_REB, I_WEG, I_WEU, I_WED, I_LN2G, I_LN2B };

template <class AF, class EF>
__device__ __forceinline__ void gemm_naive(Frame& F, int M, int N, int K, const AF arow, const float* B, int ldb, const EF epi, int tile_base) {
    LAS float* As = (LAS float*)F.lds;
    LAS float* Bs = As + 16 * 132;
    const int tid = F.tid;
    const int tm = (M + 127) / 128, tn = (N + 63) / 64, nt = tm * tn;
    const int ty = tid >> 4, tx = tid & 15;
    const int lr = tid >> 2, lk = (tid & 3) * 4;
    const int bk = (tid >> 4) & 15, bc = (tid & 15) * 4;
    for (int lt = 0; lt < nt; ++lt) {
        if ((tile_base + lt) % F.G != F.bid) continue;
        const int m0 = (lt / tn) * 128, n0 = (lt % tn) * 64;
        const float* ap = (m0 + lr < M) ? arow(m0 + lr) : nullptr;
        const bool bok = (tid < 256) && (n0 + bc < N);
        float acc[4][4];
#pragma unroll
        for (int i = 0; i < 4; ++i)
#pragma unroll
            for (int j = 0; j < 4; ++j) acc[i][j] = 0.f;
        for (int k0 = 0; k0 < K; k0 += 16) {
            f32x4 av = (f32x4){0.f, 0.f, 0.f, 0.f}, bv = (f32x4){0.f, 0.f, 0.f, 0.f};
            if (ap) av = *(const f32x4*)(ap + k0 + lk);
            if (bok) bv = *(const f32x4*)(B + (size_t)(k0 + bk) * ldb + n0 + bc);
            __syncthreads();
            As[(lk + 0) * 132 + lr] = av.x; As[(lk + 1) * 132 + lr] = av.y; As[(lk + 2) * 132 + lr] = av.z; As[(lk + 3) * 132 + lr] = av.w;
            if (tid < 256) *(LAS f32x4*)(Bs + bk * 64 + bc) = bv;
            __syncthreads();
#pragma unroll
            for (int k = 0; k < 16; ++k) {
                const f32x4 a = *(const LAS f32x4*)(As + k * 132 + ty * 4);
                const f32x4 b = *(const LAS f32x4*)(Bs + k * 64 + tx * 4);
#pragma unroll
                for (int i = 0; i < 4; ++i)
#pragma unroll
                    for (int j = 0; j < 4; ++j) acc[i][j] += a[i] * b[j];
            }
        }
#pragma unroll
        for (int i = 0; i < 4; ++i) {
            const int r = m0 + ty * 4 + i, c = n0 + tx * 4;
            if (r < M && c < N) epi(r, c, (f32x4){acc[i][0], acc[i][1], acc[i][2], acc[i][3]});
        }
    }
    __syncthreads();
}
struct ARowPlain { const float* A; int lda; __device__ __forceinline__ const float* operator()(int r) const { return A + (size_t)r * lda; } };
struct ARowList { const float* A; int lda; const int* list; __device__ __forceinline__ const float* operator()(int r) const { return A + (size_t)(list[r] >> 1) * lda; } };
struct ARowOff { const float* A; int lda; __device__ __forceinline__ const float* operator()(int r) const { return A + (size_t)r * lda; } };
struct EpiStore { float* Cm; int ldc; __device__ __forceinline__ void operator()(int r, int c, f32x4 v) const { *(f32x4*)(Cm + (size_t)r * ldc + c) = v; } };
struct EpiResid { float* Cm; const float* R; int ldc; float alpha; __device__ __forceinline__ void operator()(int r, int c, f32x4 v) const {
    const f32x4 h = *(const f32x4*)(R + (size_t)r * ldc + c); *(f32x4*)(Cm + (size_t)r * ldc + c) = h * alpha + v; } };
struct EpiSilu { float* Hd; const float* Gt; int ldc; __device__ __forceinline__ void operator()(int r, int c, f32x4 u) const {
    const f32x4 g = *(const f32x4*)(Gt + (size_t)r * ldc + c); f32x4 o;
#pragma unroll
    for (int i = 0; i < 4; ++i) o[i] = g[i] / (1.f + expf(-g[i])) * u[i];
    *(f32x4*)(Hd + (size_t)r * ldc + c) = o; } };
struct EpiScatter { float* YS; const int* list; const float* lw; __device__ __forceinline__ void operator()(int r, int c, f32x4 v) const {
    const int e = list[r]; const float w = lw[r]; *(f32x4*)(YS + (size_t)e * D + c) = v * w; } };

template <bool STORE = true>
__device__ __forceinline__ void ln_core(f32x4 (&v)[8], const float* g, const float* b, float* out, int lane) {
    float s = 0.f;
#pragma unroll
    for (int j = 0; j < 8; ++j) s += (v[j].x + v[j].y) + (v[j].z + v[j].w);
    const float mean = wave_sum(s) * (1.f / D);
    float s2 = 0.f;
#pragma unroll
    for (int j = 0; j < 8; ++j) { v[j] = v[j] - mean; s2 += (v[j].x * v[j].x + v[j].y * v[j].y) + (v[j].z * v[j].z + v[j].w * v[j].w); }
    const float rstd = 1.f / sqrtf(wave_sum(s2) * (1.f / D) + LN_EPS);
#pragma unroll
    for (int j = 0; j < 8; ++j) {
        const f32x4 gg = ((const f32x4*)g)[lane + 64 * j], bb = ((const f32x4*)b)[lane + 64 * j];
        v[j] = v[j] * rstd * gg + bb;
        if (STORE) ((f32x4*)out)[lane + 64 * j] = v[j];
    }
}

__device__ __forceinline__ void p0_transpose_item(const float* W, int K, int N, bf16_t* WT, LAS float* scr, int item, int lane) {
    const int nblk = N / 32, kb = item / nblk, nb = item % nblk, k0 = 64 * kb, n0 = 32 * nb;
#pragma unroll 8
    for (int i = 0; i < 32; ++i) { const int kk = 2 * i + (lane >> 5); scr[kk * 33 + (lane & 31)] = W[(size_t)(k0 + kk) * N + n0 + (lane & 31)]; }
    LDS_WAIT(); asm volatile("" ::: "memory");
    const int c = lane & 7;
#pragma unroll
    for (int j = 0; j < 4; ++j) { const int n = (lane >> 3) + 8 * j; const LAS float* sp = scr + (8 * c) * 33 + n;
        v4u o; o.x = pk2(sp[0 * 33], sp[1 * 33]); o.y = pk2(sp[2 * 33], sp[3 * 33]); o.z = pk2(sp[4 * 33], sp[5 * 33]); o.w = pk2(sp[6 * 33], sp[7 * 33]);
        *(v4u*)(WT + (size_t)(n0 + n) * K + k0 + 8 * c) = o; }
    LDS_WAIT(); asm volatile("" ::: "memory");
}
__device__ __forceinline__ void ph_prologue(Frame& F) {
    bf16_t* HB = (bf16_t*)(F.ws + WS_HB);
    bf16_t* MEMB = (bf16_t*)(F.ws + WS_MEMB);
    bf16_t* WINT = (bf16_t*)(F.ws + WS_WINT);
    bf16_t* WMKVT = (bf16_t*)(F.ws + WS_WMKVT);
    const int gw = F.bid * NWAVES + F.wave, NGW = F.G * NWAVES;
    LAS float* scr = (LAS float*)(F.lds + F.wave * 16384);
    constexpr int I_IN = (D / 64) * (IN_COLS / 32), I_MKV = (D / 64) * (2 * MEMW / 32);
    for (int it = gw; it < I_IN + I_MKV; it += NGW) {
        int r = it;
        if (r < I_IN) { p0_transpose_item(F.a->in[I_WIN], D, IN_COLS, WINT, scr, r, F.lane); continue; } r -= I_IN;
        p0_transpose_item(F.a->in[I_WMEMKV], D, 2 * MEMW, WMKVT, scr, r, F.lane);
    }
    { bf16_t* WL = (bf16_t*)(F.ws + WS_WLOWT);
      for (int i = F.bid * NT + F.tid; i < C * (LOWR / 8); i += F.G * NT) { const int c = i % C, kc = i / C, k0 = kc * 8;
          const float* src; int kk0;
          if (k0 < DR) { src = F.a->in[I_WDEC]; kk0 = k0; } else if (k0 < DR + AR) { src = F.a->in[I_WA]; kk0 = k0 - DR; } else { src = F.a->in[I_WG]; kk0 = k0 - DR - AR; }
          v4u o; o.x = pk2(src[(size_t)(kk0 + 0) * C + c], src[(size_t)(kk0 + 1) * C + c]); o.y = pk2(src[(size_t)(kk0 + 2) * C + c], src[(size_t)(kk0 + 3) * C + c]);
          o.z = pk2(src[(size_t)(kk0 + 4) * C + c], src[(size_t)(kk0 + 5) * C + c]); o.w = pk2(src[(size_t)(kk0 + 6) * C + c], src[(size_t)(kk0 + 7) * C + c]);
          *(v4u*)(WL + (size_t)c * LOWR + k0) = o; } }
    { bf16_t* WR = (bf16_t*)(F.ws + WS_WRT);
      for (int i = F.bid * NT + F.tid; i < 80 * D; i += F.G * NT) { const int k = i % D, col = i / D;
          const float w = col < NG ? F.a->in[I_RG][(size_t)k * NG + col] : (col < NG + NE ? F.a->in[I_RE][(size_t)k * NE + (col - NG)] : 0.f);
          const unsigned hi = f2bf(w); const float rem = w - __builtin_bit_cast(float, hi << 16);
          const size_t fo = ((size_t)((k >> 5) * 5 + (col >> 4)) * 64 + (col & 15) + 16 * ((k >> 3) & 3)) * 8 + (k & 7);
          WR[fo] = (bf16_t)hi; WR[(size_t)80 * D + fo] = (bf16_t)f2bf(rem); } }
    for (size_t i = (size_t)F.bid * NT + F.tid; i < (size_t)(PLD - IN_COLS) * D / 8; i += (size_t)F.G * NT) ((v4u*)(WINT + (size_t)IN_COLS * D))[i] = (v4u){0u, 0u, 0u, 0u};
    for (size_t i = (size_t)F.bid * NT + F.tid; i < (size_t)BATCH * MEML * D / 4; i += (size_t)F.G * NT) {
        const f32x4 v = ((const f32x4*)F.a->in[I_MEM])[i]; ((v2u*)MEMB)[i] = (v2u){pk2(v.x, v.y), pk2(v.z, v.w)}; }
    f32x4 xn[8];
    { const f32x4* xr = (const f32x4*)(F.a->in[I_X] + (size_t)(gw < T ? gw : T - 1) * D);
#pragma unroll
      for (int j = 0; j < 8; ++j) xn[j] = xr[F.lane + 64 * j]; }
    for (int row = gw; row < T; row += NGW) {
        f32x4 v[8];
#pragma unroll
        for (int j = 0; j < 8; ++j) v[j] = xn[j];
        { const f32x4* xr = (const f32x4*)(F.a->in[I_X] + (size_t)(row + NGW < T ? row + NGW : row) * D);
#pragma unroll
          for (int j = 0; j < 8; ++j) xn[j] = xr[F.lane + 64 * j]; }
        ln_core<false>(v, F.a->in[I_LNIN_G], F.a->in[I_LNIN_B], nullptr, F.lane);
#pragma unroll
        for (int j = 0; j < 8; ++j) ((v2u*)(HB + (size_t)row * D))[F.lane + 64 * j] = (v2u){pk2(v[j].x, v[j].y), pk2(v[j].z, v[j].w)};
    }
    __syncthreads();
}
struct ProjOrder {
    int G, c;
    __device__ __forceinline__ bool next(int i, pg8::Unit& u) const {
        constexpr int nM = T / 256, nN = PLD / 256, nwg = nM * nN;
        const int L = i * G + c;
        if (L >= nwg + 16) return false;
        if (L >= nwg) { const int j = L - nwg; u.pm = nM + (j >> 2); u.pn = nN + (j & 3); return true; }
        int wgid = L; { const int q = nwg / pg8::NXCD, r = nwg % pg8::NXCD, xcd = wgid % pg8::NXCD, off = wgid / pg8::NXCD; wgid = (xcd < r ? xcd * (q + 1) : r * (q + 1) + (xcd - r) * q) + off; }
        const int nig = pg8::WGM * nN, gid = wgid / nig, fm = gid * pg8::WGM, gsz = (nM - fm) < pg8::WGM ? (nM - fm) : pg8::WGM;
        u.pm = fm + ((wgid % nig) % gsz); u.pn = (wgid % nig) / gsz; return true;
    }
    __device__ __forceinline__ void a_ready(const pg8::Unit&) const {}
    __device__ __forceinline__ void done(const pg8::Unit&) const {}
};
struct EpiProj {
    static constexpr bool PERM = true, AFTER_DRAIN = false;
    bf16_t* P; bf16_t* MKV;
    __device__ __forceinline__ void operator()(const pg8::f32x4 (&acc)[2][2][4][2], const pg8::Unit& u, int wr, int wc, int fr, int fq) const {
        bf16_t* base; int ldc, row0, col0;
        if (u.pm < T / 256) { base = P; ldc = PLD; row0 = u.pm * 256 + wr * 64 + fr; col0 = u.pn * 256 + wc * 32 + 8 * fq; }
        else { base = MKV; ldc = 2 * MEMW; row0 = (u.pm - T / 256) * 256 + wr * 64 + fr; col0 = (u.pn - PLD / 256) * 256 + wc * 32 + 8 * fq; }
#pragma unroll
        for (int ai = 0; ai < 2; ++ai)
#pragma unroll
            for (int m = 0; m < 4; ++m) { bf16_t* rowp = base + (size_t)(row0 + ai * 128 + m * 16) * ldc + col0;
#pragma unroll
                for (int bj = 0; bj < 2; ++bj) { const pg8::f32x4 v0 = acc[ai][bj][m][0], v1 = acc[ai][bj][m][1];
                    v4u w; w.x = pg8::cvt_pk_bf16(v0[0], v0[1]); w.y = pg8::cvt_pk_bf16(v0[2], v0[3]); w.z = pg8::cvt_pk_bf16(v1[0], v1[1]); w.w = pg8::cvt_pk_bf16(v1[2], v1[3]);
                    *(v4u*)(rowp + bj * 128) = w; } }
    }
};
__device__ __forceinline__ void ph_proj(Frame& F) {
    pg8::Gemm g{(const bf16_t*)(F.ws + WS_HB), (const bf16_t*)(F.ws + WS_WINT), T + BATCH * MEML, PLD + 2 * MEMW, D};
    ProjOrder S{F.G, F.bid};
    EpiProj E{(bf16_t*)(F.ws + WS_PROJ), (bf16_t*)(F.ws + WS_MEMKV)};
    pg8::gemm_phase<EpiProj, ProjOrder, false>(F.lds, g, S, E, nullptr);
    __syncthreads();
    { constexpr int I_OUT = (D / 64) * (D / 32);
      bf16_t* WOUTT = (bf16_t*)(F.ws + WS_WOUTT);
      LAS float* scr = (LAS float*)(F.lds + F.wave * 16384);
      volatile LAS int* qslot = (volatile LAS int*)(F.lds + 139264);
      for (;;) {
          if (F.tid == 0) *qslot = (int)atomicAdd(F.ctl + CW_Q2, 2u * NWAVES);
          __syncthreads();
          const int base = *qslot;
          __syncthreads();
          if (base >= I_OUT) break;
#pragma unroll 1
          for (int q = 0; q < 2; ++q) { const int itq = base + 2 * F.wave + q; if (itq < I_OUT) p0_transpose_item(F.a->in[I_WOUT], D, D, WOUTT, scr, itq, F.lane); }
      } }
    __syncthreads();
}
__device__ __forceinline__ void ph_rwkv_prep(Frame& F) {
    using pg8::bf16x8;
    typedef float f4 __attribute__((ext_vector_type(4)));
    constexpr int AS = 296;
    constexpr int KSL = 1040;
    const bf16_t* P = (const bf16_t*)(F.ws + WS_PROJ);
    const bf16_t* WL = (const bf16_t*)(F.ws + WS_WLOWT);
    bf16_t* PK = (bf16_t*)(F.ws + WS_PK);
    bf16_t* GB = (bf16_t*)(F.ws + WS_G);
    const float* mu = F.a->in[I_MU];
    LAS bf16_t* act = (LAS bf16_t*)F.lds;
    LAS bf16_t* ksl = (LAS bf16_t*)(F.lds + 20480);
    LAS float* par = (LAS float*)(F.lds + 20480 + 66560);
    const int tid = F.tid, lane = F.lane, wave = F.wave, fr = lane & 15, fq = lane >> 4;
    for (int item = F.bid; item < T / 32; item += F.G) {
        const int t0 = item * 32;
        __syncthreads();
        { const int q = tid >> 8, e = (tid & 255) * 4;
          *(LAS f32x4*)(par + q * 1024 + e) = *(const f32x4*)((q ? F.a->in[I_A0] : F.a->in[I_W0]) + e);
          *(LAS f32x4*)(par + (2 + q) * 1024 + e) = *(const f32x4*)((q ? F.a->in[I_KA] : F.a->in[I_KK]) + e); }
        { v4u cu[3], pv[3]; f32x4 m0[3], m1[3];
#pragma unroll
          for (int i = 0; i < 3; ++i) { int idx = tid + NT * i; idx = idx < 32 * 36 ? idx : 32 * 36 - 1;
              const int tt = idx / 36, ch = idx % 36, t = t0 + tt, col = COL_DL + 8 * ch;
              const bf16_t* pc = P + (size_t)t * PLD + col;
              cu[i] = *(const v4u*)pc; pv[i] = *(const v4u*)((t % SEQ) ? pc - PLD : pc);
              m0[i] = *(const f32x4*)(mu + col); m1[i] = *(const f32x4*)(mu + col + 4); }
#pragma unroll
          for (int i = 0; i < 3; ++i) { const int idx = tid + NT * i, tt = idx / 36, ch = idx % 36, t = t0 + tt;
              const bool hp = (t % SEQ) != 0;
              const float c[8] = {bflo(cu[i].x), bfhi(cu[i].x), bflo(cu[i].y), bfhi(cu[i].y), bflo(cu[i].z), bfhi(cu[i].z), bflo(cu[i].w), bfhi(cu[i].w)};
              const float q[8] = {bflo(pv[i].x), bfhi(pv[i].x), bflo(pv[i].y), bfhi(pv[i].y), bflo(pv[i].z), bfhi(pv[i].z), bflo(pv[i].w), bfhi(pv[i].w)};
              const float mm[8] = {m0[i].x, m0[i].y, m0[i].z, m0[i].w, m1[i].x, m1[i].y, m1[i].z, m1[i].w};
              float a[8];
#pragma unroll
              for (int e = 0; e < 8; ++e) { const float xs = c[e] + ((hp ? q[e] : 0.f) - c[e]) * mm[e];
                  a[e] = ch < DR / 8 ? ftanh(xs) : (ch < (DR + AR) / 8 ? xs : fsigmoid(xs)); }
              if (idx < 32 * 36) *(LAS v4u*)(act + tt * AS + 8 * ch) = (v4u){pg8::cvt_pk_bf16(a[0], a[1]), pg8::cvt_pk_bf16(a[2], a[3]), pg8::cvt_pk_bf16(a[4], a[5]), pg8::cvt_pk_bf16(a[6], a[7])}; } }
#pragma unroll 1
        for (int i0 = 0; i0 < 24; i0 += 4) {
            v4u cu[4], pv[4]; f32x4 m0[4], m1[4];
#pragma unroll
            for (int i = 0; i < 4; ++i) { const int idx = tid + NT * (i0 + i), tt = idx / 384, col = 8 * (idx % 384), t = t0 + tt;
                const bf16_t* pc = P + (size_t)t * PLD + col;
                cu[i] = *(const v4u*)pc; pv[i] = *(const v4u*)((t % SEQ) ? pc - PLD : pc);
                m0[i] = *(const f32x4*)(mu + col); m1[i] = *(const f32x4*)(mu + col + 4); }
#pragma unroll
            for (int i = 0; i < 4; ++i) { const int idx = tid + NT * (i0 + i), tt = idx / 384, col = 8 * (idx % 384), t = t0 + tt, b = t / SEQ, tl = t % SEQ;
                const bool hp = tl != 0;
                const float c[8] = {bflo(cu[i].x), bfhi(cu[i].x), bflo(cu[i].y), bfhi(cu[i].y), bflo(cu[i].z), bfhi(cu[i].z), bflo(cu[i].w), bfhi(cu[i].w)};
                const float q[8] = {bflo(pv[i].x), bfhi(pv[i].x), bflo(pv[i].y), bfhi(pv[i].y), bflo(pv[i].z), bfhi(pv[i].z), bflo(pv[i].w), bfhi(pv[i].w)};
                const float mm[8] = {m0[i].x, m0[i].y, m0[i].z, m0[i].w, m1[i].x, m1[i].y, m1[i].z, m1[i].w};
                float o[8];
#pragma unroll
                for (int e = 0; e < 8; ++e) o[e] = c[e] + ((hp ? q[e] : 0.f) - c[e]) * mm[e];
                const v4u w = (v4u){pg8::cvt_pk_bf16(o[0], o[1]), pg8::cvt_pk_bf16(o[2], o[3]), pg8::cvt_pk_bf16(o[4], o[5]), pg8::cvt_pk_bf16(o[6], o[7])};
                const int reg = col >> 10, ch = col & 1023;
                if (reg == 1) *(LAS v4u*)(ksl + tt * KSL + ch) = w;
                else *(v4u*)(PK + ((size_t)(b * NH + (ch >> 6)) * SEQ + tl) * 384 + (reg ? 320 : 0) + (ch & 63)) = w; }
        }
        __syncthreads();
#pragma unroll 1
        for (int hd = 0; hd < 2; ++hd) {
            const int h = 2 * wave + hd;
            f4 ad[2][4], aa[2][4], ag[2][4];
#pragma unroll
            for (int m = 0; m < 2; ++m)
#pragma unroll
                for (int n = 0; n < 4; ++n) { ad[m][n] = (f4){0.f, 0.f, 0.f, 0.f}; aa[m][n] = ad[m][n]; ag[m][n] = ad[m][n]; }
            const LAS bf16_t* arow = act + fr * AS + 8 * fq;
            const bf16_t* wrow = WL + (size_t)(64 * h + fr) * LOWR + 8 * fq;
#pragma unroll
            for (int ks = 0; ks < 9; ++ks) {
                const bf16x8 b0 = *(const LAS bf16x8*)(arow + 32 * ks), b1 = *(const LAS bf16x8*)(arow + 16 * AS + 32 * ks);
#pragma unroll
                for (int n = 0; n < 4; ++n) { const bf16x8 af = *(const bf16x8*)(wrow + (size_t)(16 * n) * LOWR + 32 * ks);
                    if (ks < 2) { ad[0][n] = __builtin_amdgcn_mfma_f32_16x16x32_bf16(af, b0, ad[0][n], 0, 0, 0); ad[1][n] = __builtin_amdgcn_mfma_f32_16x16x32_bf16(af, b1, ad[1][n], 0, 0, 0); }
                    else if (ks < 4) { aa[0][n] = __builtin_amdgcn_mfma_f32_16x16x32_bf16(af, b0, aa[0][n], 0, 0, 0); aa[1][n] = __builtin_amdgcn_mfma_f32_16x16x32_bf16(af, b1, aa[1][n], 0, 0, 0); }
                    else { ag[0][n] = __builtin_amdgcn_mfma_f32_16x16x32_bf16(af, b0, ag[0][n], 0, 0, 0); ag[1][n] = __builtin_amdgcn_mfma_f32_16x16x32_bf16(af, b1, ag[1][n], 0, 0, 0); } }
                if (ks % 3 == 2) __builtin_amdgcn_sched_barrier(0);
            }
#pragma unroll
            for (int m = 0; m < 2; ++m)
#pragma unroll
                for (int n = 0; n < 4; ++n) *(v2u*)(GB + (size_t)(t0 + 16 * m + fr) * C + 64 * h + 16 * n + 4 * fq) = (v2u){pg8::cvt_pk_bf16(ag[m][n][0], ag[m][n][1]), pg8::cvt_pk_bf16(ag[m][n][2], ag[m][n][3])};
            __builtin_amdgcn_sched_barrier(0);
#pragma unroll
            for (int m = 0; m < 2; ++m) {
                const int t = t0 + 16 * m + fr, b = t / SEQ, tl = t % SEQ;
                bf16_t* pk = PK + ((size_t)(b * NH + h) * SEQ + tl) * 384 + 4 * fq;
                const LAS bf16_t* kr = ksl + (16 * m + fr) * KSL + 64 * h + 4 * fq;
                float ks_[4][4], av[4][4], kkr[4][4];
                float ss = 0.f;
#pragma unroll
                for (int n = 0; n < 4; ++n) {
                    const int c0 = 64 * h + 16 * n + 4 * fq;
                    const v2u kc = *(const LAS v2u*)(kr + 16 * n);
                    const f32x4 w0 = *(const LAS f32x4*)(par + c0), a0 = *(const LAS f32x4*)(par + 1024 + c0), kkc = *(const LAS f32x4*)(par + 2048 + c0);
                    const float kcv[4] = {bflo(kc.x), bfhi(kc.x), bflo(kc.y), bfhi(kc.y)};
                    float lw[4];
#pragma unroll
                    for (int r = 0; r < 4; ++r) {
                        ks_[n][r] = kcv[r];
                        const float wl = w0[r] + ad[m][n][r];
                        const float wlog = -fsoftplus(-wl) - 0.5f;
                        lw[r] = -__expf(wlog);
                        av[n][r] = fsigmoid(a0[r] + aa[m][n][r]);
                        kkr[n][r] = ks_[n][r] * kkc[r];
                        ss += kkr[n][r] * kkr[n][r];
                    }
                    *(v2u*)(pk + 16 * n + 64) = (v2u){pg8::cvt_pk_bf16(lw[0], lw[1]), pg8::cvt_pk_bf16(lw[2], lw[3])};
                }
                ss += __shfl_xor(ss, 16); ss += __shfl_xor(ss, 32);
                const float inv = 1.f / fmaxf(sqrtf(ss), 1e-12f);
#pragma unroll
                for (int n = 0; n < 4; ++n) {
                    const int c0 = 64 * h + 16 * n + 4 * fq;
                    const f32x4 kac = *(const LAS f32x4*)(par + 3072 + c0);
                    float kk[4], k2[4], bb[4];
#pragma unroll
                    for (int r = 0; r < 4; ++r) { kk[r] = kkr[n][r] * inv; k2[r] = ks_[n][r] * (1.f + (av[n][r] - 1.f) * kac[r]); bb[r] = kk[r] * av[n][r]; }
                    bf16_t* pn = pk + 16 * n;
                    *(v2u*)(pn + 128) = (v2u){pg8::cvt_pk_bf16(k2[0], k2[1]), pg8::cvt_pk_bf16(k2[2], k2[3])};
                    *(v2u*)(pn + 192) = (v2u){pg8::cvt_pk_bf16(-kk[0], -kk[1]), pg8::cvt_pk_bf16(-kk[2], -kk[3])};
                    *(v2u*)(pn + 256) = (v2u){pg8::cvt_pk_bf16(bb[0], bb[1]), pg8::cvt_pk_bf16(bb[2], bb[3])};
                }
            }
        }
    }
    __syncthreads();
}
__device__ __forceinline__ float dpp_sum8(float x) {
    x += __builtin_bit_cast(float, __builtin_amdgcn_update_dpp(0, __builtin_bit_cast(int, x), 0xB1, 0xF, 0xF, false));
    x += __builtin_bit_cast(float, __builtin_amdgcn_update_dpp(0, __builtin_bit_cast(int, x), 0x4E, 0xF, 0xF, false));
    x += __builtin_bit_cast(float, __builtin_amdgcn_update_dpp(0, __builtin_bit_cast(int, x), 0x141, 0xF, 0xF, false));
    return x;
}
template <bool IDENT>
__device__ __forceinline__ void wkv_steps8(f32x2 (&s)[4][8], const LAS float* buf, float* yout, const int vg, const int kg) {
#pragma unroll 1
    for (int st = 0; st < 8; ++st) {
        const LAS float* vb = buf + st * 384 + kg * 16;
        float sa[4], y[4];
        {
            f32x2 aa[8];
#pragma unroll
            for (int q = 0; q < 4; ++q) { const f32x4 t3 = *(const LAS f32x4*)(vb + 192 + 4 * q); aa[2 * q] = (f32x2){t3.x, t3.y}; aa[2 * q + 1] = (f32x2){t3.z, t3.w}; }
#pragma unroll
            for (int i = 0; i < 4; ++i) {
                f32x2 sa2 = s[i][0] * aa[0];
#pragma unroll
                for (int jp = 1; jp < 8; ++jp) sa2 = s[i][jp] * aa[jp] + sa2;
                sa[i] = sa2.x + sa2.y;
            }
        }
#pragma unroll
        for (int i = 0; i < 4; ++i) sa[i] += __builtin_bit_cast(float, __builtin_amdgcn_update_dpp(0, __builtin_bit_cast(int, sa[i]), 0xB1, 0xF, 0xF, false));
#pragma unroll
        for (int i = 0; i < 4; ++i) sa[i] += __builtin_bit_cast(float, __builtin_amdgcn_update_dpp(0, __builtin_bit_cast(int, sa[i]), 0x4E, 0xF, 0xF, false));
        f32x4 vv;
        if (!IDENT) vv = *(const LAS f32x4*)(buf + st * 384 + 320 + vg * 4);
        f32x2 y2[4];
#pragma unroll
        for (int hf = 0; hf < 2; ++hf) {
            f32x2 rr[4], ww[4], kk2[4], bb[4];
#pragma unroll
            for (int q = 0; q < 2; ++q) {
                const f32x4 t0 = *(const LAS f32x4*)(vb + 8 * hf + 4 * q), t1 = *(const LAS f32x4*)(vb + 64 + 8 * hf + 4 * q), t2 = *(const LAS f32x4*)(vb + 128 + 8 * hf + 4 * q), t4 = *(const LAS f32x4*)(vb + 256 + 8 * hf + 4 * q);
                rr[2 * q] = (f32x2){t0.x, t0.y}; rr[2 * q + 1] = (f32x2){t0.z, t0.w}; ww[2 * q] = (f32x2){t1.x, t1.y}; ww[2 * q + 1] = (f32x2){t1.z, t1.w};
                kk2[2 * q] = (f32x2){t2.x, t2.y}; kk2[2 * q + 1] = (f32x2){t2.z, t2.w}; bb[2 * q] = (f32x2){t4.x, t4.y}; bb[2 * q + 1] = (f32x2){t4.z, t4.w};
            }
#pragma unroll
            for (int i = 0; i < 4; ++i) {
                const f32x2 sav = (f32x2){sa[i], sa[i]};
#pragma unroll
                for (int jq = 0; jq < 4; ++jq) { const int jp = 4 * hf + jq;
                    f32x2 u = sav * bb[jq];
                    if (!IDENT) { const float vi = vv[i]; u = (f32x2){vi, vi} * kk2[jq] + u; }
                    s[i][jp] = s[i][jp] * ww[jq] + u;
                    y2[i] = (jp == 0) ? s[i][jp] * rr[jq] : s[i][jp] * rr[jq] + y2[i];
                }
            }
        }
#pragma unroll
        for (int i = 0; i < 4; ++i) y[i] = y2[i].x + y2[i].y;
#pragma unroll
        for (int i = 0; i < 4; ++i) y[i] += __builtin_bit_cast(float, __builtin_amdgcn_update_dpp(0, __builtin_bit_cast(int, y[i]), 0xB1, 0xF, 0xF, false));
#pragma unroll
        for (int i = 0; i < 4; ++i) y[i] += __builtin_bit_cast(float, __builtin_amdgcn_update_dpp(0, __builtin_bit_cast(int, y[i]), 0x4E, 0xF, 0xF, false));
        if (kg == 0) *(f32x4*)(yout + st * 64) = (f32x4){y[0], y[1], y[2], y[3]};
    }
}
__device__ __forceinline__ void ph_wkv_scan(Frame& F) {
    const bf16_t* PK = (const bf16_t*)(F.ws + WS_PK);
    const int lane = F.lane, wave = F.wave, pr = wave >> 1, role = (wave ^ (wave >> 2)) & 1, vg = lane >> 2, kg = lane & 3, l128 = role * 64 + lane;
    LAS float* pbuf = (LAS float*)(F.lds + pr * 24576);
    int woff[3]; bool isw[3];
#pragma unroll
    for (int j = 0; j < 3; ++j) { const int pi = l128 + 128 * j, stp = pi / 48, rem = pi % 48, vec = rem >> 3, c8 = rem & 7; woff[j] = (stp * 6 + vec) * 64 + c8 * 8; isw[j] = (vec == 1); }
    const int nround = (BATCH * NH * 16 + F.G * 4 - 1) / (F.G * 4);
    for (int rd = 0; rd < nround; ++rd) {
        const int item = (rd * F.G + F.bid) * 4 + pr;
        const bool act = item < BATCH * NH * 16;
        const int bh = item >> 4, ch = item & 15;
        const bf16_t* src = PK + ((size_t)bh * SEQ + ch * 128) * 384;
        f32x2 s[4][8];
#pragma unroll
        for (int i = 0; i < 4; ++i)
#pragma unroll
            for (int jp = 0; jp < 8; ++jp) s[i][jp] = (f32x2){(role && (4 * vg + i == 16 * kg + 2 * jp)) ? 1.f : 0.f, (role && (4 * vg + i == 16 * kg + 2 * jp + 1)) ? 1.f : 0.f};
        v4u rg[3];
#define WK_LOAD(sg) do { _Pragma("unroll") for (int j = 0; j < 3; ++j) rg[j] = *(const v4u*)(src + (size_t)(sg) * 8 * 384 + (size_t)(l128 + 128 * j) * 8); } while (0)
#define WK_WRITE(bf) do { _Pragma("unroll") for (int j = 0; j < 3; ++j) { float f[8]; f[0] = bflo(rg[j].x); f[1] = bfhi(rg[j].x); f[2] = bflo(rg[j].y); f[3] = bfhi(rg[j].y); f[4] = bflo(rg[j].z); f[5] = bfhi(rg[j].z); f[6] = bflo(rg[j].w); f[7] = bfhi(rg[j].w); \
            if (isw[j]) { _Pragma("unroll") for (int e = 0; e < 8; ++e) f[e] = __expf(f[e]); } \
            LAS float* d_ = pbuf + (bf) * 3072 + woff[j]; *(LAS f32x4*)d_ = (f32x4){f[0], f[1], f[2], f[3]}; *(LAS f32x4*)(d_ + 4) = (f32x4){f[4], f[5], f[6], f[7]}; } } while (0)
        __syncthreads();
        if (act) { WK_LOAD(0); WK_WRITE(0); WK_LOAD(1); }
        __syncthreads();
        float* yout = (float*)(F.ws + (role ? WS_QH : WS_YLOC)) + ((size_t)bh * SEQ + ch * 128) * 64 + vg * 4;
        for (int sg = 0; sg < 16; ++sg) {
            if (act) {
                if (role) wkv_steps8<true>(s, pbuf + (sg & 1) * 3072, yout + (size_t)sg * 8 * 64, vg, kg);
                else wkv_steps8<false>(s, pbuf + (sg & 1) * 3072, yout + (size_t)sg * 8 * 64, vg, kg);
                if (sg + 1 < 16) WK_WRITE((sg + 1) & 1);
                if (sg + 2 < 16) WK_LOAD(sg + 2);
            }
            __syncthreads();
        }
#undef WK_LOAD
#undef WK_WRITE
        if (act) { float* so = (float*)(F.ws + (role ? WS_PCH : WS_LCH)) + (size_t)item * 4096 + (size_t)(4 * vg) * 64 + 16 * kg;
#pragma unroll
            for (int i = 0; i < 4; ++i)
#pragma unroll
                for (int q = 0; q < 4; ++q) *(f32x4*)(so + i * 64 + 4 * q) = (f32x4){s[i][2 * q].x, s[i][2 * q].y, s[i][2 * q + 1].x, s[i][2 * q + 1].y}; }
    }
    __syncthreads();
}
namespace wk {
using pg8::bf16x8; using pg8::lds_byte;
typedef float f4 __attribute__((ext_vector_type(4)));
constexpr int AB = 8192;
constexpr int O_At = 0, O_Bt = AB, O_Kt = 2 * AB, O_Rt = 3 * AB, O_ATr = 4 * AB, O_BH = 5 * AB, O_KH = 6 * AB, O_VT = 7 * AB, O_N = 8 * AB, O_NT = 9 * AB, O_T0 = 10 * AB,
              O_Aak = 11 * AB, O_Arb = 12 * AB, O_Ark = 13 * AB, O_Z1T = 14 * AB, O_UT = 15 * AB, O_GT = 16 * AB, O_SEG = 17 * AB, O_WL = O_SEG + 4096, O_RAW = O_N;
struct Ctx { LAS unsigned char* lds; int am, fbase, d0, d1, ai, b0i; };
__device__ __forceinline__ void mm2(const Ctx& c, const int offA, const int offB, f4 (&acc)[2]) {
    const LAS unsigned char* pa = c.lds + offA + c.am * 2048 + c.fbase;
    const LAS unsigned char* pb = c.lds + offB + (c.b0i >> 4) * 2048 + c.fbase;
    const bf16x8 a0 = *(const LAS bf16x8*)pa, a1 = *(const LAS bf16x8*)(pa + 1024);
#pragma unroll
    for (int n = 0; n < 2; ++n) { const bf16x8 b0 = *(const LAS bf16x8*)(pb + n * 2048), b1 = *(const LAS bf16x8*)(pb + n * 2048 + 1024);
        acc[n] = __builtin_amdgcn_mfma_f32_16x16x32_bf16(a0, b0, acc[n], 0, 0, 0); acc[n] = __builtin_amdgcn_mfma_f32_16x16x32_bf16(a1, b1, acc[n], 0, 0, 0); }
}
__device__ __forceinline__ void zero2(f4 (&acc)[2]) { acc[0] = (f4){0.f, 0.f, 0.f, 0.f}; acc[1] = acc[0]; }
__device__ __forceinline__ void st_d(const Ctx& c, const int off, const int n, const f4 d) {
    *(LAS v2u*)(c.lds + off + (n ? c.d1 : c.d0)) = (v2u){pg8::cvt_pk_bf16(d[0], d[1]), pg8::cvt_pk_bf16(d[2], d[3])}; }
__device__ __forceinline__ f4 ld_d(const Ctx& c, const int off, const int n) {
    const v2u w = *(const LAS v2u*)(c.lds + off + (n ? c.d1 : c.d0)); return (f4){bflo(w.x), bfhi(w.x), bflo(w.y), bfhi(w.y)}; }
template <int MODE> __device__ __forceinline__ f4 tri(const Ctx& c, const int n, const f4 d) {
    const int b = c.b0i + 16 * n; f4 o;
#pragma unroll
    for (int r = 0; r < 4; ++r) { const int a = c.ai + r; const bool keep = MODE == 0 ? a < b : (MODE == 1 ? a <= b : a > b); o[r] = keep ? d[r] : 0.f; }
    return o; }
struct FA { bf16x8 v[2]; };
struct FB { bf16x8 v[2][2]; };
__device__ __forceinline__ FA lda(const Ctx& c, const int off) { const LAS unsigned char* p = c.lds + off + c.am * 2048 + c.fbase; FA f; f.v[0] = *(const LAS bf16x8*)p; f.v[1] = *(const LAS bf16x8*)(p + 1024); return f; }
__device__ __forceinline__ FB ldb(const Ctx& c, const int off) { const LAS unsigned char* p = c.lds + off + (c.b0i >> 4) * 2048 + c.fbase; FB f;
#pragma unroll
    for (int n = 0; n < 2; ++n) { f.v[n][0] = *(const LAS bf16x8*)(p + n * 2048); f.v[n][1] = *(const LAS bf16x8*)(p + n * 2048 + 1024); }
    return f; }
__device__ __forceinline__ void mmf(f4 (&acc)[2], const FA& a, const FB& b) {
#pragma unroll
    for (int n = 0; n < 2; ++n) acc[n] = __builtin_amdgcn_mfma_f32_16x16x32_bf16(a.v[0], b.v[n][0], acc[n], 0, 0, 0);
#pragma unroll
    for (int n = 0; n < 2; ++n) acc[n] = __builtin_amdgcn_mfma_f32_16x16x32_bf16(a.v[1], b.v[n][1], acc[n], 0, 0, 0); }
__device__ __forceinline__ void st2(const Ctx& c, const int off, const f4 (&d)[2]) { st_d(c, off, 0, d[0]); st_d(c, off, 1, d[1]); }
template <int MODE> __device__ __forceinline__ void st2tri(const Ctx& c, const int off, const f4 (&d)[2]) { st_d(c, off, 0, tri<MODE>(c, 0, d[0])); st_d(c, off, 1, tri<MODE>(c, 1, d[1])); }
__device__ __forceinline__ void chain_stage(const Ctx& c, const int Pin, const int PTin, const int Pout, const int PTout, const int Tin, const int Tout) {
    const FA aPT = lda(c, PTin), aP = lda(c, Pin); const FB bT = ldb(c, Tin), bP = ldb(c, Pin), bPT = ldb(c, PTin);
    f4 t[2], p[2], pt[2]; t[0] = ld_d(c, Tin, 0); t[1] = ld_d(c, Tin, 1); zero2(p); zero2(pt);
    __builtin_amdgcn_sched_barrier(0);
    mmf(t, aPT, bT); mmf(p, aPT, bP); mmf(pt, aP, bPT);
    st2(c, Tout, t); st2(c, Pout, p); st2(c, PTout, pt); }
}
__device__ __forceinline__ void ph_wkv_chunk(Frame& F) {
    using namespace wk;
    const bf16_t* PK = (const bf16_t*)(F.ws + WS_PK);
    bf16_t* YLOC = (bf16_t*)(F.ws + WS_YLOC); bf16_t* QH = (bf16_t*)(F.ws + WS_QH); bf16_t* PCH = (bf16_t*)(F.ws + WS_PCH); bf16_t* LCH = (bf16_t*)(F.ws + WS_LCH);
    LAS unsigned char* lds = F.lds;
    const int tid = F.tid, lane = F.lane, wave = F.wave, fr = lane & 15, fq = lane >> 4;
    Ctx c; c.lds = lds; c.am = wave >> 1; c.fbase = lds_byte(fr, 8 * fq); c.ai = 16 * (wave >> 1) + 4 * fq; c.b0i = 32 * (wave & 1) + fr;
    c.d0 = lds_byte(c.b0i, c.ai); c.d1 = lds_byte(c.b0i + 16, c.ai);
    constexpr int NIT = BATCH * NH * NCH;
    const LAS unsigned* raw32 = (const LAS unsigned*)(lds + O_RAW);
    LAS f32x2* segs2 = (LAS f32x2*)(lds + O_SEG);
    LAS float* wl = (LAS float*)(lds + O_WL);
    const int jp = tid & 31, sg = tid >> 5;
    v4u rg[6];
#define WC_LOAD(it_) do { const v4u* src_ = (const v4u*)(PK + (size_t)(it_) * 64 * 384); _Pragma("unroll") for (int q = 0; q < 6; ++q) rg[q] = src_[tid + NT * q]; } while (0)
    { const int i0 = F.bid < NIT ? F.bid : NIT - 1; WC_LOAD(i0); }
    __syncthreads();
#pragma unroll
    for (int q = 0; q < 6; ++q) *(LAS v4u*)(lds + O_RAW + (tid + NT * q) * 16) = rg[q];
    __syncthreads();
    for (int it = F.bid; it < NIT; it += F.G) {
        { const int nx = it + F.G < NIT ? it + F.G : it; WC_LOAD(nx); }
        f32x2 cs[4];
        { f32x2 run = (f32x2){0.f, 0.f};
#pragma unroll
          for (int i = 0; i < 4; ++i) { const unsigned w = raw32[(4 * sg + i) * 192 + 32 + jp]; run += (f32x2){bflo(w), bfhi(w)}; cs[i] = run; }
          segs2[sg * 32 + jp] = run; }
        __syncthreads();
        { unsigned rw[4], kw[4], aw[4], bw[4], vw[4];
#pragma unroll
          for (int i = 0; i < 4; ++i) { const LAS unsigned* rp = raw32 + (4 * sg + i) * 192 + jp; rw[i] = rp[0]; kw[i] = rp[64]; aw[i] = rp[96]; bw[i] = rp[128]; vw[i] = rp[160]; }
          f32x2 off = (f32x2){0.f, 0.f}, cl = off;
#pragma unroll
          for (int sgi = 0; sgi < 16; ++sgi) { const f32x2 v = segs2[sgi * 32 + jp]; cl += v; if (sgi < sg) off += v; }
          const f32x2 ecl = (f32x2){__expf(cl.x), __expf(cl.y)};
          if (sg == 0) *(LAS f32x2*)(wl + 2 * jp) = ecl;
          f32x2 ep = (f32x2){__expf(off.x), __expf(off.y)};
          f32x2 atv[4], bhv[4], khv[4];
          const int o0 = lds_byte(4 * sg, 2 * jp);
#pragma unroll
          for (int i = 0; i < 4; ++i) {
              const f32x2 cum = off + cs[i];
              const f32x2 eo = (f32x2){__expf(cum.x), __expf(cum.y)}, en = (f32x2){__builtin_amdgcn_rcpf(eo.x), __builtin_amdgcn_rcpf(eo.y)}, eh = ecl * en;
              const f32x2 r2 = (f32x2){bflo(rw[i]), bfhi(rw[i])}, k2 = (f32x2){bflo(kw[i]), bfhi(kw[i])}, a2 = (f32x2){bflo(aw[i]), bfhi(aw[i])}, b2 = (f32x2){bflo(bw[i]), bfhi(bw[i])};
              atv[i] = a2 * ep; bhv[i] = b2 * eh; khv[i] = k2 * eh; ep = eo;
              const f32x2 bt = b2 * en, kt = k2 * en, rt = r2 * eo;
              *(LAS unsigned*)(lds + O_At + o0 + 64 * i) = pg8::cvt_pk_bf16(atv[i].x, atv[i].y); *(LAS unsigned*)(lds + O_Bt + o0 + 64 * i) = pg8::cvt_pk_bf16(bt.x, bt.y);
              *(LAS unsigned*)(lds + O_Kt + o0 + 64 * i) = pg8::cvt_pk_bf16(kt.x, kt.y); *(LAS unsigned*)(lds + O_Rt + o0 + 64 * i) = pg8::cvt_pk_bf16(rt.x, rt.y); }
          const int ot = lds_byte(2 * jp, 4 * sg);
          *(LAS v2u*)(lds + O_ATr + ot) = (v2u){pg8::cvt_pk_bf16(atv[0].x, atv[1].x), pg8::cvt_pk_bf16(atv[2].x, atv[3].x)}; *(LAS v2u*)(lds + O_ATr + ot + 64) = (v2u){pg8::cvt_pk_bf16(atv[0].y, atv[1].y), pg8::cvt_pk_bf16(atv[2].y, atv[3].y)};
          *(LAS v2u*)(lds + O_BH + ot) = (v2u){pg8::cvt_pk_bf16(bhv[0].x, bhv[1].x), pg8::cvt_pk_bf16(bhv[2].x, bhv[3].x)}; *(LAS v2u*)(lds + O_BH + ot + 64) = (v2u){pg8::cvt_pk_bf16(bhv[0].y, bhv[1].y), pg8::cvt_pk_bf16(bhv[2].y, bhv[3].y)};
          *(LAS v2u*)(lds + O_KH + ot) = (v2u){pg8::cvt_pk_bf16(khv[0].x, khv[1].x), pg8::cvt_pk_bf16(khv[2].x, khv[3].x)}; *(LAS v2u*)(lds + O_KH + ot + 64) = (v2u){pg8::cvt_pk_bf16(khv[0].y, khv[1].y), pg8::cvt_pk_bf16(khv[2].y, khv[3].y)};
          *(LAS v2u*)(lds + O_VT + ot) = (v2u){(vw[0] & 0xffffu) | (vw[1] << 16), (vw[2] & 0xffffu) | (vw[3] << 16)}; *(LAS v2u*)(lds + O_VT + ot + 64) = (v2u){(vw[0] >> 16) | (vw[1] & 0xffff0000u), (vw[2] >> 16) | (vw[3] & 0xffff0000u)}; }
        __syncthreads();
        { const FA aB = lda(c, O_Bt), aA = lda(c, O_At), aK = lda(c, O_Kt); const FB bA = ldb(c, O_At), bB = ldb(c, O_Bt), bR = ldb(c, O_Rt);
          __builtin_amdgcn_sched_barrier(0);
          f4 nn[2], nt[2], ak[2], rb[2], rk[2]; zero2(nn); zero2(nt); zero2(ak); zero2(rb); zero2(rk);
          mmf(nn, aB, bA); mmf(nt, aA, bB); mmf(ak, aK, bA); mmf(rb, aB, bR); mmf(rk, aK, bR);
#pragma unroll
          for (int n = 0; n < 2; ++n) { const f4 m = tri<0>(c, n, nn[n]); st_d(c, O_N, n, m);
              const int b = c.b0i + 16 * n; f4 t1;
#pragma unroll
              for (int r = 0; r < 4; ++r) t1[r] = (c.ai + r == b) ? 1.f : m[r];
              st_d(c, O_T0, n, t1); }
          st2tri<2>(c, O_NT, nt); st2tri<0>(c, O_Aak, ak); st2tri<1>(c, O_Arb, rb); st2tri<1>(c, O_Ark, rk); }
        __syncthreads();
        { const FA aNT = lda(c, O_NT), aN = lda(c, O_N), aAk = lda(c, O_Aak); const FB bN = ldb(c, O_N), bNT = ldb(c, O_NT), bV = ldb(c, O_VT);
          __builtin_amdgcn_sched_barrier(0);
          f4 p[2], pt[2], z[2]; zero2(p); zero2(pt); zero2(z);
          mmf(p, aNT, bN); mmf(pt, aN, bNT); mmf(z, aAk, bV);
          st2(c, O_At, p); st2(c, O_Bt, pt); st2(c, O_Z1T, z); }
        __syncthreads();
        chain_stage(c, O_At, O_Bt, O_N, O_NT, O_T0, O_Kt);
        __syncthreads();
        chain_stage(c, O_N, O_NT, O_At, O_Bt, O_Kt, O_T0);
        __syncthreads();
        chain_stage(c, O_At, O_Bt, O_N, O_NT, O_T0, O_Kt);
        __syncthreads();
        { const FA aPT = lda(c, O_NT), aP = lda(c, O_N); const FB bT = ldb(c, O_Kt), bPT = ldb(c, O_NT);
          f4 t[2], pt[2]; t[0] = ld_d(c, O_Kt, 0); t[1] = ld_d(c, O_Kt, 1); zero2(pt);
          __builtin_amdgcn_sched_barrier(0);
          mmf(t, aPT, bT); mmf(pt, aP, bPT);
          st2(c, O_T0, t); st2(c, O_Bt, pt); }
        __syncthreads();
        { const FA aPT = lda(c, O_Bt); const FB bT = ldb(c, O_T0); f4 t[2]; t[0] = ld_d(c, O_T0, 0); t[1] = ld_d(c, O_T0, 1);
          mmf(t, aPT, bT); st2(c, O_Kt, t); }
        __syncthreads();
        { const FA aT = lda(c, O_Kt); const FB bZ = ldb(c, O_Z1T), bAT = ldb(c, O_ATr);
          f4 u[2], g[2]; zero2(u); zero2(g);
          mmf(u, aT, bZ); mmf(g, aT, bAT);
          st2(c, O_UT, u); st2(c, O_GT, g); }
        __syncthreads();
        { const int bh = it >> 5, ch = it & 31;
          const size_t row0 = (size_t)bh * SEQ + ch * 64;
          const FA aG = lda(c, O_GT), aU = lda(c, O_UT), aV = lda(c, O_VT), aBH = lda(c, O_BH), aKH = lda(c, O_KH);
          const FB bRb = ldb(c, O_Arb), bRk = ldb(c, O_Ark), bBH = ldb(c, O_BH), bU = ldb(c, O_UT), bV = ldb(c, O_VT);
          f4 q[2], y[2], pm[2], lc[2]; q[0] = ld_d(c, O_Rt, 0); q[1] = ld_d(c, O_Rt, 1); zero2(y); zero2(pm); zero2(lc);
          const float w0 = wl[c.b0i], w1 = wl[c.b0i + 16];
          __builtin_amdgcn_sched_barrier(0);
          mmf(q, aG, bRb);
          mmf(y, aU, bRb); mmf(y, aV, bRk);
          mmf(pm, aG, bBH);
          mmf(lc, aBH, bU); mmf(lc, aKH, bV);
#pragma unroll
          for (int n = 0; n < 2; ++n) { const int b = c.b0i + 16 * n;
              *(v2u*)(QH + (row0 + b) * 64 + c.ai) = (v2u){pg8::cvt_pk_bf16(q[n][0], q[n][1]), pg8::cvt_pk_bf16(q[n][2], q[n][3])};
              *(v2u*)(YLOC + (row0 + b) * 64 + c.ai) = (v2u){pg8::cvt_pk_bf16(y[n][0], y[n][1]), pg8::cvt_pk_bf16(y[n][2], y[n][3])};
              f4 o = pm[n]; const float wd = n ? w1 : w0;
#pragma unroll
              for (int r = 0; r < 4; ++r) o[r] += (c.ai + r == b) ? wd : 0.f;
              *(v2u*)(PCH + (size_t)it * 4096 + b * 64 + c.ai) = (v2u){pg8::cvt_pk_bf16(o[0], o[1]), pg8::cvt_pk_bf16(o[2], o[3])};
              *(v2u*)(LCH + (size_t)it * 4096 + b * 64 + c.ai) = (v2u){pg8::cvt_pk_bf16(lc[n][0], lc[n][1]), pg8::cvt_pk_bf16(lc[n][2], lc[n][3])}; } }
        __syncthreads();
#pragma unroll
        for (int q = 0; q < 6; ++q) *(LAS v4u*)(lds + O_RAW + (tid + NT * q) * 16) = rg[q];
        __syncthreads();
    }
#undef WC_LOAD
    __syncthreads();
}
__device__ __forceinline__ void wkv_carry_bh(Frame& F, const int bh) {
    using namespace wk;
    const bf16_t* PT = (const bf16_t*)(F.ws + WS_PCH) + (size_t)bh * NCH * 4096;
    const bf16_t* LC = (const bf16_t*)(F.ws + WS_LCH) + (size_t)bh * NCH * 4096;
    bf16_t* SST = (bf16_t*)(F.ws + WS_SST) + (size_t)bh * NCH * 4096;
    const int lane = F.lane, wave = F.wave, fr = lane & 15, fq = lane >> 4;
    Ctx c; c.lds = F.lds; c.am = wave >> 1; c.fbase = lds_byte(fr, 8 * fq); c.ai = 16 * (wave >> 1) + 4 * fq; c.b0i = 32 * (wave & 1) + fr;
    c.d0 = lds_byte(c.b0i, c.ai); c.d1 = lds_byte(c.b0i + 16, c.ai);
    __syncthreads();
    { const f4 z = (f4){0.f, 0.f, 0.f, 0.f};
#pragma unroll
      for (int n = 0; n < 2; ++n) { st_d(c, 0, n, z); st_d(c, AB, n, z); *(v2u*)(SST + (c.b0i + 16 * n) * 64 + c.ai) = (v2u){0u, 0u}; } }
    const int pofs = (16 * c.am + fr) * 64 + 8 * fq;
    bf16x8 pa0 = *(const bf16x8*)(PT + pofs), pa1 = *(const bf16x8*)(PT + pofs + 32);
    v2u lv0 = *(const v2u*)(LC + c.b0i * 64 + c.ai), lv1 = *(const v2u*)(LC + (c.b0i + 16) * 64 + c.ai);
    __syncthreads();
    for (int ch = 0; ch < NCH - 1; ++ch) {
        const int cur = (ch & 1) * 2 * AB, nxt = 2 * AB - cur;
        const FB sh = ldb(c, cur), sl = ldb(c, cur + AB);
        FA a; a.v[0] = pa0; a.v[1] = pa1;
        f4 acc[2]; acc[0] = (f4){bflo(lv0.x), bfhi(lv0.x), bflo(lv0.y), bfhi(lv0.y)}; acc[1] = (f4){bflo(lv1.x), bfhi(lv1.x), bflo(lv1.y), bfhi(lv1.y)};
        { const int cn = ch + 1 < NCH - 1 ? ch + 1 : NCH - 2;
          const bf16_t* pn = PT + (size_t)cn * 4096; const bf16_t* ln = LC + (size_t)cn * 4096;
          pa0 = *(const bf16x8*)(pn + pofs); pa1 = *(const bf16x8*)(pn + pofs + 32);
          lv0 = *(const v2u*)(ln + c.b0i * 64 + c.ai); lv1 = *(const v2u*)(ln + (c.b0i + 16) * 64 + c.ai); }
        mmf(acc, a, sh); mmf(acc, a, sl);
        bf16_t* so = SST + (size_t)(ch + 1) * 4096;
#pragma unroll
        for (int n = 0; n < 2; ++n) { const f4 d = acc[n];
            const v2u hi = (v2u){pg8::cvt_pk_bf16(d[0], d[1]), pg8::cvt_pk_bf16(d[2], d[3])};
            const f4 lo = (f4){d[0] - bflo(hi.x), d[1] - bfhi(hi.x), d[2] - bflo(hi.y), d[3] - bfhi(hi.y)};
            *(LAS v2u*)(c.lds + nxt + (n ? c.d1 : c.d0)) = hi; st_d(c, nxt + AB, n, lo);
            *(v2u*)(so + (c.b0i + 16 * n) * 64 + c.ai) = hi; }
        __syncthreads();
    }
    __syncthreads();
}
struct PostIn { pg8::bf16x8 qf[2], sf[4][2]; v2u yw[4], rr[4], kk[4], vv[4], gg[4]; };
__device__ __forceinline__ void ph_wkv_post(Frame& F) {
    using pg8::bf16x8;
    typedef float f4 __attribute__((ext_vector_type(4)));
    const bf16_t* PK = (const bf16_t*)(F.ws + WS_PK);
    const bf16_t* GB = (const bf16_t*)(F.ws + WS_G);
    const bf16_t* YLOC = (const bf16_t*)(F.ws + WS_YLOC);
    const bf16_t* QH = (const bf16_t*)(F.ws + WS_QH);
    const bf16_t* SST = (const bf16_t*)(F.ws + WS_SST);
    bf16_t* YC = (bf16_t*)(F.ws + WS_YCAT);
    const int lane = F.lane, wave = F.wave, fr = lane & 15, fq = lane >> 4;
    constexpr int NI = BATCH * NH * 16;
#define POST_LOAD(R, item_) do { const int it_ = (item_); const int bh_ = it_ >> 4, ch_ = it_ & 15, b_ = bh_ / NH, h_ = bh_ % NH; const int tl_ = ch_ * 128 + 16 * wave + fr; \
        const size_t ro_ = (size_t)bh_ * SEQ + tl_, tg_ = (size_t)b_ * SEQ + tl_; const bf16_t* pk_ = PK + ro_ * 384 + 4 * fq; \
        _Pragma("unroll") for (int ks = 0; ks < 2; ++ks) R.qf[ks] = *(const bf16x8*)(QH + ro_ * 64 + 32 * ks + 8 * fq); \
        _Pragma("unroll") for (int m = 0; m < 4; ++m) { \
            _Pragma("unroll") for (int ks = 0; ks < 2; ++ks) R.sf[m][ks] = *(const bf16x8*)(SST + ((size_t)it_ * 2 + (wave >> 2)) * 4096 + (16 * m + fr) * 64 + 32 * ks + 8 * fq); \
            R.yw[m] = *(const v2u*)(YLOC + ro_ * 64 + 16 * m + 4 * fq); R.rr[m] = *(const v2u*)(pk_ + 16 * m); R.kk[m] = *(const v2u*)(pk_ + 128 + 16 * m); R.vv[m] = *(const v2u*)(pk_ + 320 + 16 * m); \
            R.gg[m] = *(const v2u*)(GB + tg_ * C + h_ * HD + 16 * m + 4 * fq); } } while (0)
    PostIn cur;
    { const int i0 = F.bid < NI ? F.bid : NI - 1; POST_LOAD(cur, i0); }
    for (int item = F.bid; item < NI; item += F.G) {
        const int bh = item >> 4, ch = item & 15, b = bh / NH, h = bh % NH;
        const int tl = ch * 128 + 16 * wave + fr;
        const size_t tg = (size_t)b * SEQ + tl;
        PostIn nx;
        { const int nxi = item + F.G < NI ? item + F.G : item; POST_LOAD(nx, nxi); }
        f4 yv[4], lg[4], lb[4], rkv[4];
#pragma unroll
        for (int m = 0; m < 4; ++m) { const int c0 = h * HD + 16 * m + 4 * fq;
            yv[m] = (f4){bflo(cur.yw[m].x), bfhi(cur.yw[m].x), bflo(cur.yw[m].y), bfhi(cur.yw[m].y)};
            lg[m] = *(const f4*)(F.a->in[I_LNXG] + c0); lb[m] = *(const f4*)(F.a->in[I_LNXB] + c0); rkv[m] = *(const f4*)(F.a->in[I_RK] + c0); }
#pragma unroll
        for (int m = 0; m < 4; ++m) { f4 acc = (f4){0.f, 0.f, 0.f, 0.f};
#pragma unroll
            for (int ks = 0; ks < 2; ++ks) acc = __builtin_amdgcn_mfma_f32_16x16x32_bf16(cur.sf[m][ks], cur.qf[ks], acc, 0, 0, 0);
            yv[m] += acc; }
        float sm = 0.f;
#pragma unroll
        for (int m = 0; m < 4; ++m) sm += (yv[m].x + yv[m].y) + (yv[m].z + yv[m].w);
        sm += __shfl_xor(sm, 16); sm += __shfl_xor(sm, 32);
        const float mu = sm * (1.f / HD);
        float s2 = 0.f, bn = 0.f;
#pragma unroll
        for (int m = 0; m < 4; ++m) { yv[m] = yv[m] - mu; s2 += (yv[m].x * yv[m].x + yv[m].y * yv[m].y) + (yv[m].z * yv[m].z + yv[m].w * yv[m].w);
            bn += bflo(cur.rr[m].x) * bflo(cur.kk[m].x) * rkv[m].x + bfhi(cur.rr[m].x) * bfhi(cur.kk[m].x) * rkv[m].y + bflo(cur.rr[m].y) * bflo(cur.kk[m].y) * rkv[m].z + bfhi(cur.rr[m].y) * bfhi(cur.kk[m].y) * rkv[m].w; }
        s2 += __shfl_xor(s2, 16); s2 += __shfl_xor(s2, 32);
        bn += __shfl_xor(bn, 16); bn += __shfl_xor(bn, 32);
        const float rstd = 1.f / sqrtf(s2 * (1.f / HD) + GN_EPS);
#pragma unroll
        for (int m = 0; m < 4; ++m) { const int c0 = h * HD + 16 * m + 4 * fq;
            const float o0 = (yv[m].x * rstd * lg[m].x + lb[m].x + bn * bflo(cur.vv[m].x)) * bflo(cur.gg[m].x), o1 = (yv[m].y * rstd * lg[m].y + lb[m].y + bn * bfhi(cur.vv[m].x)) * bfhi(cur.gg[m].x);
            const float o2 = (yv[m].z * rstd * lg[m].z + lb[m].z + bn * bflo(cur.vv[m].y)) * bflo(cur.gg[m].y), o3 = (yv[m].w * rstd * lg[m].w + lb[m].w + bn * bfhi(cur.vv[m].y)) * bfhi(cur.gg[m].y);
            *(v2u*)(YC + tg * D + c0) = (v2u){pg8::cvt_pk_bf16(o0, o1), pg8::cvt_pk_bf16(o2, o3)}; }
        cur = nx;
    }
#undef POST_LOAD
    __syncthreads();
}
__device__ __forceinline__ void ph_sb_attn_naive(Frame& F) {
    const bf16_t* P = (const bf16_t*)(F.ws + WS_PROJ);
    bf16_t* YC = (bf16_t*)(F.ws + WS_YCAT);
    LAS float* qs = (LAS float*)F.lds + F.wave * 256;
    LAS float* as = qs + 128;
    const int gw = F.bid * NWAVES + F.wave, NGW = F.G * NWAVES, lane = F.lane;
    const float scale = 0.08838834764831845f;
    for (int it = gw; it < T * SBH; it += NGW) {
        const int t = it >> 2, hh = it & 3, b = t / SEQ, tl = t % SEQ;
        const bf16_t* qp = P + (size_t)t * PLD + COL_SBQ + hh * SBD;
        wave_lds_sync();
        qs[lane] = bf2f(qp[lane]); qs[64 + lane] = bf2f(qp[64 + lane]);
        wave_lds_sync();
        float o0 = 0.f, o1 = 0.f, carry = 0.f;
        const int nkb = (tl + 63) >> 6;
        for (int kb = nkb - 1; kb >= 0; --kb) {
            const int s = kb * 64 + lane; const bool valid = s < tl;
            float z = 0.f;
            if (valid) {
                const bf16_t* kp = P + (size_t)(b * SEQ + s) * PLD + COL_SBK + hh * SBD;
#pragma unroll 4
                for (int d = 0; d < SBD; d += 8) { const v4u kv = *(const v4u*)(kp + d); const f32x4 q0 = *(const LAS f32x4*)(qs + d), q1 = *(const LAS f32x4*)(qs + d + 4);
                    z += q0.x * bflo(kv.x) + q0.y * bfhi(kv.x) + q0.z * bflo(kv.y) + q0.w * bfhi(kv.y) + q1.x * bflo(kv.z) + q1.y * bfhi(kv.z) + q1.z * bflo(kv.w) + q1.w * bfhi(kv.w); }
            }
            z *= scale;
            const float sp = softplusf(z);
            const float lk = valid ? -sp : 0.f;
            float x = lk;
#pragma unroll
            for (int o = 1; o < 64; o <<= 1) { const float y = __shfl_down(x, o); if (lane + o < 64) x += y; }
            const float excl = x - lk;
            const float attn = valid ? expf(z - sp + carry + excl) : 0.f;
            carry += __shfl(x, 0);
            wave_lds_sync();
            as[lane] = attn;
            wave_lds_sync();
            const bf16_t* vp = P + (size_t)(b * SEQ + kb * 64) * PLD + COL_SBV + hh * SBD + 2 * lane;
            const int nv = min(64, tl - kb * 64);
            for (int j = 0; j < nv; ++j) { const float a = as[j]; const unsigned vv = *(const unsigned*)(vp + (size_t)j * PLD); o0 += a * bflo(vv); o1 += a * bfhi(vv); }
        }
        *(unsigned*)(YC + (size_t)t * D + C + hh * SBD + 2 * lane) = pk2(o0, o1);
    }
}
__device__ __forceinline__ void vt_tile(const bf16_t* src, int ld, bf16_t* dst, int dld, LAS bf16_t* tl, int lane) {
    constexpr int RS = 136;
#pragma unroll 4
    for (int i = 0; i < 16; ++i) { const int row = i * 4 + (lane >> 4), ch = lane & 15;
        *(LAS v4u*)(tl + row * RS + ch * 8) = *(const v4u*)(src + (size_t)row * ld + ch * 8); }
    wave_lds_sync();
#pragma unroll 4
    for (int it = 0; it < 16; ++it) { const int o = it * 64 + lane, d = o >> 3, ch = o & 7, sgrp = ch >> 2, fqq = ch & 3;
        const LAS bf16_t* c0 = tl + (32 * sgrp + 4 * fqq) * RS + d;
        v4u w;
        w.x = (unsigned)c0[0 * RS] | ((unsigned)c0[1 * RS] << 16); w.y = (unsigned)c0[2 * RS] | ((unsigned)c0[3 * RS] << 16);
        w.z = (unsigned)c0[16 * RS] | ((unsigned)c0[17 * RS] << 16); w.w = (unsigned)c0[18 * RS] | ((unsigned)c0[19 * RS] << 16);
        *(v4u*)(dst + (size_t)d * dld + 8 * ch) = w; }
    wave_lds_sync();
}
__device__ __forceinline__ void ph_vt(Frame& F) {
    const bf16_t* P = (const bf16_t*)(F.ws + WS_PROJ);
    const bf16_t* MKV = (const bf16_t*)(F.ws + WS_MEMKV);
    bf16_t* VTSB = (bf16_t*)(F.ws + WS_VTSB);
    bf16_t* VTMEM = (bf16_t*)(F.ws + WS_VTMEM);
    LAS bf16_t* tl = (LAS bf16_t*)(F.lds + F.wave * 17408);
    const int gw = F.bid * NWAVES + F.wave, NGW = F.G * NWAVES;
    constexpr int N_SB = BATCH * SBH * (SEQ / 64), N_MEM = BATCH * MEMH * (MEML / 64);
    for (int it = gw; it < N_SB + N_MEM; it += NGW) {
        if (it < N_SB) { const int kt = it % (SEQ / 64), bh = it / (SEQ / 64), b = bh / SBH, h = bh % SBH;
            vt_tile(P + (size_t)(b * SEQ + kt * 64) * PLD + COL_SBV + h * SBD, PLD, VTSB + (size_t)bh * SBD * SEQ + kt * 64, SEQ, tl, F.lane); }
        else { const int j = it - N_SB, kt = j % (MEML / 64), bh = j / (MEML / 64), b = bh / MEMH, h = bh % MEMH;
            vt_tile(MKV + (size_t)(b * MEML + kt * 64) * (2 * MEMW) + MEMW + h * MEMD, 2 * MEMW, VTMEM + (size_t)bh * MEMD * MEML + kt * 64, MEML, tl, F.lane); }
    }
    __syncthreads();
}
__device__ __forceinline__ void sb_item(Frame& F, const int b, const int h, const int jq, bf16_t* OUT, const int old_, const int ocol) {
    using pg8::bf16x8; using pg8::lds_byte;
    typedef float f4 __attribute__((ext_vector_type(4)));
    const bf16_t* P = (const bf16_t*)(F.ws + WS_PROJ);
    const bf16_t* VT = (const bf16_t*)(F.ws + WS_VTSB) + (size_t)(b * SBH + h) * SBD * SEQ;
    LAS unsigned char* lds = F.lds;
    const int tid = F.tid, lane = F.lane, wave = F.wave, hf = wave >> 2, qg = wave & 3, fr = lane & 15, fq = lane >> 4, ht = tid & 255;
    const int nt = jq + 1, nh = (nt + 1) >> 1, nl = nt - nh;
    const int my_n = hf ? nl : nh, kt0 = hf ? (jq - nh) : jq;
    const float scale = 0.08838834764831845f * 1.4426950408889634f;
    const bf16_t* kbase = P + (size_t)(b * SEQ) * PLD + COL_SBK + h * SBD;
    int kwoff[4], vwoff[4]; size_t ksrc[4], vsrc[4];
#pragma unroll
    for (int i = 0; i < 4; ++i) { const int pp = ht + 256 * i, r = pp >> 4, c = pp & 15;
        kwoff[i] = (c >> 3) * 8192 + lds_byte(r, (c & 7) * 8); ksrc[i] = (size_t)r * PLD + 8 * c;
        const int d = pp >> 3, c2 = pp & 7;
        vwoff[i] = lds_byte(d, 8 * c2); vsrc[i] = (size_t)d * SEQ + 8 * c2; }
    const int fbase = lds_byte(fr, 8 * fq);
    bf16x8 qf[4];
    { const bf16_t* qp = P + (size_t)(b * SEQ + 64 * jq + 16 * qg + fr) * PLD + COL_SBQ + h * SBD + 8 * fq;
#pragma unroll
      for (int kk = 0; kk < 4; ++kk) qf[kk] = *(const bf16x8*)(qp + 32 * kk); }
    f4 acc_o[8];
#pragma unroll
    for (int i = 0; i < 8; ++i) acc_o[i] = (f4){0.f, 0.f, 0.f, 0.f};
    float carry = 0.f;
    v4u rk[4], rv[4];
#define SB_LOAD(stp) do { const int _kt = kt0 - (stp); _Pragma("unroll") for (int i = 0; i < 4; ++i) { rk[i] = *(const v4u*)(kbase + (size_t)_kt * 64 * PLD + ksrc[i]); rv[i] = *(const v4u*)(VT + (size_t)_kt * 64 + vsrc[i]); } } while (0)
#define SB_WRITE(stg) do { LAS unsigned char* _b = lds + ((stg) * 2 + hf) * 32768; _Pragma("unroll") for (int i = 0; i < 4; ++i) { *(LAS v4u*)(_b + kwoff[i]) = rk[i]; *(LAS v4u*)(_b + 16384 + vwoff[i]) = rv[i]; } } while (0)
    if (0 < my_n) { SB_LOAD(0); SB_WRITE(0); }
    if (1 < my_n) SB_LOAD(1);
    __syncthreads();
    for (int st = 0; st < nh; ++st) {
        if (st < my_n) {
            const LAS unsigned char* kb = lds + ((st & 1) * 2 + hf) * 32768;
            const LAS unsigned char* vb = kb + 16384;
            f4 sc[4];
#pragma unroll
            for (int i = 0; i < 4; ++i) { sc[i] = (f4){0.f, 0.f, 0.f, 0.f};
#pragma unroll
                for (int kk = 0; kk < 4; ++kk) { const bf16x8 kf = *(const LAS bf16x8*)(kb + fbase + i * 2048 + (kk & 1) * 1024 + (kk >> 1) * 8192);
                    sc[i] = __builtin_amdgcn_mfma_f32_16x16x32_bf16(kf, qf[kk], sc[i], 0, 0, 0); } }
            const bool diag = (hf == 0) && (st == 0);
            float av[4][4], tt[4], xx[4];
#pragma unroll
            for (int i = 0; i < 4; ++i) {
                float lk[4];
#pragma unroll
                for (int r = 0; r < 4; ++r) { float z = sc[i][r] * scale; const float e = __builtin_amdgcn_exp2f(-fabsf(z)); float l = -(fmaxf(z, 0.f) + __builtin_amdgcn_logf(1.f + e));
                    if (diag && !((16 * i + 4 * fq + r) < (16 * qg + fr))) { l = 0.f; z = -1.0e30f; }
                    lk[r] = l; sc[i][r] = z; }
                av[i][3] = lk[3]; av[i][2] = lk[2] + av[i][3]; av[i][1] = lk[1] + av[i][2]; av[i][0] = lk[0] + av[i][1];
                const float tot = av[i][0], u = __shfl_xor(tot, 16), t1 = tot + u, v = __shfl_xor(t1, 32);
                tt[i] = t1 + v; xx[i] = ((fq & 1) ? 0.f : u) + ((fq & 2) ? 0.f : v);
            }
            const float y2 = tt[3], y1 = y2 + tt[2], y0 = y1 + tt[1], total = y0 + tt[0];
            xx[0] += y0 + carry; xx[1] += y1 + carry; xx[2] += y2 + carry; xx[3] += carry;
            carry += total;
            bf16x8 pf[2];
#pragma unroll
            for (int sg2 = 0; sg2 < 2; ++sg2) {
                float pv[8];
#pragma unroll
                for (int a = 0; a < 2; ++a)
#pragma unroll
                    for (int r = 0; r < 4; ++r) pv[4 * a + r] = __builtin_amdgcn_exp2f(sc[2 * sg2 + a][r] + av[2 * sg2 + a][r] + xx[2 * sg2 + a]);
                v4u w; w.x = pg8::cvt_pk_bf16(pv[0], pv[1]); w.y = pg8::cvt_pk_bf16(pv[2], pv[3]); w.z = pg8::cvt_pk_bf16(pv[4], pv[5]); w.w = pg8::cvt_pk_bf16(pv[6], pv[7]);
                pf[sg2] = __builtin_bit_cast(bf16x8, w);
            }
#pragma unroll
            for (int ds = 0; ds < 8; ++ds)
#pragma unroll
                for (int sg2 = 0; sg2 < 2; ++sg2) { const bf16x8 vf = *(const LAS bf16x8*)(vb + fbase + ds * 2048 + sg2 * 1024);
                    acc_o[ds] = __builtin_amdgcn_mfma_f32_16x16x32_bf16(vf, pf[sg2], acc_o[ds], 0, 0, 0); }
        }
        if (st + 1 < my_n) SB_WRITE((st + 1) & 1);
        if (st + 2 < my_n) SB_LOAD(st + 2);
        __syncthreads();
    }
#undef SB_LOAD
#undef SB_WRITE
    LAS float* xb = (LAS float*)lds + qg * 2048;
    if (hf) {
#pragma unroll
        for (int ds = 0; ds < 8; ++ds)
#pragma unroll
            for (int r = 0; r < 4; ++r) xb[(ds * 4 + r) * 64 + lane] = acc_o[ds][r];
    }
    __syncthreads();
    if (!hf) {
        const float ec = __builtin_amdgcn_exp2f(carry);
        bf16_t* op = OUT + (size_t)(b * SEQ + 64 * jq + 16 * qg + fr) * old_ + ocol + h * SBD + 4 * fq;
#pragma unroll
        for (int ds = 0; ds < 8; ++ds) { float o[4];
#pragma unroll
            for (int r = 0; r < 4; ++r) o[r] = acc_o[ds][r] + ec * xb[(ds * 4 + r) * 64 + lane];
            *(v2u*)(op + 16 * ds) = (v2u){pg8::cvt_pk_bf16(o[0], o[1]), pg8::cvt_pk_bf16(o[2], o[3])}; }
    }
    __syncthreads();
}
#if DBG
__device__ __forceinline__ void dbg_max(Frame& F, int slot, float v) { if (v > 0.f) atomicMax(F.ctl + CW_DBG + slot, __builtin_bit_cast(unsigned, v)); }
__device__ __forceinline__ void ph_dbg_check(Frame& F) {
    const bf16_t* P = (const bf16_t*)(F.ws + WS_PROJ);
    const bf16_t* VTSB = (const bf16_t*)(F.ws + WS_VTSB);
    const bf16_t* YC = (const bf16_t*)(F.ws + WS_YCAT);
    const bf16_t* DB = (const bf16_t*)(F.ws + WS_DBG);
    const size_t gt = (size_t)F.bid * NT + F.tid, GT = (size_t)F.G * NT;
    float ea = 0.f;
    for (size_t i = gt; i < (size_t)BATCH * SBH * SBD * SEQ; i += GT) {
        const int pos = (int)(i % SEQ), d = (int)((i / SEQ) % SBD), bh = (int)(i / ((size_t)SEQ * SBD)), b = bh / SBH, h = bh % SBH;
        const int s32 = pos >> 5, q = pos & 31, fqq = q >> 3, a = (q >> 2) & 1, r = q & 3, key = 32 * s32 + 16 * a + 4 * fqq + r;
        const float e = fabsf(bf2f(VTSB[i]) - bf2f(P[(size_t)(b * SEQ + key) * PLD + COL_SBV + h * SBD + d]));
        ea = fmaxf(ea, e);
    }
    dbg_max(F, 0, ea);
    float eb = 0.f, ec = 0.f, ed = 0.f, ee = 0.f;
    for (size_t i = gt; i < (size_t)T * SBW; i += GT) {
        const int t = (int)(i / SBW), c = (int)(i % SBW), jq = (t % SEQ) >> 6;
        const float e = fabsf(bf2f(DB[i]) - bf2f(YC[(size_t)t * D + C + c]));
        if (jq == 0) eb = fmaxf(eb, e); else if (jq == 1) ec = fmaxf(ec, e); else if (jq < 4) ed = fmaxf(ed, e); else ee = fmaxf(ee, e);
    }
    dbg_max(F, 1, eb); dbg_max(F, 2, ec); dbg_max(F, 3, ed); dbg_max(F, 4, ee);
}
#endif
__device__ __forceinline__ void mem_item(Frame& F, const int it) {
    using pg8::bf16x8; using pg8::lds_byte;
    typedef float f4 __attribute__((ext_vector_type(4)));
    const bf16_t* P = (const bf16_t*)(F.ws + WS_PROJ);
    const bf16_t* MKV = (const bf16_t*)(F.ws + WS_MEMKV);
    const bf16_t* VTM = (const bf16_t*)(F.ws + WS_VTMEM);
    bf16_t* YC = (bf16_t*)(F.ws + WS_YCAT);
    LAS unsigned char* lds = F.lds;
    const int tid = F.tid, lane = F.lane, wave = F.wave, fr = lane & 15, fq = lane >> 4;
    const float scale = 0.08838834764831845f;
    const int fbase = lds_byte(fr, 8 * fq);
    {
        const int qt = it & 15, bh = it >> 4, b = bh / MEMH, h = bh % MEMH;
        __syncthreads();
#pragma unroll
        for (int t = 0; t < 4; ++t)
#pragma unroll
            for (int i = 0; i < 2; ++i) { const int pp = tid + 512 * i, r = pp >> 4, c = pp & 15, d = pp >> 3, c2 = pp & 7;
                const v4u kv = *(const v4u*)(MKV + (size_t)(b * MEML + 64 * t + r) * (2 * MEMW) + h * MEMD + 8 * c);
                const v4u vv = *(const v4u*)(VTM + ((size_t)bh * MEMD + d) * MEML + 64 * t + 8 * c2);
                *(LAS v4u*)(lds + t * 16384 + (c >> 3) * 8192 + lds_byte(r, (c & 7) * 8)) = kv;
                *(LAS v4u*)(lds + 65536 + t * 16384 + lds_byte(d, 8 * c2)) = vv; }
        bf16x8 qf[4];
        const int q = b * SEQ + 128 * qt + 16 * wave + fr;
        { const bf16_t* qp = P + (size_t)q * PLD + COL_QM + h * MEMD + 8 * fq;
#pragma unroll
          for (int kk = 0; kk < 4; ++kk) qf[kk] = *(const bf16x8*)(qp + 32 * kk); }
        __syncthreads();
        f4 sc[16];
#pragma unroll
        for (int ti = 0; ti < 16; ++ti) { sc[ti] = (f4){0.f, 0.f, 0.f, 0.f};
#pragma unroll
            for (int kk = 0; kk < 4; ++kk) { const bf16x8 kf = *(const LAS bf16x8*)(lds + (ti >> 2) * 16384 + fbase + (ti & 3) * 2048 + (kk & 1) * 1024 + (kk >> 1) * 8192);
                sc[ti] = __builtin_amdgcn_mfma_f32_16x16x32_bf16(kf, qf[kk], sc[ti], 0, 0, 0); } }
        float mx = -3.0e38f;
#pragma unroll
        for (int ti = 0; ti < 16; ++ti)
#pragma unroll
            for (int r = 0; r < 4; ++r) { sc[ti][r] *= scale * 1.4426950408889634f; mx = fmaxf(mx, sc[ti][r]); }
        mx = fmaxf(mx, __shfl_xor(mx, 16)); mx = fmaxf(mx, __shfl_xor(mx, 32));
        float sum = 0.f;
#pragma unroll
        for (int ti = 0; ti < 16; ++ti)
#pragma unroll
            for (int r = 0; r < 4; ++r) { sc[ti][r] = __builtin_amdgcn_exp2f(sc[ti][r] - mx); sum += sc[ti][r]; }
        sum += __shfl_xor(sum, 16); sum += __shfl_xor(sum, 32);
        const float inv = 1.f / sum;
        f4 acc_o[8];
#pragma unroll
        for (int ds = 0; ds < 8; ++ds) acc_o[ds] = (f4){0.f, 0.f, 0.f, 0.f};
#pragma unroll
        for (int ks = 0; ks < 8; ++ks) {
            v4u w; w.x = pg8::cvt_pk_bf16(sc[2 * ks][0], sc[2 * ks][1]); w.y = pg8::cvt_pk_bf16(sc[2 * ks][2], sc[2 * ks][3]);
            w.z = pg8::cvt_pk_bf16(sc[2 * ks + 1][0], sc[2 * ks + 1][1]); w.w = pg8::cvt_pk_bf16(sc[2 * ks + 1][2], sc[2 * ks + 1][3]);
            const bf16x8 pf = __builtin_bit_cast(bf16x8, w);
#pragma unroll
            for (int ds = 0; ds < 8; ++ds) { const bf16x8 vf = *(const LAS bf16x8*)(lds + 65536 + (ks >> 1) * 16384 + fbase + ds * 2048 + (ks & 1) * 1024);
                acc_o[ds] = __builtin_amdgcn_mfma_f32_16x16x32_bf16(vf, pf, acc_o[ds], 0, 0, 0); }
        }
        bf16_t* op = YC + (size_t)q * D + C + SBW + h * MEMD + 4 * fq;
#pragma unroll
        for (int ds = 0; ds < 8; ++ds)
            *(v2u*)(op + 16 * ds) = (v2u){pg8::cvt_pk_bf16(acc_o[ds][0] * inv, acc_o[ds][1] * inv), pg8::cvt_pk_bf16(acc_o[ds][2] * inv, acc_o[ds][3] * inv)};
    }
    __syncthreads();
}
__device__ __forceinline__ void sb128_item(Frame& F, const int b, const int h, const int jt) {
    using pg8::bf16x8; using pg8::lds_byte;
    typedef float f4 __attribute__((ext_vector_type(4)));
    const bf16_t* P = (const bf16_t*)(F.ws + WS_PROJ);
    const bf16_t* VT = (const bf16_t*)(F.ws + WS_VTSB) + (size_t)(b * SBH + h) * SBD * SEQ;
    bf16_t* YC = (bf16_t*)(F.ws + WS_YCAT);
    LAS unsigned char* lds = F.lds;
    volatile LAS float* cmax = (volatile LAS float*)(lds + 65536);
    const int tid = F.tid, lane = F.lane, wave = F.wave, fr = lane & 15, fq = lane >> 4;
    const float scale = 0.08838834764831845f * 1.4426950408889634f;
    const bf16_t* kbase = P + (size_t)(b * SEQ) * PLD + COL_SBK + h * SBD;
    int kwoff[2], vwoff[2]; size_t ksrc[2], vsrc[2];
#pragma unroll
    for (int i = 0; i < 2; ++i) { const int pp = tid + 512 * i, r = pp >> 4, c = pp & 15;
        kwoff[i] = (c >> 3) * 8192 + lds_byte(r, (c & 7) * 8); ksrc[i] = (size_t)r * PLD + 8 * c;
        const int d = pp >> 3, c2 = pp & 7;
        vwoff[i] = lds_byte(d, 8 * c2); vsrc[i] = (size_t)d * SEQ + 8 * c2; }
    const int fbase = lds_byte(fr, 8 * fq);
    bf16x8 qf[4];
    { const bf16_t* qp = P + (size_t)(b * SEQ + 128 * jt + 16 * wave + fr) * PLD + COL_SBQ + h * SBD + 8 * fq;
#pragma unroll
      for (int kk = 0; kk < 4; ++kk) qf[kk] = *(const bf16x8*)(qp + 32 * kk); }
    f4 acc_o[8];
#pragma unroll
    for (int i = 0; i < 8; ++i) acc_o[i] = (f4){0.f, 0.f, 0.f, 0.f};
    float carry = 0.f;
    v4u rk[2], rv[2];
    const int ktop = 2 * jt + 1;
#define S8_LOAD(kt_) do { const int _kt = (kt_) > 0 ? (kt_) : 0; _Pragma("unroll") for (int i = 0; i < 2; ++i) { rk[i] = *(const v4u*)(kbase + (size_t)_kt * 64 * PLD + ksrc[i]); rv[i] = *(const v4u*)(VT + (size_t)_kt * 64 + vsrc[i]); } } while (0)
#define S8_WRITE(stg) do { LAS unsigned char* _b = lds + (stg) * 32768; _Pragma("unroll") for (int i = 0; i < 2; ++i) { *(LAS v4u*)(_b + kwoff[i]) = rk[i]; *(LAS v4u*)(_b + 16384 + vwoff[i]) = rv[i]; } } while (0)
    __syncthreads();
    S8_LOAD(ktop); S8_WRITE(0); S8_LOAD(ktop - 1);
    __syncthreads();
    for (int st = 0; st <= ktop; ++st) {
        const int kt = ktop - st;
        const int rel = kt - 2 * jt;
        const bool active = !(rel == 1 && wave < 4);
        if (active) {
            const LAS unsigned char* kb = lds + (st & 1) * 32768;
            const LAS unsigned char* vb = kb + 16384;
            f4 sc[4];
#pragma unroll
            for (int i = 0; i < 4; ++i) { sc[i] = (f4){0.f, 0.f, 0.f, 0.f};
#pragma unroll
                for (int kk = 0; kk < 4; ++kk) { const bf16x8 kf = *(const LAS bf16x8*)(kb + fbase + i * 2048 + (kk & 1) * 1024 + (kk >> 1) * 8192);
                    sc[i] = __builtin_amdgcn_mfma_f32_16x16x32_bf16(kf, qf[kk], sc[i], 0, 0, 0); } }
            const bool diag = rel >= 0;
            float av[4][4], tt[4], xx[4];
#pragma unroll
            for (int i = 0; i < 4; ++i) {
                float lk[4];
#pragma unroll
                for (int r = 0; r < 4; ++r) { float z = sc[i][r] * scale; const float e = __builtin_amdgcn_exp2f(-fabsf(z)); float l = -(fmaxf(z, 0.f) + __builtin_amdgcn_logf(1.f + e));
                    if (diag && !((64 * rel + 16 * i + 4 * fq + r) < (16 * wave + fr))) { l = 0.f; z = -1.0e30f; }
                    lk[r] = l; sc[i][r] = z; }
                av[i][3] = lk[3]; av[i][2] = lk[2] + av[i][3]; av[i][1] = lk[1] + av[i][2]; av[i][0] = lk[0] + av[i][1];
                const float tot = av[i][0], u = __shfl_xor(tot, 16), t1 = tot + u, v = __shfl_xor(t1, 32);
                tt[i] = t1 + v; xx[i] = ((fq & 1) ? 0.f : u) + ((fq & 2) ? 0.f : v);
            }
            const float y2 = tt[3], y1 = y2 + tt[2], y0 = y1 + tt[1], total = y0 + tt[0];
            xx[0] += y0 + carry; xx[1] += y1 + carry; xx[2] += y2 + carry; xx[3] += carry;
            carry += total;
            bf16x8 pf[2];
#pragma unroll
            for (int sg2 = 0; sg2 < 2; ++sg2) {
                float pv[8];
#pragma unroll
                for (int a = 0; a < 2; ++a)
#pragma unroll
                    for (int r = 0; r < 4; ++r) pv[4 * a + r] = __builtin_amdgcn_exp2f(sc[2 * sg2 + a][r] + av[2 * sg2 + a][r] + xx[2 * sg2 + a]);
                v4u w; w.x = pg8::cvt_pk_bf16(pv[0], pv[1]); w.y = pg8::cvt_pk_bf16(pv[2], pv[3]); w.z = pg8::cvt_pk_bf16(pv[4], pv[5]); w.w = pg8::cvt_pk_bf16(pv[6], pv[7]);
                pf[sg2] = __builtin_bit_cast(bf16x8, w);
            }
#pragma unroll
            for (int ds = 0; ds < 8; ++ds)
#pragma unroll
                for (int sg2 = 0; sg2 < 2; ++sg2) { const bf16x8 vf = *(const LAS bf16x8*)(vb + fbase + ds * 2048 + sg2 * 1024);
                    acc_o[ds] = __builtin_amdgcn_mfma_f32_16x16x32_bf16(vf, pf[sg2], acc_o[ds], 0, 0, 0); }
        }
        { float cm = (128 * jt + 16 * wave + fr == 0) ? -1.0e30f : carry;
          cm = wave_max(cm);
          if (lane == 0) cmax[(st & 1) * 8 + wave] = cm; }
        S8_WRITE((st + 1) & 1);
        S8_LOAD(kt - 2);
        __syncthreads();
        float gm = cmax[(st & 1) * 8];
#pragma unroll
        for (int w = 1; w < 8; ++w) gm = fmaxf(gm, cmax[(st & 1) * 8 + w]);
        if (gm <= -140.f) break;
    }
#undef S8_LOAD
#undef S8_WRITE
    bf16_t* op = YC + (size_t)(b * SEQ + 128 * jt + 16 * wave + fr) * D + C + h * SBD + 4 * fq;
#pragma unroll
    for (int ds = 0; ds < 8; ++ds)
        *(v2u*)(op + 16 * ds) = (v2u){pg8::cvt_pk_bf16(acc_o[ds][0], acc_o[ds][1]), pg8::cvt_pk_bf16(acc_o[ds][2], acc_o[ds][3])};
}
__device__ __forceinline__ void ph_mix(Frame& F) {
    for (int bh = F.bid; bh < BATCH * NH; bh += F.G) wkv_carry_bh(F, bh);
    volatile LAS int* qslot = (volatile LAS int*)(F.lds + 139264);
    constexpr int N_SB = BATCH * SBH * 16, N_MEM = BATCH * MEMH * (SEQ / 128);
    int nxt = 0;
    if (F.tid == 0) nxt = (int)atomicAdd(F.ctl + CW_Q, 1u);
    for (;;) {
        __syncthreads();
        if (F.tid == 0) *qslot = nxt;
        __syncthreads();
        const int i = *qslot;
        if (i >= N_SB + N_MEM) break;
        if (F.tid == 0) nxt = (int)atomicAdd(F.ctl + CW_Q, 1u);
        if (i < N_SB) { const int jt = 15 - (i >> 4), bh = i & 15;
            sb128_item(F, bh / SBH, bh % SBH, jt); }
        else mem_item(F, i - N_SB);
    }
    __syncthreads();
}
struct EpiOut {
    static constexpr bool PERM = false, AFTER_DRAIN = false;
    bf16_t* Z; const bf16_t* H;
    __device__ __forceinline__ void operator()(const pg8::f32x4 (&acc)[2][2][4][2], const pg8::Unit& u, int wr, int wc, int fr, int fq) const {
        const int row0 = u.pm * 256 + wr * 64 + fr, col0 = u.pn * 256 + wc * 32 + 4 * fq;
#pragma unroll
        for (int ai = 0; ai < 2; ++ai)
#pragma unroll
            for (int m = 0; m < 4; ++m) { const size_t ro = (size_t)(row0 + ai * 128 + m * 16) * D + col0;
#pragma unroll
                for (int bj = 0; bj < 2; ++bj)
#pragma unroll
                    for (int n = 0; n < 2; ++n) { const v2u hb = *(const v2u*)(H + ro + bj * 128 + n * 16); const f32x4 h = (f32x4){bflo(hb.x), bfhi(hb.x), bflo(hb.y), bfhi(hb.y)}; const f32x4 z = h * ALPHA + acc[ai][bj][m][n]; *(v2u*)(Z + ro + bj * 128 + n * 16) = (v2u){pg8::cvt_pk_bf16(z[0], z[1]), pg8::cvt_pk_bf16(z[2], z[3])}; } }
    }
};
__device__ __forceinline__ void ph_outproj(Frame& F) {
    pg8::Gemm g{(const bf16_t*)(F.ws + WS_YCAT), (const bf16_t*)(F.ws + WS_WOUTT), T, D, D};
    pg8::StaticOrder S; S.init(T, D, F.G, F.bid);
    EpiOut E{(bf16_t*)(F.ws + WS_Z1), (const bf16_t*)(F.ws + WS_HB)};
    pg8::gemm_phase<EpiOut, pg8::StaticOrder, false>(F.lds, g, S, E, nullptr);
    __syncthreads();
}
__device__ __forceinline__ void ph_ln1_router(Frame& F) {
    using pg8::bf16x8;
    typedef float f4 __attribute__((ext_vector_type(4)));
    constexpr int TI = 32, RS2 = 1024 + 8;
    const bf16_t* Z1 = (const bf16_t*)(F.ws + WS_Z1);
    bf16_t* H1B = (bf16_t*)(F.ws + WS_H1B);
    const bf16_t* WR = (const bf16_t*)(F.ws + WS_WRT);
    int* LIST = (int*)(F.ws + WS_LIST);
    float* LISTW = (float*)(F.ws + WS_LISTW);
    LAS bf16_t* Ahi = (LAS bf16_t*)F.lds;
    LAS bf16_t* Alo = Ahi + TI * RS2;
    LAS float* red = (LAS float*)F.lds;
    LAS float* lg = red + 8 * 5 * 2 * 4 * 64;
    const int tid = F.tid, lane = F.lane, wave = F.wave, fr = lane & 15, fq = lane >> 4;
    const float* G1 = F.a->in[I_LN1G]; const float* B1 = F.a->in[I_LN1B];
    for (int item = F.bid; item < T / TI; item += F.G) {
        const int t0 = item * TI;
        __syncthreads();
        bf16x8 wq[2][10];
        const char* wb = (const char*)WR + (size_t)__builtin_amdgcn_readfirstlane(wave) * (4 * 5 * 1024);
        int lz = lane; asm volatile("" : "+v"(lz));
        const unsigned lo16 = (unsigned)lz * 16u;
        const unsigned lo8 = (unsigned)lz * 8u;
        const size_t rowb = (size_t)(t0 + 4 * __builtin_amdgcn_readfirstlane(wave)) * (D * 2);
        const char* zb = (const char*)Z1 + rowb; char* hb = (char*)H1B + rowb;
#define RT_WLOAD(slot, s_) do { _Pragma("unroll") for (int n = 0; n < 5; ++n) { const int co_ = ((32 * ((s_) >> 2) + ((s_) & 3)) * 5 + n) * 1024; \
            wq[slot][2 * n] = *(const bf16x8*)(wb + co_ + lo16); wq[slot][2 * n + 1] = *(const bf16x8*)(wb + 80 * D * 2 + co_ + lo16); } } while (0)
        float mean[4], rstd[4]; v2u zh[4][4];
        {   v2u zc[4][8];
#pragma unroll
            for (int rr = 0; rr < 4; ++rr)
#pragma unroll
                for (int j = 0; j < 8; ++j) zc[rr][j] = *(const v2u*)(zb + rr * (D * 2) + j * 512 + lo8);
#pragma unroll
            for (int rr = 0; rr < 4; ++rr) { float sm = 0.f;
#pragma unroll
                for (int j = 0; j < 8; ++j) sm += (bflo(zc[rr][j].x) + bfhi(zc[rr][j].x)) + (bflo(zc[rr][j].y) + bfhi(zc[rr][j].y));
                mean[rr] = wave_sum(sm) * (1.f / D);
                float s2 = 0.f;
#pragma unroll
                for (int j = 0; j < 8; ++j) { const float a0 = bflo(zc[rr][j].x) - mean[rr], a1 = bfhi(zc[rr][j].x) - mean[rr], a2 = bflo(zc[rr][j].y) - mean[rr], a3 = bfhi(zc[rr][j].y) - mean[rr]; s2 += (a0 * a0 + a1 * a1) + (a2 * a2 + a3 * a3); }
                rstd[rr] = 1.f / sqrtf(wave_sum(s2) * (1.f / D) + LN_EPS);
#pragma unroll
                for (int j = 0; j < 4; ++j) zh[rr][j] = zc[rr][j]; }
        }
        __builtin_amdgcn_sched_barrier(0);
        RT_WLOAD(0, 0); RT_WLOAD(1, 1);
        f4 acc[5][2];
#pragma unroll
        for (int hf = 0; hf < 2; ++hf) {
            if (hf) {
#pragma unroll
                for (int rr = 0; rr < 4; ++rr)
#pragma unroll
                    for (int j = 0; j < 4; ++j) zh[rr][j] = *(const v2u*)(zb + rr * (D * 2) + 2048 + j * 512 + lo8);
                __syncthreads();
            }
#pragma unroll
            for (int j = 0; j < 4; ++j) {
                const f32x4 gg = *(const f32x4*)((const char*)G1 + (4 * hf + j) * 1024 + lo16), bb = *(const f32x4*)((const char*)B1 + (4 * hf + j) * 1024 + lo16);
#pragma unroll
                for (int rr = 0; rr < 4; ++rr) { const int row = 4 * wave + rr; const v2u z = zh[rr][j];
                    const f32x4 v = ((f32x4){bflo(z.x), bfhi(z.x), bflo(z.y), bfhi(z.y)} - mean[rr]) * rstd[rr] * gg + bb;
                    const v2u hi = (v2u){pg8::cvt_pk_bf16(v.x, v.y), pg8::cvt_pk_bf16(v.z, v.w)};
                    const v2u lo = (v2u){pg8::cvt_pk_bf16(v.x - bflo(hi.x), v.y - bfhi(hi.x)), pg8::cvt_pk_bf16(v.z - bflo(hi.y), v.w - bfhi(hi.y))};
                    *(v2u*)(hb + rr * (D * 2) + (4 * hf + j) * 512 + lo8) = hi;
                    *(LAS v2u*)(Ahi + row * RS2 + 4 * (lane + 64 * j)) = hi;
                    *(LAS v2u*)(Alo + row * RS2 + 4 * (lane + 64 * j)) = lo; }
            }
            __syncthreads();
            if (hf == 0) {
#pragma unroll
                for (int n = 0; n < 5; ++n) { acc[n][0] = (f4){0.f, 0.f, 0.f, 0.f}; acc[n][1] = acc[n][0]; } }
#pragma unroll
            for (int ks = 0; ks < 4; ++ks) {
                const int s_ = 4 * hf + ks, k = 128 * wave + 32 * ks + 8 * fq;
                bf16x8 bh[2], bl[2];
#pragma unroll
                for (int tt = 0; tt < 2; ++tt) { bh[tt] = *(const LAS bf16x8*)(Ahi + (16 * tt + fr) * RS2 + k); bl[tt] = *(const LAS bf16x8*)(Alo + (16 * tt + fr) * RS2 + k); }
#pragma unroll
                for (int n = 0; n < 5; ++n) { const bf16x8 wh = wq[s_ & 1][2 * n], wl = wq[s_ & 1][2 * n + 1];
#pragma unroll
                    for (int tt = 0; tt < 2; ++tt) {
                        acc[n][tt] = __builtin_amdgcn_mfma_f32_16x16x32_bf16(wh, bh[tt], acc[n][tt], 0, 0, 0);
                        acc[n][tt] = __builtin_amdgcn_mfma_f32_16x16x32_bf16(wl, bh[tt], acc[n][tt], 0, 0, 0);
                        acc[n][tt] = __builtin_amdgcn_mfma_f32_16x16x32_bf16(wh, bl[tt], acc[n][tt], 0, 0, 0); } }
                __builtin_amdgcn_sched_barrier(0);
                if (s_ + 2 < 8) { if ((s_ & 1) == 0) RT_WLOAD(0, s_ + 2); else RT_WLOAD(1, s_ + 2); }
                __builtin_amdgcn_sched_barrier(0);
            }
        }
#undef RT_WLOAD
        __syncthreads();
#pragma unroll
        for (int n = 0; n < 5; ++n)
#pragma unroll
            for (int tt = 0; tt < 2; ++tt)
#pragma unroll
                for (int r = 0; r < 4; ++r) red[(((wave * 5 + n) * 2 + tt) * 4 + r) * 64 + lane] = acc[n][tt][r];
        __syncthreads();
        for (int idx = tid; idx < 5 * 2 * 4 * 64; idx += NT) {
            const int l = idx & 63, q = idx >> 6, r = q & 3, tt = (q >> 2) & 1, n = q >> 3;
            float sm = 0.f;
#pragma unroll
            for (int w = 0; w < 8; ++w) sm += red[(((w * 5 + n) * 2 + tt) * 4 + r) * 64 + l];
            lg[(16 * tt + (l & 15)) * 80 + 16 * n + 4 * (l >> 4) + r] = sm;
        }
        __syncthreads();
        if (tid < TI) {
            const int t = t0 + tid;
            const LAS float* lp = lg + tid * 80;
            float gl[NG];
            { const f32x4 g0 = *(const f32x4*)(F.a->in[I_RGB]), g1 = *(const f32x4*)(F.a->in[I_RGB] + 4);
              const float gb[NG] = {g0.x, g0.y, g0.z, g0.w, g1.x, g1.y, g1.z, g1.w};
#pragma unroll
              for (int j = 0; j < NG; ++j) gl[j] = lp[j] + gb[j]; }
            int gi = 0; float gm = gl[0];
#pragma unroll
            for (int j = 1; j < NG; ++j) if (gl[j] > gm) { gm = gl[j]; gi = j; }
            float gs = 0.f;
#pragma unroll
            for (int j = 0; j < NG; ++j) gs += expf(gl[j] - gm);
            const float gw_ = 1.f / gs;
            float v0 = -3.0e38f, v1 = -3.0e38f; int i0 = 0, i1 = 0;
            const f32x4 e0 = *(const f32x4*)(F.a->in[I_REB] + gi * EPG), e1v = *(const f32x4*)(F.a->in[I_REB] + gi * EPG + 4);
            const float eb[EPG] = {e0.x, e0.y, e0.z, e0.w, e1v.x, e1v.y, e1v.z, e1v.w};
#pragma unroll
            for (int j = 0; j < EPG; ++j) {
                const float l = lp[NG + gi * EPG + j] + eb[j];
                if (l > v0) { v1 = v0; i1 = i0; v0 = l; i0 = j; } else if (l > v1) { v1 = l; i1 = j; }
            }
            const float e1 = expf(v1 - v0);
            const float w0 = gw_ / (1.f + e1), w1 = gw_ * e1 / (1.f + e1);
            const int ex0 = gi * EPG + i0, ex1 = gi * EPG + i1;
            const unsigned p0 = atomicAdd(F.ctl + CW_CNT + ex0, 1u);
            LIST[ex0 * LISTCAP + p0] = t * 2; LISTW[ex0 * LISTCAP + p0] = w0;
            const unsigned p1 = atomicAdd(F.ctl + CW_CNT + ex1, 1u);
            LIST[ex1 * LISTCAP + p1] = t * 2 + 1; LISTW[ex1 * LISTCAP + p1] = w1;
        }
    }
    __syncthreads();
}
namespace sg {
using pg8::bf16x8; using pg8::lds_byte;
typedef float acc_t __attribute__((ext_vector_type(4)));
constexpr int MT = 5;
constexpr int A_BUF = 4 * MT * 2048, B_BUF = 16384, A_OFF = 0, B_OFF = 2 * A_BUF;

template <class Maker, int LDB>
__device__ __forceinline__ void run_units(LAS unsigned char* lds, const Maker& mk, const int nk, const int nrounds, const int tid) {
    typedef typename Maker::AP AP; typedef typename Maker::BP BP; typedef typename Maker::Epi Epi;
    AP ap; BP bp; Epi ep;
    int r = 0;
    bool has = false;
    while (r < nrounds && !(has = mk(r, ap, bp, ep))) ++r;
    if (!has) return;
    const int wid = __builtin_amdgcn_readfirstlane(tid >> 6), lane = tid & 63, wr = wid >> 1, wc = wid & 1, fr = lane & 15, fq = lane >> 4;
    const int awoff = (tid >> 7) * 2048 + lds_byte((tid >> 3) & 15, 8 * (tid & 7));
    const int kq = tid >> 5, nq = tid & 31;
    const int bwoff0 = lds_byte(bp.rho(4 * nq), 4 * kq);
    const int aoff = wr * 2048 + lds_byte(fr, fq * 8);
    const int boff = lds_byte(wc * 64 + fr, fq * 8);
    unsigned aoffs[MT];
    const bf16_t* abase; const float* bsrc; constexpr size_t ldb = LDB;
#define SG_SETUP(ap_, bp_) do { _Pragma("unroll") for (int i = 0; i < MT; ++i) aoffs[i] = (ap_).row((tid >> 3) + 64 * i) + 8 * (tid & 7); \
        abase = (ap_).base(); bsrc = (bp_).ptr(4 * nq) + (size_t)(4 * kq) * ldb; } while (0)
    SG_SETUP(ap, bp);
    acc_t acc[MT][4];
#pragma unroll
    for (int m = 0; m < MT; ++m)
#pragma unroll
        for (int n = 0; n < 4; ++n) acc[m][n] = (acc_t){0.f, 0.f, 0.f, 0.f};
    v4u ra0[MT]; f32x4 rb0[4], rb1[4];
#define SG_LOADA(ra, kt) do { _Pragma("unroll") for (int i = 0; i < MT; ++i) ra[i] = *(const v4u*)(abase + aoffs[i] + (size_t)(kt) * 64); } while (0)
#define SG_LOADB(rb, kt) do { _Pragma("unroll") for (int j = 0; j < 4; ++j) rb[j] = __builtin_nontemporal_load((const f32x4*)(bsrc + ((size_t)(kt) * 64 + j) * ldb)); } while (0)
#define SG_WRITEA(ra, buf, w5) do { _Pragma("unroll") for (int i = 0; i < MT - 1; ++i) *(LAS v4u*)(lds + A_OFF + (buf) * A_BUF + i * 8192 + awoff) = ra[i]; \
        if (w5) *(LAS v4u*)(lds + A_OFF + (buf) * A_BUF + (MT - 1) * 8192 + awoff) = ra[MT - 1]; } while (0)
#define SG_WRITEB(rb, buf) do { _Pragma("unroll") for (int c = 0; c < 4; ++c) { v2u w; w.x = pg8::cvt_pk_bf16(rb[0][c], rb[1][c]); w.y = pg8::cvt_pk_bf16(rb[2][c], rb[3][c]); \
            *(LAS v2u*)(lds + B_OFF + (buf) * B_BUF + bwoff0 + 64 * c) = w; } } while (0)
#define SG_COMPUTE(buf) do { _Pragma("unroll") for (int k = 0; k < 2; ++k) { bf16x8 bfr[4]; \
        _Pragma("unroll") for (int n = 0; n < 4; ++n) bfr[n] = *(const LAS bf16x8*)(lds + B_OFF + (buf) * B_BUF + boff + n * 2048 + k * 1024); \
        _Pragma("unroll") for (int m = 0; m < MT - 1; ++m) { const bf16x8 af = *(const LAS bf16x8*)(lds + A_OFF + (buf) * A_BUF + aoff + m * 8192 + k * 1024); \
            _Pragma("unroll") for (int n = 0; n < 4; ++n) acc[m][n] = __builtin_amdgcn_mfma_f32_16x16x32_bf16(bfr[n], af, acc[m][n], 0, 0, 0); } \
        if (h5) { const bf16x8 af = *(const LAS bf16x8*)(lds + A_OFF + (buf) * A_BUF + aoff + (MT - 1) * 8192 + k * 1024); \
            _Pragma("unroll") for (int n = 0; n < 4; ++n) acc[MT - 1][n] = __builtin_amdgcn_mfma_f32_16x16x32_bf16(bfr[n], af, acc[MT - 1][n], 0, 0, 0); } \
        __builtin_amdgcn_sched_barrier(0); } } while (0)
#define SG_FLAGS(ap_, w5_, h5_) do { const int nv_ = __builtin_amdgcn_readfirstlane((ap_).nvalid); w5_ = nv_ > 64 * (MT - 1); h5_ = nv_ > 16 * (wr + 4 * (MT - 1)); } while (0)
    bool w5, h5; SG_FLAGS(ap, w5, h5);
    SG_LOADA(ra0, 0); SG_LOADB(rb0, 0); SG_LOADB(rb1, 1);
    SG_WRITEA(ra0, 0, w5); SG_WRITEB(rb0, 0);
    SG_LOADA(ra0, 1);
    __syncthreads();
    for (;;) {
        int kt = 0;
        for (; kt + 4 < nk; kt += 2) {
            SG_LOADB(rb0, kt + 2); SG_COMPUTE(0); SG_WRITEA(ra0, 1, w5); SG_WRITEB(rb1, 1); SG_LOADA(ra0, kt + 2); __syncthreads();
            SG_LOADB(rb1, kt + 3); SG_COMPUTE(1); SG_WRITEA(ra0, 0, w5); SG_WRITEB(rb0, 0); SG_LOADA(ra0, kt + 3); __syncthreads();
        }
        SG_LOADB(rb0, kt + 2); SG_COMPUTE(0); SG_WRITEA(ra0, 1, w5); SG_WRITEB(rb1, 1); SG_LOADA(ra0, kt + 2); __syncthreads();
        SG_LOADB(rb1, kt + 3); SG_COMPUTE(1); SG_WRITEA(ra0, 0, w5); SG_WRITEB(rb0, 0); SG_LOADA(ra0, kt + 3); __syncthreads();
        AP apn; BP bpn; Epi epn; int rn = r + 1; bool hasn = false;
        while (rn < nrounds && !(hasn = mk(rn, apn, bpn, epn))) ++rn;
        if (!hasn) { apn = ap; bpn = bp; }
        bool w5n, h5n; SG_FLAGS(apn, w5n, h5n);
        unsigned nrow[MT];
#pragma unroll
        for (int i = 0; i < MT; ++i) nrow[i] = apn.row((tid >> 3) + 64 * i);
        int pe[MT]; float pw[MT];
        { int tz = tid; asm volatile("" : "+v"(tz)); ep.pre(pe, pw, __builtin_amdgcn_readfirstlane(tz >> 7), tz & 15); }
        __builtin_amdgcn_sched_barrier(0);
        SG_COMPUTE(0); SG_WRITEA(ra0, 1, w5); SG_WRITEB(rb1, 1);
        __builtin_amdgcn_sched_barrier(0);
#pragma unroll
        for (int i = 0; i < MT; ++i) aoffs[i] = nrow[i] + 8 * (tid & 7);
        abase = apn.base(); bsrc = bpn.ptr(4 * nq) + (size_t)(4 * kq) * ldb;
        __builtin_amdgcn_sched_barrier(0);
        SG_LOADA(ra0, 0); SG_LOADB(rb0, 0); __syncthreads();
        SG_LOADB(rb1, 1); SG_COMPUTE(1); SG_WRITEA(ra0, 0, w5n); SG_WRITEB(rb0, 0); SG_LOADA(ra0, 1);
        { int tz = tid; asm volatile("" : "+v"(tz));
          const int wz = __builtin_amdgcn_readfirstlane(tz >> 6), lz = tz & 63;
          ep.fin(acc, pe, pw, wz >> 1, wz & 1, lz & 15, lz >> 4); }
        __syncthreads();
        if (!hasn) break;
#pragma unroll
        for (int m = 0; m < MT; ++m)
#pragma unroll
            for (int n = 0; n < 4; ++n) acc[m][n] = (acc_t){0.f, 0.f, 0.f, 0.f};
        ap = apn; bp = bpn; ep = epn; r = rn; w5 = w5n; h5 = h5n;
    }
#undef SG_FLAGS
#undef SG_SETUP
#undef SG_LOADA
#undef SG_LOADB
#undef SG_WRITEA
#undef SG_WRITEB
#undef SG_COMPUTE
}
}

constexpr int MT_ROWS = 64 * sg::MT;
__device__ __forceinline__ void moe_build_tab(Frame& F, LAS int* tab) {
    __syncthreads();
    if (F.wave == 0) {
        const int e = F.lane, n = (int)F.ctl[CW_CNT + e], ns = (n + MT_ROWS - 1) / MT_ROWS;
        int off = n, so = ns;
#pragma unroll
        for (int d = 1; d < 64; d <<= 1) { const int a = __shfl_up(off, d), b = __shfl_up(so, d); if (e >= d) { off += a; so += b; } }
        tab[e] = n; tab[NE + e] = off - n;
        for (int mt = 0; mt < ns; ++mt) tab[129 + so - ns + mt] = e | (mt << 8);
        if (e == 63) tab[128] = so;
    }
    __syncthreads();
}
__device__ __forceinline__ bool moe_unit(const int G, const int bid, const LAS int* tab, int r, int& e, int& mt, int& nt) {
    int slot;
    if (G == 256) { const int x = bid & 7, j = bid >> 3; slot = r * 16 + (j >> 4) * 8 + x; nt = j & 15; }
    else { const int u = r * G + bid; slot = u >> 4; nt = u & 15; }
    if (slot >= tab[128]) return false;
    const int sv = tab[129 + slot]; e = sv & 255; mt = sv >> 8; return true;
}
struct APGather { const bf16_t* X; const int* list; int nvalid;
    __device__ __forceinline__ const bf16_t* base() const { return X; }
    __device__ __forceinline__ unsigned row(int r) const { const int rr = r < nvalid ? r : nvalid - 1; return (unsigned)(list[rr] >> 1) * (unsigned)D; } };
struct APPlain { const bf16_t* X; int ld; int nvalid;
    __device__ __forceinline__ const bf16_t* base() const { return X; }
    __device__ __forceinline__ unsigned row(int r) const { const int rr = r < nvalid ? r : nvalid - 1; return (unsigned)rr * (unsigned)ld; } };
struct BPUp { const float* Wg; const float* Wu; int ldb;
    __device__ __forceinline__ const float* ptr(int nu4) const { return nu4 < 64 ? Wg + nu4 : Wu + (nu4 - 64); }
    __device__ __forceinline__ int rho(int nu) const { const int j = nu & 63, h = nu >> 6; return 64 * (j >> 5) + 32 * h + (j & 31); } };
struct BPDown { const float* W; int ldb;
    __device__ __forceinline__ const float* ptr(int nu4) const { return W + nu4; }
    __device__ __forceinline__ int rho(int nu) const { return nu; } };
struct EpiUp { bf16_t* H; int nvalid;
    __device__ __forceinline__ void pre(int (&)[sg::MT], float (&)[sg::MT], int, int) const {}
    __device__ __forceinline__ void fin(const sg::acc_t (&acc)[sg::MT][4], const int (&)[sg::MT], const float (&)[sg::MT], int wr, int wc, int fr, int fq) const { (*this)(acc, wr, wc, fr, fq); }
    template <int NM> __device__ __forceinline__ void runi(const sg::acc_t (&acc)[sg::MT][4], int wr, int wc, int fr, int fq) const {
#pragma unroll
        for (int m = 0; m < NM; ++m) { const int row = 16 * (wr + 4 * m) + fr;
            if (row < nvalid) {
#pragma unroll
                for (int n = 0; n < 2; ++n) { const sg::acc_t g = acc[m][n], u = acc[m][n + 2]; float h[4];
#pragma unroll
                    for (int j = 0; j < 4; ++j) h[j] = g[j] * __builtin_amdgcn_rcpf(1.f + __expf(-g[j])) * u[j];
                    *(v2u*)(H + (size_t)row * DE + 32 * wc + 16 * n + 4 * fq) = (v2u){pg8::cvt_pk_bf16(h[0], h[1]), pg8::cvt_pk_bf16(h[2], h[3])}; } } }
    }
    __device__ __forceinline__ void operator()(const sg::acc_t (&acc)[sg::MT][4], int wr, int wc, int fr, int fq) const {
#pragma unroll
        for (int m = 0; m < sg::MT; ++m) { const int row = 16 * (wr + 4 * m) + fr;
            if (row < nvalid) {
#pragma unroll
                for (int n = 0; n < 2; ++n) { const sg::acc_t g = acc[m][n], u = acc[m][n + 2]; float h[4];
#pragma unroll
                    for (int j = 0; j < 4; ++j) h[j] = g[j] * __builtin_amdgcn_rcpf(1.f + __expf(-g[j])) * u[j];
                    *(v2u*)(H + (size_t)row * DE + 32 * wc + 16 * n + 4 * fq) = (v2u){pg8::cvt_pk_bf16(h[0], h[1]), pg8::cvt_pk_bf16(h[2], h[3])}; } } }
    }
};
struct EpiDown { bf16_t* YS; const int* list; const float* lw; int nvalid, n0;
    template <int NM> __device__ __forceinline__ void runi(const sg::acc_t (&acc)[sg::MT][4], int wr, int wc, int fr, int fq) const {
#pragma unroll
        for (int m = 0; m < NM; ++m) { const int row = 16 * (wr + 4 * m) + fr;
            if (row < nvalid) { const int e = list[row]; const float w = lw[row]; bf16_t* dst = YS + (size_t)e * D + n0 + 64 * wc + 4 * fq;
#pragma unroll
                for (int n = 0; n < 4; ++n) *(v2u*)(dst + 16 * n) = (v2u){pg8::cvt_pk_bf16(acc[m][n][0] * w, acc[m][n][1] * w), pg8::cvt_pk_bf16(acc[m][n][2] * w, acc[m][n][3] * w)}; } }
    }
    __device__ __forceinline__ void pre(int (&pe)[sg::MT], float (&pw)[sg::MT], int wr, int fr) const {
#pragma unroll
        for (int m = 0; m < sg::MT; ++m) { const int row = 16 * (wr + 4 * m) + fr, rr = row < nvalid ? row : nvalid - 1; pe[m] = list[rr]; pw[m] = lw[rr]; } }
    __device__ __forceinline__ void fin(const sg::acc_t (&acc)[sg::MT][4], const int (&pe)[sg::MT], const float (&pw)[sg::MT], int wr, int wc, int fr, int fq) const {
#pragma unroll
        for (int m = 0; m < sg::MT; ++m) { const int row = 16 * (wr + 4 * m) + fr;
            if (row < nvalid) { const float w = pw[m]; bf16_t* dst = YS + (size_t)pe[m] * D + n0 + 64 * wc + 4 * fq;
#pragma unroll
                for (int n = 0; n < 4; ++n) *(v2u*)(dst + 16 * n) = (v2u){pg8::cvt_pk_bf16(acc[m][n][0] * w, acc[m][n][1] * w), pg8::cvt_pk_bf16(acc[m][n][2] * w, acc[m][n][3] * w)}; } } }
    __device__ __forceinline__ void operator()(const sg::acc_t (&acc)[sg::MT][4], int wr, int wc, int fr, int fq) const {
#pragma unroll
        for (int m = 0; m < sg::MT; ++m) { const int row = 16 * (wr + 4 * m) + fr;
            if (row < nvalid) { const int e = list[row]; const float w = lw[row]; bf16_t* dst = YS + (size_t)e * D + n0 + 64 * wc + 4 * fq;
#pragma unroll
                for (int n = 0; n < 4; ++n) *(v2u*)(dst + 16 * n) = (v2u){pg8::cvt_pk_bf16(acc[m][n][0] * w, acc[m][n][1] * w), pg8::cvt_pk_bf16(acc[m][n][2] * w, acc[m][n][3] * w)}; } }
    }
};
struct MakerUp { typedef APGather AP; typedef BPUp BP; typedef EpiUp Epi;
    const LAS int* tab; int G, bid; const bf16_t* H1B; const int* LIST; bf16_t* HID; const float* WEG; const float* WEU;
    __device__ __forceinline__ bool operator()(int r, AP& ap, BP& bp, Epi& ep) const {
        int e, mt, nt; if (!moe_unit(G, bid, tab, r, e, mt, nt)) return false;
        const int cnt = tab[e], off = tab[NE + e], nvalid = min(MT_ROWS, cnt - mt * MT_ROWS), n0 = nt * 64;
        ap = AP{H1B, LIST + e * LISTCAP + mt * MT_ROWS, nvalid};
        bp = BP{WEG + (size_t)e * D * DE + n0, WEU + (size_t)e * D * DE + n0, DE};
        ep = Epi{HID + (size_t)(off + mt * MT_ROWS) * DE + n0, nvalid};
        return true; } };
__device__ __forceinline__ void ph_moe_up(Frame& F) {
    LAS int* tab = (LAS int*)(F.lds + 131072);
    moe_build_tab(F, tab);
    const MakerUp mk{tab, F.G, F.bid, (const bf16_t*)(F.ws + WS_H1B), (const int*)(F.ws + WS_LIST), (bf16_t*)(F.ws + WS_HID), F.a->in[I_WEG], F.a->in[I_WEU]};
    sg::run_units<MakerUp, DE>(F.lds, mk, D / 64, (tab[128] * 16 + F.G - 1) / F.G + 1, F.tid);
    __syncthreads();
}
struct MakerDown { typedef APPlain AP; typedef BPDown BP; typedef EpiDown Epi;
    const LAS int* tab; int G, bid; const bf16_t* HID; const int* LIST; const float* LISTW; bf16_t* YS; const float* WED;
    __device__ __forceinline__ bool operator()(int r, AP& ap, BP& bp, Epi& ep) const {
        int e, mt, nt; if (!moe_unit(G, bid, tab, r, e, mt, nt)) return false;
        const int cnt = tab[e], off = tab[NE + e], nvalid = min(MT_ROWS, cnt - mt * MT_ROWS), n0 = nt * 128;
        ap = AP{HID + (size_t)(off + mt * MT_ROWS) * DE, DE, nvalid};
        bp = BP{WED + (size_t)e * DE * D + n0, D};
        ep = Epi{YS, LIST + e * LISTCAP + mt * MT_ROWS, LISTW + e * LISTCAP + mt * MT_ROWS, nvalid, n0};
        return true; } };
__device__ __forceinline__ void ph_moe_down(Frame& F) {
    LAS int* tab = (LAS int*)(F.lds + 131072);
    moe_build_tab(F, tab);
    const MakerDown mk{tab, F.G, F.bid, (const bf16_t*)(F.ws + WS_HID), (const int*)(F.ws + WS_LIST), (const float*)(F.ws + WS_LISTW), (bf16_t*)(F.ws + WS_YS), F.a->in[I_WED]};
    sg::run_units<MakerDown, D>(F.lds, mk, DE / 64, (tab[128] * 16 + F.G - 1) / F.G + 1, F.tid);
    __syncthreads();
}
__device__ __forceinline__ void ph_ln2(Frame& F) {
    const bf16_t* H1B = (const bf16_t*)(F.ws + WS_H1B);
    const bf16_t* YS = (const bf16_t*)(F.ws + WS_YS);
    const int gw = F.bid * NWAVES + F.wave, NGW = F.G * NWAVES;
    v2u hc[8], ac[8], cc[8];
#define LN2_LOAD(row_) do { const v2u* hr_ = (const v2u*)(H1B + (size_t)(row_) * D); const v2u* y0_ = (const v2u*)(YS + (size_t)(row_) * 2 * D); const v2u* y1_ = y0_ + D / 4; \
        _Pragma("unroll") for (int j = 0; j < 8; ++j) { hc[j] = hr_[F.lane + 64 * j]; ac[j] = y0_[F.lane + 64 * j]; cc[j] = y1_[F.lane + 64 * j]; } } while (0)
    { const int r0 = gw < T ? gw : T - 1; LN2_LOAD(r0); }
    for (int row = gw; row < T; row += NGW) {
        f32x4 v[8];
#pragma unroll
        for (int j = 0; j < 8; ++j) { const v2u h = hc[j], a = ac[j], c = cc[j];
            v[j] = (f32x4){bflo(h.x) * ALPHA + (bflo(a.x) + bflo(c.x)), bfhi(h.x) * ALPHA + (bfhi(a.x) + bfhi(c.x)), bflo(h.y) * ALPHA + (bflo(a.y) + bflo(c.y)), bfhi(h.y) * ALPHA + (bfhi(a.y) + bfhi(c.y))}; }
        { const int nr = row + NGW < T ? row + NGW : row; LN2_LOAD(nr); }
        ln_core(v, F.a->in[I_LN2G], F.a->in[I_LN2B], F.out + (size_t)row * D, F.lane);
    }
#undef LN2_LOAD
}

constexpr int N_PHASES = 13;
__global__ void __launch_bounds__(NT, 2) fwd(Args args) {
    extern __shared__ __attribute__((aligned(16))) unsigned char lds[];
    Frame F;
    F.lds = (LAS unsigned char*)lds;
    F.tid = threadIdx.x; F.lane = (int)__builtin_amdgcn_mbcnt_hi(~0u, __builtin_amdgcn_mbcnt_lo(~0u, 0u)); F.wave = __builtin_amdgcn_readfirstlane(F.tid >> 6);
    F.bid = blockIdx.x; F.G = gridDim.x;
    F.ws = args.ws; F.ctl = (unsigned*)(args.ws + WS_CTL); F.out = args.out;
    F.a = &args;
    volatile LAS unsigned* xbw = (volatile LAS unsigned*)(F.lds + LDS_BYTES - 16);
    if (F.tid == 0) { xbw[0] = 0u; xbw[1] = 0u; xbw[2] = 0u; xbw[3] = 0u; }
    __syncthreads();
    const int lo = args.ph_lo, hi = args.ph_hi;
    XcdBarrier bar; bar.bar = F.ctl + CW_BAR; bar.x = 0; bar.st = xbw;
    if (hi - lo > 1) bar = xcd_barrier_post(F.ctl + CW_BAR, xbw);
#define IN(k) (lo <= (k) && (k) < hi)
#define SEAM(k) do { if (IN(k) && IN((k) + 1)) xcd_barrier(bar); } while (0)
    if (IN(0)) { ph_prologue(F); } SEAM(0);
    if (IN(1)) { ph_proj(F); } SEAM(1);
    if (IN(2)) { ph_rwkv_prep(F); ph_vt(F); } SEAM(2);
    if (IN(3)) { ph_wkv_chunk(F); } SEAM(3);
    if (IN(4)) { ph_mix(F); }
    if (IN(5)) { }
    if (IN(6)) { } SEAM(6);
    if (IN(7)) { ph_wkv_post(F); } SEAM(7);
    if (IN(8)) { ph_outproj(F); } SEAM(8);
    if (IN(9)) { ph_ln1_router(F); } SEAM(9);
    if (IN(10)) { ph_moe_up(F); } SEAM(10);
    if (IN(11)) { ph_moe_down(F); } SEAM(11);
    if (IN(12)) { ph_ln2(F); }
#undef IN
#undef SEAM
}

extern "C" void kernel_launch(void* const* d_in, const int* in_sizes, int n_in, void* d_out, int out_size, void* d_ws, size_t ws_size, hipStream_t stream) {
    static int grid = 0;
    if (grid == 0) {
        if (n_in != 29 || out_size != T * D || ws_size < WS_END) { fprintf(stderr, "kernel_launch: unexpected shapes n_in %d out %d ws %zu (need %zu)\n", n_in, out_size, ws_size, (size_t)WS_END); grid = -1; return; }
        int dev = 0, cus = 0;
        if (hipGetDevice(&dev) != hipSuccess || hipDeviceGetAttribute(&cus, hipDeviceAttributeMultiprocessorCount, dev) != hipSuccess) { grid = -1; return; }
        if (hipFuncSetAttribute((const void*)fwd, hipFuncAttributeMaxDynamicSharedMemorySize, LDS_BYTES) != hipSuccess) { fprintf(stderr, "kernel_launch: hipFuncSetAttribute failed\n"); grid = -1; return; }
        int per_cu = 0;
        if (hipOccupancyMaxActiveBlocksPerMultiprocessor(&per_cu, (const void*)fwd, NT, LDS_BYTES) != hipSuccess || per_cu < 1) fprintf(stderr, "kernel_launch: occupancy query says %d\n", per_cu);
        (void)hipGetLastError();
        grid = cus;
    }
    if (grid < 0) return;
    (void)hipMemsetAsync((char*)d_ws + WS_CTL, 0, CTL_ZERO_BYTES, stream);
    Args a{};
    for (int i = 0; i < 29; ++i) a.in[i] = (const float*)d_in[i];
    a.out = (float*)d_out; a.ws = (unsigned char*)d_ws;
#if MK_N_LAUNCHES == 1
    a.ph_lo = 0; a.ph_hi = N_PHASES;
    hipLaunchKernelGGL(fwd, dim3(grid), dim3(NT), LDS_BYTES, stream, a);
#else
    const int cuts[] = {0, 1, 2, 3, 4, 7, 8, 9, 10, 11, 12, 13};
    for (int i = 0; i + 1 < (int)(sizeof(cuts) / sizeof(int)); ++i) {
        a.ph_lo = cuts[i]; a.ph_hi = cuts[i + 1];
        hipLaunchKernelGGL(fwd, dim3(grid), dim3(NT), LDS_BYTES, stream, a);
    }
#endif
    const hipError_t le = hipPeekAtLastError();
    if (le != hipSuccess) fprintf(stderr, "kernel_launch: launch failed: %s\n", hipGetErrorName(le));
}
```

```cpp
#include <hip/hip_runtime.h>
#include <cstdio>
#include <cstdint>

#ifndef DBG
#define DBG 0
#endif
#ifndef MK_N_LAUNCHES
#define MK_N_LAUNCHES 1
#endif

#define LAS __attribute__((address_space(3)))
typedef float f32x4 __attribute__((ext_vector_type(4)));
typedef float f32x2 __attribute__((ext_vector_type(2)));
typedef unsigned short bf16_t;
typedef unsigned v4u __attribute__((ext_vector_type(4)));
typedef unsigned v2u __attribute__((ext_vector_type(2)));

constexpr int BATCH = 4, SEQ = 2048, T = BATCH * SEQ, D = 2048, C = 1024, NH = 16, HD = 64;
constexpr int DR = 64, AR = 64, GR = 160, LOWR = DR + AR + GR;
constexpr int RWKV_COLS = 3 * C + LOWR;
constexpr int SBW = 512, SBH = 4, SBD = 128, MEMW = 512, MEMH = 4, MEMD = 128, MEML = 256;
constexpr int IN_COLS = RWKV_COLS + 3 * SBW + MEMW;
constexpr int PLD = 5632;
constexpr int COL_R = 0, COL_K = C, COL_V = 2 * C, COL_DL = 3 * C, COL_SBQ = RWKV_COLS, COL_SBK = RWKV_COLS + SBW, COL_SBV = RWKV_COLS + 2 * SBW, COL_QM = RWKV_COLS + 3 * SBW;
constexpr int NG = 8, EPG = 8, NE = 64, DE = 1024;
constexpr float ALPHA = 1.18920711500272f;
constexpr float LN_EPS = 1e-5f, GN_EPS = 64e-5f;
constexpr int NT = 512, NWAVES = 8;
constexpr int LISTCAP = 8192;

constexpr size_t MiB = 1u << 20;
constexpr size_t WS_CTL = 0, CTL_ZERO_BYTES = 32768;
constexpr size_t WS_H32 = 2 * MiB;
constexpr size_t WS_HB = WS_H32 + 64 * MiB;
constexpr size_t WS_MEMB = WS_HB + 32 * MiB;
constexpr size_t WS_WINT = WS_MEMB + 4 * MiB;
constexpr size_t WS_WMKVT = WS_WINT + 22 * MiB;
constexpr size_t WS_WOUTT = WS_WMKVT + 4 * MiB;
constexpr size_t WS_PROJ = WS_WOUTT + 8 * MiB;
constexpr size_t WS_MEMKV = WS_PROJ + 88 * MiB;
constexpr size_t WS_PK = WS_MEMKV + 2 * MiB;
constexpr size_t WS_G = WS_PK + 96 * MiB;
constexpr size_t WS_YLOC = WS_G + 16 * MiB;
constexpr size_t WS_QH = WS_YLOC + 32 * MiB;
constexpr size_t WS_WLOWT = WS_QH + 32 * MiB + 48 * MiB;
constexpr size_t WS_WRT = WS_WLOWT + 1 * MiB;
constexpr size_t WS_Y = WS_WLOWT;
constexpr size_t WS_YCAT = WS_Y + 32 * MiB;
constexpr size_t WS_Z1 = WS_YLOC;
constexpr size_t WS_H1 = WS_YCAT + 64 * MiB;
constexpr size_t WS_LIST = WS_H1 + 64 * MiB;
constexpr size_t WS_LISTW = WS_LIST + 2 * MiB;
constexpr size_t WS_H1B_OLD = WS_LISTW + 2 * MiB;
constexpr size_t WS_HID = WS_PROJ;
constexpr size_t WS_YS = WS_PK;
constexpr size_t WS_VTSB = WS_H1B_OLD + 32 * MiB;
constexpr size_t WS_VTMEM = WS_VTSB + 8 * MiB;
constexpr size_t WS_DBG = WS_VTMEM + 2 * MiB;
constexpr int NCH = 32;
constexpr size_t WS_PCH = WS_DBG + 64 * MiB;
constexpr size_t WS_LCH = WS_PCH + 32 * MiB;
constexpr size_t WS_SST = WS_LCH + 32 * MiB;
constexpr size_t WS_H1B = WS_PCH;
constexpr size_t WS_END = WS_SST + 32 * MiB;
constexpr int CW_CNT = 64;
constexpr int CW_Q = 160;
constexpr int CW_Q2 = 161;
constexpr int CW_DBG = 128;
constexpr int CW_BAR = 4096;

constexpr int LDS_BYTES = 147456;

#define XB_TMO      128
#define XB_XCNT(j)  (256  + 64 * (j))
#define XB_XSUB(j)  (1280 + 64 * (j))
#define XB_XGEN(j)  (2304 + 64 * (j))
#define XB_TOP      3328
#define XB_TOPGEN   3392
#define XCD_BAR_WORDS 3456
#define XB_SPIN_CAP (1u << 18)

__device__ __forceinline__ unsigned xb_ld(unsigned* p)              { return __hip_atomic_load(p, __ATOMIC_RELAXED, __HIP_MEMORY_SCOPE_AGENT); }
__device__ __forceinline__ unsigned xb_add(unsigned* p, unsigned v) { return __hip_atomic_fetch_add(p, v, __ATOMIC_RELAXED, __HIP_MEMORY_SCOPE_AGENT); }
__device__ __forceinline__ unsigned xb_xcc_id() { return (unsigned)__builtin_amdgcn_s_getreg((3 << 11) | 20) & 0xFu; }
#define XB_SPIN(cond, bar) do { unsigned _sp = 0; while (cond) { __builtin_amdgcn_s_sleep(1); \
    if ((++_sp & 255u) == 0u) { if (xb_ld(&(bar)[XB_TMO])) break; if (_sp > XB_SPIN_CAP) { atomicAdd(&(bar)[XB_TMO], 1u); break; } } } } while (0)

struct XcdBarrier { unsigned* bar; unsigned x; volatile LAS unsigned* st; };

__device__ __forceinline__ XcdBarrier xcd_barrier_post(unsigned* bar, volatile LAS unsigned* st) {
    XcdBarrier b; b.bar = bar; b.x = xb_xcc_id(); b.st = st;
    if (threadIdx.x == 0) (void)xb_add(&bar[XB_XCNT(b.x)], 1u);
    return b;
}
__device__ __forceinline__ void xcd_barrier_complete(unsigned* bar, unsigned x, unsigned& nloc, unsigned& nx) {
    const unsigned G = gridDim.x * gridDim.y * gridDim.z;
    unsigned sum, cnt, mine, sp = 0u;
    for (;;) {
        sum = 0u; cnt = 0u; mine = 0u;
#pragma unroll
        for (unsigned j = 0; j < 16; ++j) { const unsigned c = xb_ld(&bar[XB_XCNT(j)]); sum += c; cnt += (c > 0u) ? 1u : 0u; mine = (j == x) ? c : mine; }
        if (sum == G) break;
        __builtin_amdgcn_s_sleep(1);
        if ((++sp & 255u) == 0u) { if (xb_ld(&bar[XB_TMO])) break; if (sp > XB_SPIN_CAP) { atomicAdd(&bar[XB_TMO], 1u); break; } }
    }
    nloc = mine > 0u ? mine : 1u; nx = cnt > 0u ? cnt : 1u;
}
__device__ __forceinline__ void xcd_barrier(const XcdBarrier& b) {
    asm volatile("s_waitcnt vmcnt(0)" ::: "memory");
    __syncthreads();
    if (threadIdx.x == 0) {
        unsigned* bar = b.bar;
        __builtin_amdgcn_s_waitcnt(0);
        unsigned nloc = b.st[0], nx = b.st[1];
        if (nloc == 0u) { xcd_barrier_complete(bar, b.x, nloc, nx); b.st[0] = nloc; b.st[1] = nx; }
        const unsigned old = xb_add(&bar[XB_XSUB(b.x)], 1u);
        const unsigned gen = old / nloc;
        if (old + 1u == (gen + 1u) * nloc) {
            __builtin_amdgcn_fence(__ATOMIC_RELEASE, "agent");
            asm volatile("s_waitcnt vmcnt(0)" ::: "memory");
            const unsigned og = xb_add(&bar[XB_TOP], 1u);
            const unsigned tg = og / nx;
            if (og + 1u == (tg + 1u) * nx) xb_add(&bar[XB_TOPGEN], 1u);
            else XB_SPIN(xb_ld(&bar[XB_TOPGEN]) == tg, bar);
            __builtin_amdgcn_fence(__ATOMIC_ACQUIRE, "agent");
            xb_add(&bar[XB_XGEN(b.x)], 1u);
            asm volatile("s_waitcnt vmcnt(0)" ::: "memory");
        } else {
            XB_SPIN(xb_ld(&bar[XB_XGEN(b.x)]) == gen, bar);
            __builtin_amdgcn_fence(__ATOMIC_ACQUIRE, "agent");
            asm volatile("s_waitcnt vmcnt(0)" ::: "memory");
        }
    }
    __syncthreads();
}

__device__ __forceinline__ float wave_sum(float v) {
#pragma unroll
    for (int o = 1; o < 64; o <<= 1) v += __shfl_xor(v, o);
    return v;
}
__device__ __forceinline__ float wave_max(float v) {
#pragma unroll
    for (int o = 1; o < 64; o <<= 1) v = fmaxf(v, __shfl_xor(v, o));
    return v;
}
__device__ __forceinline__ float softplusf(float x) { return fmaxf(x, 0.f) + log1pf(expf(-fabsf(x))); }
__device__ __forceinline__ float sigmoidf(float x) { return 1.f / (1.f + expf(-x)); }
__device__ __forceinline__ float fsigmoid(float x) { return __builtin_amdgcn_rcpf(1.f + __expf(-x)); }
__device__ __forceinline__ float fsoftplus(float x) { return fmaxf(x, 0.f) + __logf(1.f + __expf(-fabsf(x))); }
__device__ __forceinline__ float ftanh(float x) { const float e = __expf(-2.f * fabsf(x)); const float t = (1.f - e) * __builtin_amdgcn_rcpf(1.f + e); return x < 0.f ? -t : t; }
__device__ __forceinline__ void wave_lds_sync() { asm volatile("s_waitcnt lgkmcnt(0)" ::: "memory"); __builtin_amdgcn_wave_barrier(); }

__device__ __forceinline__ unsigned f2bf(float f) { unsigned u = __builtin_bit_cast(unsigned, f); return (u + 0x7fffu + ((u >> 16) & 1u)) >> 16; }
__device__ __forceinline__ unsigned pk2(float lo, float hi) { return f2bf(lo) | (f2bf(hi) << 16); }
__device__ __forceinline__ float bf2f(bf16_t b) { return __builtin_bit_cast(float, (unsigned)b << 16); }
__device__ __forceinline__ float bflo(unsigned w) { return __builtin_bit_cast(float, w << 16); }
__device__ __forceinline__ float bfhi(unsigned w) { return __builtin_bit_cast(float, w & 0xffff0000u); }
#define LDS_WAIT() asm volatile("s_waitcnt lgkmcnt(0)" ::: "memory")

namespace pg8 {
#define PG8_LAS __attribute__((address_space(3)))
typedef unsigned short bf16_t;
typedef short bf16x8 __attribute__((ext_vector_type(8)));
typedef float f32x4 __attribute__((ext_vector_type(4)));
typedef unsigned u32x4 __attribute__((ext_vector_type(4)));
constexpr int BM = 256, BK = 64, HALF = 128, HTB = HALF * BK * 2  , STAGE_BYTES = 8 * HTB, NXCD = 8, WGM = 8;

__host__ __device__ __forceinline__ int lds_byte(int r, int c) { const int st = (r >> 4) * 2 + (c >> 5), rr = r & 15, cc = c & 31, ob = rr * 64 + cc * 2; return st * 1024 + (ob ^ (((ob >> 9) & 1) << 5)); }
__host__ __device__ __forceinline__ void stage_rc(int b, int& R, int& C) { const int st = b / 1024, sb = b % 1024, swz = sb ^ (((sb >> 9) & 1) << 5); R = (st >> 1) * 16 + swz / 64; C = (st & 1) * 32 + (swz % 64) / 2; }
__host__ __device__ __forceinline__ int perm32(int rho) { const int n = rho >> 4, i = rho & 15; return 8 * (i >> 2) + 4 * n + (i & 3); }

struct Unit { int pm, pn; };
struct Gemm { const bf16_t* A; const bf16_t* Bt; int M, N, K; };

struct StaticOrder {
    int nM, nN, nwg, G, c;
    __host__ __device__ void init(int M, int N, int G_, int c_) { nM = M / BM; nN = N / BM; nwg = nM * nN; G = G_; c = c_; }
    __host__ __device__ bool next(int i, Unit& u) const {
        const long L = (long)i * G + c; if (L >= nwg) return false;
        int wgid = (int)L; { const int q = nwg / NXCD, r = nwg % NXCD, xcd = wgid % NXCD, off = wgid / NXCD; wgid = (xcd < r ? xcd * (q + 1) : r * (q + 1) + (xcd - r) * q) + off; }
        const int nig = WGM * nN, gid = wgid / nig, fm = gid * WGM, gsz = (nM - fm) < WGM ? (nM - fm) : WGM;
        u.pm = fm + ((wgid % nig) % gsz); u.pn = (wgid % nig) / gsz; return true;
    }
    __device__ __forceinline__ void a_ready(const Unit&) const {}
    __device__ __forceinline__ void done(const Unit&) const {}
};
typedef __bf16 bf16x2_t __attribute__((ext_vector_type(2))); typedef float cvt_f32x2 __attribute__((ext_vector_type(2)));
__device__ __forceinline__ unsigned cvt_pk_bf16(float lo, float hi) { const cvt_f32x2 v = {lo, hi}; return __builtin_bit_cast(unsigned, __builtin_convertvector(v, bf16x2_t)); }


template <class Epi, class Sched, bool STAMP = false>
__device__ __forceinline__ void gemm_phase(PG8_LAS unsigned char* lds, const Gemm g, const Sched& S, const Epi& E, unsigned long long* stamps) {
    const int tid = threadIdx.x, wid = __builtin_amdgcn_readfirstlane(tid >> 6), lane = tid & 63, wr = wid >> 2, wc = wid & 3, fr = lane & 15, fq = lane >> 4;
    const int K = g.K, nt = K / BK;
    int ts_lo = 0, ts_hi = 0, nts = 0; const unsigned long long rt_entry = STAMP ? (unsigned long long)wall_clock64() : 0ull;
#define PG8_STAMP() do { if (STAMP && wid == 0 && nts < 64) { const unsigned long long _c = (unsigned long long)clock64(); \
        ts_lo = (lane == nts) ? (int)(unsigned)_c : ts_lo; ts_hi = (lane == nts) ? (int)(unsigned)(_c >> 32) : ts_hi; ++nts; } } while (0)
    PG8_STAMP();
    unsigned voffA[2], voffB[2];
#pragma unroll
    for (int i = 0; i < 2; ++i) { int R, C; stage_rc(tid * 16 + i * 8192, R, C); const int Rb = Epi::PERM ? ((R & ~31) + perm32(R & 31)) : R;
        voffA[i] = (unsigned)(R * K + C) * 2u; voffB[i] = (unsigned)(Rb * K + C) * 2u; }
    const size_t kstep = (size_t)(BK * 2);
    const size_t hstep = (size_t)HALF * K * 2;
    const size_t tstep = 2 * hstep;
    const unsigned ldsw = (unsigned)wid * 1024u;
    const int aoff = lds_byte(wr * 64 + fr, fq * 8), boff = lds_byte(wc * 32 + fr, fq * 8);
#define PG8_SA(b, h) (((b) * 2 + (h)) * HTB)
#define PG8_SB(b, h) ((4 + (b) * 2 + (h)) * HTB)
#define PG8_STAGE(bufoff, gbase, voff) do { _Pragma("unroll") for (int _i = 0; _i < 2; ++_i) \
        __builtin_amdgcn_global_load_lds((const unsigned*)((const char*)(gbase) + (voff)[_i]), (PG8_LAS unsigned*)(lds + (bufoff) + ldsw + _i * 8192), 16, 0, 0); } while (0)
#define PG8_LDA(dst, b, h) do { _Pragma("unroll") for (int m = 0; m < 4; ++m) _Pragma("unroll") for (int k = 0; k < 2; ++k) dst[m][k] = *(const PG8_LAS bf16x8*)(lds + PG8_SA(b, h) + aoff + m * 2048 + k * 1024); } while (0)
#define PG8_LDB(dst, b, h) do { _Pragma("unroll") for (int n = 0; n < 2; ++n) _Pragma("unroll") for (int k = 0; k < 2; ++k) dst[n][k] = *(const PG8_LAS bf16x8*)(lds + PG8_SB(b, h) + boff + n * 2048 + k * 1024); } while (0)
#define PG8_MMA(ai, bj, At, Bt) do { __builtin_amdgcn_s_setprio(1); _Pragma("unroll") for (int m = 0; m < 4; ++m) _Pragma("unroll") for (int n = 0; n < 2; ++n) _Pragma("unroll") for (int k = 0; k < 2; ++k) \
        acc[ai][bj][m][n] = __builtin_amdgcn_mfma_f32_16x16x32_bf16(Bt[n][k], At[m][k], acc[ai][bj][m][n], 0, 0, 0); __builtin_amdgcn_s_setprio(0); } while (0)
#define PG8_WAIT_V(n) asm volatile("s_waitcnt vmcnt(" #n ")" ::: "memory")
#define PG8_WAIT_L(n) asm volatile("s_waitcnt lgkmcnt(" #n ")" ::: "memory")
#define PG8_BAR __builtin_amdgcn_s_barrier()
#define PG8_SCHED __builtin_amdgcn_sched_barrier(0)
    Unit cur, nxt; int ui = 0;
    if (!S.next(0, cur)) return;
    f32x4 acc[2][2][4][2];
#pragma unroll
    for (int a = 0; a < 2; ++a)
#pragma unroll
        for (int b = 0; b < 2; ++b)
#pragma unroll
            for (int m = 0; m < 4; ++m)
#pragma unroll
                for (int n = 0; n < 2; ++n) acc[a][b][m][n] = (f32x4){0.f, 0.f, 0.f, 0.f};
    bf16x8 At[4][2], B0[2][2], B1[2][2];
    const char* cA = (const char*)g.A + (size_t)cur.pm * tstep; const char* cB = (const char*)g.Bt + (size_t)cur.pn * tstep;
    S.a_ready(cur);
    PG8_STAGE(PG8_SB(0, 0), cB, voffB); PG8_STAGE(PG8_SA(0, 0), cA, voffA); PG8_STAGE(PG8_SB(0, 1), cB + hstep, voffB); PG8_STAGE(PG8_SA(0, 1), cA + hstep, voffA);
    if (wr == 1) PG8_BAR;
    PG8_WAIT_V(4); PG8_BAR;
    PG8_STAGE(PG8_SB(1, 0), cB + kstep, voffB); PG8_STAGE(PG8_SA(1, 0), cA + kstep, voffA); PG8_STAGE(PG8_SB(1, 1), cB + hstep + kstep, voffB);
    PG8_WAIT_V(6); PG8_BAR;
    PG8_STAMP();
    for (;;) {
        const bool has_next = S.next(ui + 1, nxt);
        const char* nA = has_next ? (const char*)g.A + (size_t)nxt.pm * tstep : cA; const char* nB = has_next ? (const char*)g.Bt + (size_t)nxt.pn * tstep : cB;
        for (int t = 0; t < nt; t += 2) {
            const bool last = (t == nt - 2);
            const char* a1 = cA + (size_t)(t + 1) * kstep;
            const char* a2 = last ? nA : cA + (size_t)(t + 2) * kstep; const char* b2 = last ? nB : cB + (size_t)(t + 2) * kstep;
            const char* a3 = a2 + kstep; const char* b3 = b2 + kstep;
            if (last && has_next) S.a_ready(nxt);
            PG8_LDB(B0, 0, 0); PG8_SCHED; PG8_LDA(At, 0, 0); PG8_STAGE(PG8_SA(1, 1), a1 + hstep, voffA);
            PG8_WAIT_L(8); PG8_BAR; PG8_WAIT_L(0); PG8_MMA(0, 0, At, B0); PG8_BAR; PG8_SCHED;
            PG8_LDB(B1, 0, 1); PG8_STAGE(PG8_SB(0, 0), b2, voffB);
            PG8_BAR; PG8_WAIT_L(0); PG8_MMA(0, 1, At, B1); PG8_BAR;
            PG8_LDA(At, 0, 1); PG8_STAGE(PG8_SA(0, 0), a2, voffA);
            PG8_BAR; PG8_WAIT_L(0); PG8_MMA(1, 0, At, B0); PG8_BAR; PG8_SCHED;
            PG8_STAGE(PG8_SB(0, 1), b2 + hstep, voffB);
            PG8_WAIT_V(6); PG8_BAR; PG8_MMA(1, 1, At, B1); PG8_BAR;
            PG8_LDB(B0, 1, 0); PG8_SCHED; PG8_LDA(At, 1, 0); PG8_STAGE(PG8_SA(0, 1), a2 + hstep, voffA);
            PG8_WAIT_L(8); PG8_BAR; PG8_WAIT_L(0); PG8_MMA(0, 0, At, B0); PG8_BAR; PG8_SCHED;
            PG8_LDB(B1, 1, 1); PG8_STAGE(PG8_SB(1, 0), b3, voffB);
            PG8_BAR; PG8_WAIT_L(0); PG8_MMA(0, 1, At, B1); PG8_BAR;
            PG8_LDA(At, 1, 1); PG8_STAGE(PG8_SA(1, 0), a3, voffA);
            PG8_BAR; PG8_WAIT_L(0); PG8_MMA(1, 0, At, B0); PG8_BAR; PG8_SCHED;
            PG8_STAGE(PG8_SB(1, 1), b3 + hstep, voffB);
            PG8_WAIT_V(6); PG8_BAR; PG8_MMA(1, 1, At, B1); PG8_BAR;
        }
        PG8_STAMP();
        if constexpr (!Epi::AFTER_DRAIN) { E(acc, cur, wr, wc, fr, fq); S.done(cur); }
        PG8_STAMP();
        if (!has_next) break;
#pragma unroll
        for (int a = 0; a < 2; ++a)
#pragma unroll
            for (int b = 0; b < 2; ++b)
#pragma unroll
                for (int m = 0; m < 4; ++m)
#pragma unroll
                    for (int n = 0; n < 2; ++n) acc[a][b][m][n] = (f32x4){0.f, 0.f, 0.f, 0.f};
        cur = nxt; cA = nA; cB = nB; ++ui;
    }
    PG8_WAIT_V(0);
    if (wr == 0) PG8_BAR;
    PG8_BAR;
    if constexpr (Epi::AFTER_DRAIN) { E.fused(acc, cur, wr, wc, fr, fq, lds, wid, lane); S.done(cur); }
    PG8_STAMP();
    if (STAMP && wid == 0) { stamps[lane] = lane < nts ? (((unsigned long long)(unsigned)ts_hi << 32) | (unsigned)ts_lo) : 0ull;
        if (lane == 62) stamps[62] = rt_entry; if (lane == 63) stamps[63] = (unsigned long long)wall_clock64(); }
#undef PG8_STAMP
#undef PG8_SA
#undef PG8_SB
#undef PG8_STAGE
#undef PG8_LDA
#undef PG8_LDB
#undef PG8_MMA
#undef PG8_WAIT_V
#undef PG8_WAIT_L
#undef PG8_BAR
#undef PG8_SCHED
}
}


struct Args { const float* in[29]; float* out; unsigned char* ws; int ph_lo, ph_hi; };
struct Frame {
    LAS unsigned char* lds;
    int tid, lane, wave, bid, G;
    unsigned* ctl;
    const Args* a;
    float* out;
    unsigned char* ws;
};
enum { I_X = 0, I_MEM, I_LNIN_G, I_LNIN_B, I_WIN, I_MU, I_W0, I_WDEC, I_A0, I_WA, I_WG, I_KK, I_KA, I_RK, I_LNXG, I_LNXB, I_WMEMKV, I_WOUT, I_LN1G, I_LN1B,
       I_RG, I_RGB, I_RE, I_REB, I_WEG, I_WEU, I_WED, I_LN2G, I_LN2B };

template <class AF, class EF>
__device__ __forceinline__ void gemm_naive(Frame& F, int M, int N, int K, const AF arow, const float* B, int ldb, const EF epi, int tile_base) {
    LAS float* As = (LAS float*)F.lds;
    LAS float* Bs = As + 16 * 132;
    const int tid = F.tid;
    const int tm = (M + 127) / 128, tn = (N + 63) / 64, nt = tm * tn;
    const int ty = tid >> 4, tx = tid & 15;
    const int lr = tid >> 2, lk = (tid & 3) * 4;
    const int bk = (tid >> 4) & 15, bc = (tid & 15) * 4;
    for (int lt = 0; lt < nt; ++lt) {
        if ((tile_base + lt) % F.G != F.bid) continue;
        const int m0 = (lt / tn) * 128, n0 = (lt % tn) * 64;
        const float* ap = (m0 + lr < M) ? arow(m0 + lr) : nullptr;
        const bool bok = (tid < 256) && (n0 + bc < N);
        float acc[4][4];
#pragma unroll
        for (int i = 0; i < 4; ++i)
#pragma unroll
            for (int j = 0; j < 4; ++j) acc[i][j] = 0.f;
        for (int k0 = 0; k0 < K; k0 += 16) {
            f32x4 av = (f32x4){0.f, 0.f, 0.f, 0.f}, bv = (f32x4){0.f, 0.f, 0.f, 0.f};
            if (ap) av = *(const f32x4*)(ap + k0 + lk);
            if (bok) bv = *(const f32x4*)(B + (size_t)(k0 + bk) * ldb + n0 + bc);
            __syncthreads();
            As[(lk + 0) * 132 + lr] = av.x; As[(lk + 1) * 132 + lr] = av.y; As[(lk + 2) * 132 + lr] = av.z; As[(lk + 3) * 132 + lr] = av.w;
            if (tid < 256) *(LAS f32x4*)(Bs + bk * 64 + bc) = bv;
            __syncthreads();
#pragma unroll
            for (int k = 0; k < 16; ++k) {
                const f32x4 a = *(const LAS f32x4*)(As + k * 132 + ty * 4);
                const f32x4 b = *(const LAS f32x4*)(Bs + k * 64 + tx * 4);
#pragma unroll
                for (int i = 0; i < 4; ++i)
#pragma unroll
                    for (int j = 0; j < 4; ++j) acc[i][j] += a[i] * b[j];
            }
        }
#pragma unroll
        for (int i = 0; i < 4; ++i) {
            const int r = m0 + ty * 4 + i, c = n0 + tx * 4;
            if (r < M && c < N) epi(r, c, (f32x4){acc[i][0], acc[i][1], acc[i][2], acc[i][3]});
        }
    }
    __syncthreads();
}
struct ARowPlain { const float* A; int lda; __device__ __forceinline__ const float* operator()(int r) const { return A + (size_t)r * lda; } };
struct ARowList { const float* A; int lda; const int* list; __device__ __forceinline__ const float* operator()(int r) const { return A + (size_t)(list[r] >> 1) * lda; } };
struct ARowOff { const float* A; int lda; __device__ __forceinline__ const float* operator()(int r) const { return A + (size_t)r * lda; } };
struct EpiStore { float* Cm; int ldc; __device__ __forceinline__ void operator()(int r, int c, f32x4 v) const { *(f32x4*)(Cm + (size_t)r * ldc + c) = v; } };
struct EpiResid { float* Cm; const float* R; int ldc; float alpha; __device__ __forceinline__ void operator()(int r, int c, f32x4 v) const {
    const f32x4 h = *(const f32x4*)(R + (size_t)r * ldc + c); *(f32x4*)(Cm + (size_t)r * ldc + c) = h * alpha + v; } };
struct EpiSilu { float* Hd; const float* Gt; int ldc; __device__ __forceinline__ void operator()(int r, int c, f32x4 u) const {
    const f32x4 g = *(const f32x4*)(Gt + (size_t)r * ldc + c); f32x4 o;
#pragma unroll
    for (int i = 0; i < 4; ++i) o[i] = g[i] / (1.f + expf(-g[i])) * u[i];
    *(f32x4*)(Hd + (size_t)r * ldc + c) = o; } };
struct EpiScatter { float* YS; const int* list; const float* lw; __device__ __forceinline__ void operator()(int r, int c, f32x4 v) const {
    const int e = list[r]; const float w = lw[r]; *(f32x4*)(YS + (size_t)e * D + c) = v * w; } };

template <bool STORE = true>
__device__ __forceinline__ void ln_core(f32x4 (&v)[8], const float* g, const float* b, float* out, int lane) {
    float s = 0.f;
#pragma unroll
    for (int j = 0; j < 8; ++j) s += (v[j].x + v[j].y) + (v[j].z + v[j].w);
    const float mean = wave_sum(s) * (1.f / D);
    float s2 = 0.f;
#pragma unroll
    for (int j = 0; j < 8; ++j) { v[j] = v[j] - mean; s2 += (v[j].x * v[j].x + v[j].y * v[j].y) + (v[j].z * v[j].z + v[j].w * v[j].w); }
    const float rstd = 1.f / sqrtf(wave_sum(s2) * (1.f / D) + LN_EPS);
#pragma unroll
    for (int j = 0; j < 8; ++j) {
        const f32x4 gg = ((const f32x4*)g)[lane + 64 * j], bb = ((const f32x4*)b)[lane + 64 * j];
        v[j] = v[j] * rstd * gg + bb;
        if (STORE) ((f32x4*)out)[lane + 64 * j] = v[j];
    }
}

__device__ __forceinline__ void p0_transpose_item(const float* W, int K, int N, bf16_t* WT, LAS float* scr, int item, int lane) {
    const int nblk = N / 32, kb = item / nblk, nb = item % nblk, k0 = 64 * kb, n0 = 32 * nb;
#pragma unroll 8
    for (int i = 0; i < 32; ++i) { const int kk = 2 * i + (lane >> 5); scr[kk * 33 + (lane & 31)] = __builtin_nontemporal_load(W + (size_t)(k0 + kk) * N + n0 + (lane & 31)); }
    LDS_WAIT(); asm volatile("" ::: "memory");
    const int c = lane & 7;
#pragma unroll
    for (int j = 0; j < 4; ++j) { const int n = (lane >> 3) + 8 * j; const LAS float* sp = scr + (8 * c) * 33 + n;
        v4u o; o.x = pk2(sp[0 * 33], sp[1 * 33]); o.y = pk2(sp[2 * 33], sp[3 * 33]); o.z = pk2(sp[4 * 33], sp[5 * 33]); o.w = pk2(sp[6 * 33], sp[7 * 33]);
        *(v4u*)(WT + (size_t)(n0 + n) * K + k0 + 8 * c) = o; }
    LDS_WAIT(); asm volatile("" ::: "memory");
}
__device__ __forceinline__ void ph_prologue(Frame& F) {
    bf16_t* HB = (bf16_t*)(F.ws + WS_HB);
    bf16_t* MEMB = (bf16_t*)(F.ws + WS_MEMB);
    bf16_t* WINT = (bf16_t*)(F.ws + WS_WINT);
    bf16_t* WMKVT = (bf16_t*)(F.ws + WS_WMKVT);
    const int gw = F.bid * NWAVES + F.wave, NGW = F.G * NWAVES;
    LAS float* scr = (LAS float*)(F.lds + F.wave * 16384);
    constexpr int I_IN = (D / 64) * (IN_COLS / 32), I_MKV = (D / 64) * (2 * MEMW / 32);
    for (int it = gw; it < I_IN + I_MKV; it += NGW) {
        int r = it;
        if (r < I_IN) { p0_transpose_item(F.a->in[I_WIN], D, IN_COLS, WINT, scr, r, F.lane); continue; } r -= I_IN;
        p0_transpose_item(F.a->in[I_WMEMKV], D, 2 * MEMW, WMKVT, scr, r, F.lane);
    }
    { bf16_t* WL = (bf16_t*)(F.ws + WS_WLOWT);
      for (int i = F.bid * NT + F.tid; i < C * (LOWR / 8); i += F.G * NT) { const int c = i % C, kc = i / C, k0 = kc * 8;
          const float* src; int kk0;
          if (k0 < DR) { src = F.a->in[I_WDEC]; kk0 = k0; } else if (k0 < DR + AR) { src = F.a->in[I_WA]; kk0 = k0 - DR; } else { src = F.a->in[I_WG]; kk0 = k0 - DR - AR; }
          v4u o; o.x = pk2(src[(size_t)(kk0 + 0) * C + c], src[(size_t)(kk0 + 1) * C + c]); o.y = pk2(src[(size_t)(kk0 + 2) * C + c], src[(size_t)(kk0 + 3) * C + c]);
          o.z = pk2(src[(size_t)(kk0 + 4) * C + c], src[(size_t)(kk0 + 5) * C + c]); o.w = pk2(src[(size_t)(kk0 + 6) * C + c], src[(size_t)(kk0 + 7) * C + c]);
          *(v4u*)(WL + (size_t)c * LOWR + k0) = o; } }
    { bf16_t* WR = (bf16_t*)(F.ws + WS_WRT);
      for (int i = F.bid * NT + F.tid; i < 80 * D; i += F.G * NT) { const int k = i % D, col = i / D;
          const float w = col < NG ? F.a->in[I_RG][(size_t)k * NG + col] : (col < NG + NE ? F.a->in[I_RE][(size_t)k * NE + (col - NG)] : 0.f);
          const unsigned hi = f2bf(w); const float rem = w - __builtin_bit_cast(float, hi << 16);
          const size_t fo = ((size_t)((k >> 5) * 5 + (col >> 4)) * 64 + (col & 15) + 16 * ((k >> 3) & 3)) * 8 + (k & 7);
          WR[fo] = (bf16_t)hi; WR[(size_t)80 * D + fo] = (bf16_t)f2bf(rem); } }
    for (size_t i = (size_t)F.bid * NT + F.tid; i < (size_t)(PLD - IN_COLS) * D / 8; i += (size_t)F.G * NT) ((v4u*)(WINT + (size_t)IN_COLS * D))[i] = (v4u){0u, 0u, 0u, 0u};
    for (size_t i = (size_t)F.bid * NT + F.tid; i < (size_t)BATCH * MEML * D / 4; i += (size_t)F.G * NT) {
        const f32x4 v = ((const f32x4*)F.a->in[I_MEM])[i]; ((v2u*)MEMB)[i] = (v2u){pk2(v.x, v.y), pk2(v.z, v.w)}; }
    f32x4 xn[8];
    { const f32x4* xr = (const f32x4*)(F.a->in[I_X] + (size_t)(gw < T ? gw : T - 1) * D);
#pragma unroll
      for (int j = 0; j < 8; ++j) xn[j] = __builtin_nontemporal_load(xr + F.lane + 64 * j); }
    for (int row = gw; row < T; row += NGW) {
        f32x4 v[8];
#pragma unroll
        for (int j = 0; j < 8; ++j) v[j] = xn[j];
        { const f32x4* xr = (const f32x4*)(F.a->in[I_X] + (size_t)(row + NGW < T ? row + NGW : row) * D);
#pragma unroll
          for (int j = 0; j < 8; ++j) xn[j] = __builtin_nontemporal_load(xr + F.lane + 64 * j); }
        ln_core<false>(v, F.a->in[I_LNIN_G], F.a->in[I_LNIN_B], nullptr, F.lane);
#pragma unroll
        for (int j = 0; j < 8; ++j) ((v2u*)(HB + (size_t)row * D))[F.lane + 64 * j] = (v2u){pk2(v[j].x, v[j].y), pk2(v[j].z, v[j].w)};
    }
    __syncthreads();
}
struct ProjOrder {
    int G, c;
    __device__ __forceinline__ bool next(int i, pg8::Unit& u) const {
        constexpr int nM = T / 256, nN = PLD / 256, nwg = nM * nN;
        const int L = i * G + c;
        if (L >= nwg + 16) return false;
        if (L >= nwg) { const int j = L - nwg; u.pm = nM + (j >> 2); u.pn = nN + (j & 3); return true; }
        int wgid = L; { const int q = nwg / pg8::NXCD, r = nwg % pg8::NXCD, xcd = wgid % pg8::NXCD, off = wgid / pg8::NXCD; wgid = (xcd < r ? xcd * (q + 1) : r * (q + 1) + (xcd - r) * q) + off; }
        const int nig = pg8::WGM * nN, gid = wgid / nig, fm = gid * pg8::WGM, gsz = (nM - fm) < pg8::WGM ? (nM - fm) : pg8::WGM;
        u.pm = fm + ((wgid % nig) % gsz); u.pn = (wgid % nig) / gsz; return true;
    }
    __device__ __forceinline__ void a_ready(const pg8::Unit&) const {}
    __device__ __forceinline__ void done(const pg8::Unit&) const {}
};
struct EpiProj {
    static constexpr bool PERM = true, AFTER_DRAIN = false;
    bf16_t* P; bf16_t* MKV;
    __device__ __forceinline__ void operator()(const pg8::f32x4 (&acc)[2][2][4][2], const pg8::Unit& u, int wr, int wc, int fr, int fq) const {
        bf16_t* base; int ldc, row0, col0;
        if (u.pm < T / 256) { base = P; ldc = PLD; row0 = u.pm * 256 + wr * 64 + fr; col0 = u.pn * 256 + wc * 32 + 8 * fq; }
        else { base = MKV; ldc = 2 * MEMW; row0 = (u.pm - T / 256) * 256 + wr * 64 + fr; col0 = (u.pn - PLD / 256) * 256 + wc * 32 + 8 * fq; }
#pragma unroll
        for (int ai = 0; ai < 2; ++ai)
#pragma unroll
            for (int m = 0; m < 4; ++m) { bf16_t* rowp = base + (size_t)(row0 + ai * 128 + m * 16) * ldc + col0;
#pragma unroll
                for (int bj = 0; bj < 2; ++bj) { const pg8::f32x4 v0 = acc[ai][bj][m][0], v1 = acc[ai][bj][m][1];
                    v4u w; w.x = pg8::cvt_pk_bf16(v0[0], v0[1]); w.y = pg8::cvt_pk_bf16(v0[2], v0[3]); w.z = pg8::cvt_pk_bf16(v1[0], v1[1]); w.w = pg8::cvt_pk_bf16(v1[2], v1[3]);
                    *(v4u*)(rowp + bj * 128) = w; } }
    }
};
__device__ __forceinline__ void ph_proj(Frame& F) {
    pg8::Gemm g{(const bf16_t*)(F.ws + WS_HB), (const bf16_t*)(F.ws + WS_WINT), T + BATCH * MEML, PLD + 2 * MEMW, D};
    ProjOrder S{F.G, F.bid};
    EpiProj E{(bf16_t*)(F.ws + WS_PROJ), (bf16_t*)(F.ws + WS_MEMKV)};
    pg8::gemm_phase<EpiProj, ProjOrder, false>(F.lds, g, S, E, nullptr);
    __syncthreads();
    { constexpr int I_OUT = (D / 64) * (D / 32);
      bf16_t* WOUTT = (bf16_t*)(F.ws + WS_WOUTT);
      LAS float* scr = (LAS float*)(F.lds + F.wave * 16384);
      volatile LAS int* qslot = (volatile LAS int*)(F.lds + 139264);
      for (;;) {
          if (F.tid == 0) *qslot = (int)atomicAdd(F.ctl + CW_Q2, 2u * NWAVES);
          __syncthreads();
          const int base = *qslot;
          __syncthreads();
          if (base >= I_OUT) break;
#pragma unroll 1
          for (int q = 0; q < 2; ++q) { const int itq = base + 2 * F.wave + q; if (itq < I_OUT) p0_transpose_item(F.a->in[I_WOUT], D, D, WOUTT, scr, itq, F.lane); }
      } }
    __syncthreads();
}
__device__ __forceinline__ void ph_rwkv_prep(Frame& F) {
    using pg8::bf16x8;
    typedef float f4 __attribute__((ext_vector_type(4)));
    constexpr int AS = 296;
    constexpr int KSL = 1040;
    const bf16_t* P = (const bf16_t*)(F.ws + WS_PROJ);
    const bf16_t* WL = (const bf16_t*)(F.ws + WS_WLOWT);
    bf16_t* PK = (bf16_t*)(F.ws + WS_PK);
    bf16_t* GB = (bf16_t*)(F.ws + WS_G);
    const float* mu = F.a->in[I_MU];
    LAS bf16_t* act = (LAS bf16_t*)F.lds;
    LAS bf16_t* ksl = (LAS bf16_t*)(F.lds + 20480);
    LAS float* par = (LAS float*)(F.lds + 20480 + 66560);
    const int tid = F.tid, lane = F.lane, wave = F.wave, fr = lane & 15, fq = lane >> 4;
    for (int item = F.bid; item < T / 32; item += F.G) {
        const int t0 = item * 32;
        __syncthreads();
        { const int q = tid >> 8, e = (tid & 255) * 4;
          *(LAS f32x4*)(par + q * 1024 + e) = *(const f32x4*)((q ? F.a->in[I_A0] : F.a->in[I_W0]) + e);
          *(LAS f32x4*)(par + (2 + q) * 1024 + e) = *(const f32x4*)((q ? F.a->in[I_KA] : F.a->in[I_KK]) + e); }
        { v4u cu[3], pv[3]; f32x4 m0[3], m1[3];
#pragma unroll
          for (int i = 0; i < 3; ++i) { int idx = tid + NT * i; idx = idx < 32 * 36 ? idx : 32 * 36 - 1;
              const int tt = idx / 36, ch = idx % 36, t = t0 + tt, col = COL_DL + 8 * ch;
              const bf16_t* pc = P + (size_t)t * PLD + col;
              cu[i] = *(const v4u*)pc; pv[i] = *(const v4u*)((t % SEQ) ? pc - PLD : pc);
              m0[i] = *(const f32x4*)(mu + col); m1[i] = *(const f32x4*)(mu + col + 4); }
#pragma unroll
          for (int i = 0; i < 3; ++i) { const int idx = tid + NT * i, tt = idx / 36, ch = idx % 36, t = t0 + tt;
              const bool hp = (t % SEQ) != 0;
              const float c[8] = {bflo(cu[i].x), bfhi(cu[i].x), bflo(cu[i].y), bfhi(cu[i].y), bflo(cu[i].z), bfhi(cu[i].z), bflo(cu[i].w), bfhi(cu[i].w)};
              const float q[8] = {bflo(pv[i].x), bfhi(pv[i].x), bflo(pv[i].y), bfhi(pv[i].y), bflo(pv[i].z), bfhi(pv[i].z), bflo(pv[i].w), bfhi(pv[i].w)};
              const float mm[8] = {m0[i].x, m0[i].y, m0[i].z, m0[i].w, m1[i].x, m1[i].y, m1[i].z, m1[i].w};
              float a[8];
#pragma unroll
              for (int e = 0; e < 8; ++e) { const float xs = c[e] + ((hp ? q[e] : 0.f) - c[e]) * mm[e];
                  a[e] = ch < DR / 8 ? ftanh(xs) : (ch < (DR + AR) / 8 ? xs : fsigmoid(xs)); }
              if (idx < 32 * 36) *(LAS v4u*)(act + tt * AS + 8 * ch) = (v4u){pg8::cvt_pk_bf16(a[0], a[1]), pg8::cvt_pk_bf16(a[2], a[3]), pg8::cvt_pk_bf16(a[4], a[5]), pg8::cvt_pk_bf16(a[6], a[7])}; } }
#pragma unroll 1
        for (int i0 = 0; i0 < 24; i0 += 4) {
            v4u cu[4], pv[4]; f32x4 m0[4], m1[4];
#pragma unroll
            for (int i = 0; i < 4; ++i) { const int idx = tid + NT * (i0 + i), tt = idx / 384, col = 8 * (idx % 384), t = t0 + tt;
                const bf16_t* pc = P + (size_t)t * PLD + col;
                cu[i] = *(const v4u*)pc; pv[i] = *(const v4u*)((t % SEQ) ? pc - PLD : pc);
                m0[i] = *(const f32x4*)(mu + col); m1[i] = *(const f32x4*)(mu + col + 4); }
#pragma unroll
            for (int i = 0; i < 4; ++i) { const int idx = tid + NT * (i0 + i), tt = idx / 384, col = 8 * (idx % 384), t = t0 + tt, b = t / SEQ, tl = t % SEQ;
                const bool hp = tl != 0;
                const float c[8] = {bflo(cu[i].x), bfhi(cu[i].x), bflo(cu[i].y), bfhi(cu[i].y), bflo(cu[i].z), bfhi(cu[i].z), bflo(cu[i].w), bfhi(cu[i].w)};
                const float q[8] = {bflo(pv[i].x), bfhi(pv[i].x), bflo(pv[i].y), bfhi(pv[i].y), bflo(pv[i].z), bfhi(pv[i].z), bflo(pv[i].w), bfhi(pv[i].w)};
                const float mm[8] = {m0[i].x, m0[i].y, m0[i].z, m0[i].w, m1[i].x, m1[i].y, m1[i].z, m1[i].w};
                float o[8];
#pragma unroll
                for (int e = 0; e < 8; ++e) o[e] = c[e] + ((hp ? q[e] : 0.f) - c[e]) * mm[e];
                const v4u w = (v4u){pg8::cvt_pk_bf16(o[0], o[1]), pg8::cvt_pk_bf16(o[2], o[3]), pg8::cvt_pk_bf16(o[4], o[5]), pg8::cvt_pk_bf16(o[6], o[7])};
                const int reg = col >> 10, ch = col & 1023;
                if (reg == 1) *(LAS v4u*)(ksl + tt * KSL + ch) = w;
                else *(v4u*)(PK + ((size_t)(b * NH + (ch >> 6)) * SEQ + tl) * 384 + (reg ? 320 : 0) + (ch & 63)) = w; }
        }
        __syncthreads();
#pragma unroll 1
        for (int hd = 0; hd < 2; ++hd) {
            const int h = 2 * wave + hd;
            f4 ad[2][4], aa[2][4], ag[2][4];
#pragma unroll
            for (int m = 0; m < 2; ++m)
#pragma unroll
                for (int n = 0; n < 4; ++n) { ad[m][n] = (f4){0.f, 0.f, 0.f, 0.f}; aa[m][n] = ad[m][n]; ag[m][n] = ad[m][n]; }
            const LAS bf16_t* arow = act + fr * AS + 8 * fq;
            const bf16_t* wrow = WL + (size_t)(64 * h + fr) * LOWR + 8 * fq;
#pragma unroll
            for (int ks = 0; ks < 9; ++ks) {
                const bf16x8 b0 = *(const LAS bf16x8*)(arow + 32 * ks), b1 = *(const LAS bf16x8*)(arow + 16 * AS + 32 * ks);
#pragma unroll
                for (int n = 0; n < 4; ++n) { const bf16x8 af = *(const bf16x8*)(wrow + (size_t)(16 * n) * LOWR + 32 * ks);
                    if (ks < 2) { ad[0][n] = __builtin_amdgcn_mfma_f32_16x16x32_bf16(af, b0, ad[0][n], 0, 0, 0); ad[1][n] = __builtin_amdgcn_mfma_f32_16x16x32_bf16(af, b1, ad[1][n], 0, 0, 0); }
                    else if (ks < 4) { aa[0][n] = __builtin_amdgcn_mfma_f32_16x16x32_bf16(af, b0, aa[0][n], 0, 0, 0); aa[1][n] = __builtin_amdgcn_mfma_f32_16x16x32_bf16(af, b1, aa[1][n], 0, 0, 0); }
                    else { ag[0][n] = __builtin_amdgcn_mfma_f32_16x16x32_bf16(af, b0, ag[0][n], 0, 0, 0); ag[1][n] = __builtin_amdgcn_mfma_f32_16x16x32_bf16(af, b1, ag[1][n], 0, 0, 0); } }
                if (ks % 3 == 2) __builtin_amdgcn_sched_barrier(0);
            }
#pragma unroll
            for (int m = 0; m < 2; ++m)
#pragma unroll
                for (int n = 0; n < 4; ++n) *(v2u*)(GB + (size_t)(t0 + 16 * m + fr) * C + 64 * h + 16 * n + 4 * fq) = (v2u){pg8::cvt_pk_bf16(ag[m][n][0], ag[m][n][1]), pg8::cvt_pk_bf16(ag[m][n][2], ag[m][n][3])};
            __builtin_amdgcn_sched_barrier(0);
#pragma unroll
            for (int m = 0; m < 2; ++m) {
                const int t = t0 + 16 * m + fr, b = t / SEQ, tl = t % SEQ;
                bf16_t* pk = PK + ((size_t)(b * NH + h) * SEQ + tl) * 384 + 4 * fq;
                const LAS bf16_t* kr = ksl + (16 * m + fr) * KSL + 64 * h + 4 * fq;
                float ks_[4][4], av[4][4], kkr[4][4];
                float ss = 0.f;
#pragma unroll
                for (int n = 0; n < 4; ++n) {
                    const int c0 = 64 * h + 16 * n + 4 * fq;
                    const v2u kc = *(const LAS v2u*)(kr + 16 * n);
                    const f32x4 w0 = *(const LAS f32x4*)(par + c0), a0 = *(const LAS f32x4*)(par + 1024 + c0), kkc = *(const LAS f32x4*)(par + 2048 + c0);
                    const float kcv[4] = {bflo(kc.x), bfhi(kc.x), bflo(kc.y), bfhi(kc.y)};
                    float lw[4];
#pragma unroll
                    for (int r = 0; r < 4; ++r) {
                        ks_[n][r] = kcv[r];
                        const float wl = w0[r] + ad[m][n][r];
                        const float wlog = -fsoftplus(-wl) - 0.5f;
                        lw[r] = -__expf(wlog);
                        av[n][r] = fsigmoid(a0[r] + aa[m][n][r]);
                        kkr[n][r] = ks_[n][r] * kkc[r];
                        ss += kkr[n][r] * kkr[n][r];
                    }
                    *(v2u*)(pk + 16 * n + 64) = (v2u){pg8::cvt_pk_bf16(lw[0], lw[1]), pg8::cvt_pk_bf16(lw[2], lw[3])};
                }
                ss += __shfl_xor(ss, 16); ss += __shfl_xor(ss, 32);
                const float inv = 1.f / fmaxf(sqrtf(ss), 1e-12f);
#pragma unroll
                for (int n = 0; n < 4; ++n) {
                    const int c0 = 64 * h + 16 * n + 4 * fq;
                    const f32x4 kac = *(const LAS f32x4*)(par + 3072 + c0);
                    float kk[4], k2[4], bb[4];
#pragma unroll
                    for (int r = 0; r < 4; ++r) { kk[r] = kkr[n][r] * inv; k2[r] = ks_[n][r] * (1.f + (av[n][r] - 1.f) * kac[r]); bb[r] = kk[r] * av[n][r]; }
                    bf16_t* pn = pk + 16 * n;
                    *(v2u*)(pn + 128) = (v2u){pg8::cvt_pk_bf16(k2[0], k2[1]), pg8::cvt_pk_bf16(k2[2], k2[3])};
                    *(v2u*)(pn + 192) = (v2u){pg8::cvt_pk_bf16(-kk[0], -kk[1]), pg8::cvt_pk_bf16(-kk[2], -kk[3])};
                    *(v2u*)(pn + 256) = (v2u){pg8::cvt_pk_bf16(bb[0], bb[1]), pg8::cvt_pk_bf16(bb[2], bb[3])};
                }
            }
        }
    }
    __syncthreads();
}
__device__ __forceinline__ float dpp_sum8(float x) {
    x += __builtin_bit_cast(float, __builtin_amdgcn_update_dpp(0, __builtin_bit_cast(int, x), 0xB1, 0xF, 0xF, false));
    x += __builtin_bit_cast(float, __builtin_amdgcn_update_dpp(0, __builtin_bit_cast(int, x), 0x4E, 0xF, 0xF, false));
    x += __builtin_bit_cast(float, __builtin_amdgcn_update_dpp(0, __builtin_bit_cast(int, x), 0x141, 0xF, 0xF, false));
    return x;
}
template <bool IDENT>
__device__ __forceinline__ void wkv_steps8(f32x2 (&s)[4][8], const LAS float* buf, float* yout, const int vg, const int kg) {
#pragma unroll 1
    for (int st = 0; st < 8; ++st) {
        const LAS float* vb = buf + st * 384 + kg * 16;
        float sa[4], y[4];
        {
            f32x2 aa[8];
#pragma unroll
            for (int q = 0; q < 4; ++q) { const f32x4 t3 = *(const LAS f32x4*)(vb + 192 + 4 * q); aa[2 * q] = (f32x2){t3.x, t3.y}; aa[2 * q + 1] = (f32x2){t3.z, t3.w}; }
#pragma unroll
            for (int i = 0; i < 4; ++i) {
                f32x2 sa2 = s[i][0] * aa[0];
#pragma unroll
                for (int jp = 1; jp < 8; ++jp) sa2 = s[i][jp] * aa[jp] + sa2;
                sa[i] = sa2.x + sa2.y;
            }
        }
#pragma unroll
        for (int i = 0; i < 4; ++i) sa[i] += __builtin_bit_cast(float, __builtin_amdgcn_update_dpp(0, __builtin_bit_cast(int, sa[i]), 0xB1, 0xF, 0xF, false));
#pragma unroll
        for (int i = 0; i < 4; ++i) sa[i] += __builtin_bit_cast(float, __builtin_amdgcn_update_dpp(0, __builtin_bit_cast(int, sa[i]), 0x4E, 0xF, 0xF, false));
        f32x4 vv;
        if (!IDENT) vv = *(const LAS f32x4*)(buf + st * 384 + 320 + vg * 4);
        f32x2 y2[4];
#pragma unroll
        for (int hf = 0; hf < 2; ++hf) {
            f32x2 rr[4], ww[4], kk2[4], bb[4];
#pragma unroll
            for (int q = 0; q < 2; ++q) {
                const f32x4 t0 = *(const LAS f32x4*)(vb + 8 * hf + 4 * q), t1 = *(const LAS f32x4*)(vb + 64 + 8 * hf + 4 * q), t2 = *(const LAS f32x4*)(vb + 128 + 8 * hf + 4 * q), t4 = *(const LAS f32x4*)(vb + 256 + 8 * hf + 4 * q);
                rr[2 * q] = (f32x2){t0.x, t0.y}; rr[2 * q + 1] = (f32x2){t0.z, t0.w}; ww[2 * q] = (f32x2){t1.x, t1.y}; ww[2 * q + 1] = (f32x2){t1.z, t1.w};
                kk2[2 * q] = (f32x2){t2.x, t2.y}; kk2[2 * q + 1] = (f32x2){t2.z, t2.w}; bb[2 * q] = (f32x2){t4.x, t4.y}; bb[2 * q + 1] = (f32x2){t4.z, t4.w};
            }
#pragma unroll
            for (int i = 0; i < 4; ++i) {
                const f32x2 sav = (f32x2){sa[i], sa[i]};
#pragma unroll
                for (int jq = 0; jq < 4; ++jq) { const int jp = 4 * hf + jq;
                    f32x2 u = sav * bb[jq];
                    if (!IDENT) { const float vi = vv[i]; u = (f32x2){vi, vi} * kk2[jq] + u; }
                    s[i][jp] = s[i][jp] * ww[jq] + u;
                    y2[i] = (jp == 0) ? s[i][jp] * rr[jq] : s[i][jp] * rr[jq] + y2[i];
                }
            }
        }
#pragma unroll
        for (int i = 0; i < 4; ++i) y[i] = y2[i].x + y2[i].y;
#pragma unroll
        for (int i = 0; i < 4; ++i) y[i] += __builtin_bit_cast(float, __builtin_amdgcn_update_dpp(0, __builtin_bit_cast(int, y[i]), 0xB1, 0xF, 0xF, false));
#pragma unroll
        for (int i = 0; i < 4; ++i) y[i] += __builtin_bit_cast(float, __builtin_amdgcn_update_dpp(0, __builtin_bit_cast(int, y[i]), 0x4E, 0xF, 0xF, false));
        if (kg == 0) *(f32x4*)(yout + st * 64) = (f32x4){y[0], y[1], y[2], y[3]};
    }
}
__device__ __forceinline__ void ph_wkv_scan(Frame& F) {
    const bf16_t* PK = (const bf16_t*)(F.ws + WS_PK);
    const int lane = F.lane, wave = F.wave, pr = wave >> 1, role = (wave ^ (wave >> 2)) & 1, vg = lane >> 2, kg = lane & 3, l128 = role * 64 + lane;
    LAS float* pbuf = (LAS float*)(F.lds + pr * 24576);
    int woff[3]; bool isw[3];
#pragma unroll
    for (int j = 0; j < 3; ++j) { const int pi = l128 + 128 * j, stp = pi / 48, rem = pi % 48, vec = rem >> 3, c8 = rem & 7; woff[j] = (stp * 6 + vec) * 64 + c8 * 8; isw[j] = (vec == 1); }
    const int nround = (BATCH * NH * 16 + F.G * 4 - 1) / (F.G * 4);
    for (int rd = 0; rd < nround; ++rd) {
        const int item = (rd * F.G + F.bid) * 4 + pr;
        const bool act = item < BATCH * NH * 16;
        const int bh = item >> 4, ch = item & 15;
        const bf16_t* src = PK + ((size_t)bh * SEQ + ch * 128) * 384;
        f32x2 s[4][8];
#pragma unroll
        for (int i = 0; i < 4; ++i)
#pragma unroll
            for (int jp = 0; jp < 8; ++jp) s[i][jp] = (f32x2){(role && (4 * vg + i == 16 * kg + 2 * jp)) ? 1.f : 0.f, (role && (4 * vg + i == 16 * kg + 2 * jp + 1)) ? 1.f : 0.f};
        v4u rg[3];
#define WK_LOAD(sg) do { _Pragma("unroll") for (int j = 0; j < 3; ++j) rg[j] = *(const v4u*)(src + (size_t)(sg) * 8 * 384 + (size_t)(l128 + 128 * j) * 8); } while (0)
#define WK_WRITE(bf) do { _Pragma("unroll") for (int j = 0; j < 3; ++j) { float f[8]; f[0] = bflo(rg[j].x); f[1] = bfhi(rg[j].x); f[2] = bflo(rg[j].y); f[3] = bfhi(rg[j].y); f[4] = bflo(rg[j].z); f[5] = bfhi(rg[j].z); f[6] = bflo(rg[j].w); f[7] = bfhi(rg[j].w); \
            if (isw[j]) { _Pragma("unroll") for (int e = 0; e < 8; ++e) f[e] = __expf(f[e]); } \
            LAS float* d_ = pbuf + (bf) * 3072 + woff[j]; *(LAS f32x4*)d_ = (f32x4){f[0], f[1], f[2], f[3]}; *(LAS f32x4*)(d_ + 4) = (f32x4){f[4], f[5], f[6], f[7]}; } } while (0)
        __syncthreads();
        if (act) { WK_LOAD(0); WK_WRITE(0); WK_LOAD(1); }
        __syncthreads();
        float* yout = (float*)(F.ws + (role ? WS_QH : WS_YLOC)) + ((size_t)bh * SEQ + ch * 128) * 64 + vg * 4;
        for (int sg = 0; sg < 16; ++sg) {
            if (act) {
                if (role) wkv_steps8<true>(s, pbuf + (sg & 1) * 3072, yout + (size_t)sg * 8 * 64, vg, kg);
                else wkv_steps8<false>(s, pbuf + (sg & 1) * 3072, yout + (size_t)sg * 8 * 64, vg, kg);
                if (sg + 1 < 16) WK_WRITE((sg + 1) & 1);
                if (sg + 2 < 16) WK_LOAD(sg + 2);
            }
            __syncthreads();
        }
#undef WK_LOAD
#undef WK_WRITE
        if (act) { float* so = (float*)(F.ws + (role ? WS_PCH : WS_LCH)) + (size_t)item * 4096 + (size_t)(4 * vg) * 64 + 16 * kg;
#pragma unroll
            for (int i = 0; i < 4; ++i)
#pragma unroll
                for (int q = 0; q < 4; ++q) *(f32x4*)(so + i * 64 + 4 * q) = (f32x4){s[i][2 * q].x, s[i][2 * q].y, s[i][2 * q + 1].x, s[i][2 * q + 1].y}; }
    }
    __syncthreads();
}
namespace wk {
using pg8::bf16x8; using pg8::lds_byte;
typedef float f4 __attribute__((ext_vector_type(4)));
constexpr int AB = 8192;
constexpr int O_At = 0, O_Bt = AB, O_Kt = 2 * AB, O_Rt = 3 * AB, O_ATr = 4 * AB, O_BH = 5 * AB, O_KH = 6 * AB, O_VT = 7 * AB, O_N = 8 * AB, O_NT = 9 * AB, O_T0 = 10 * AB,
              O_Aak = 11 * AB, O_Arb = 12 * AB, O_Ark = 13 * AB, O_Z1T = 14 * AB, O_UT = 15 * AB, O_GT = 16 * AB, O_SEG = 17 * AB, O_WL = O_SEG + 4096, O_RAW = O_N;
struct Ctx { LAS unsigned char* lds; int am, fbase, d0, d1, ai, b0i; };
__device__ __forceinline__ void mm2(const Ctx& c, const int offA, const int offB, f4 (&acc)[2]) {
    const LAS unsigned char* pa = c.lds + offA + c.am * 2048 + c.fbase;
    const LAS unsigned char* pb = c.lds + offB + (c.b0i >> 4) * 2048 + c.fbase;
    const bf16x8 a0 = *(const LAS bf16x8*)pa, a1 = *(const LAS bf16x8*)(pa + 1024);
#pragma unroll
    for (int n = 0; n < 2; ++n) { const bf16x8 b0 = *(const LAS bf16x8*)(pb + n * 2048), b1 = *(const LAS bf16x8*)(pb + n * 2048 + 1024);
        acc[n] = __builtin_amdgcn_mfma_f32_16x16x32_bf16(a0, b0, acc[n], 0, 0, 0); acc[n] = __builtin_amdgcn_mfma_f32_16x16x32_bf16(a1, b1, acc[n], 0, 0, 0); }
}
__device__ __forceinline__ void zero2(f4 (&acc)[2]) { acc[0] = (f4){0.f, 0.f, 0.f, 0.f}; acc[1] = acc[0]; }
__device__ __forceinline__ void st_d(const Ctx& c, const int off, const int n, const f4 d) {
    *(LAS v2u*)(c.lds + off + (n ? c.d1 : c.d0)) = (v2u){pg8::cvt_pk_bf16(d[0], d[1]), pg8::cvt_pk_bf16(d[2], d[3])}; }
__device__ __forceinline__ f4 ld_d(const Ctx& c, const int off, const int n) {
    const v2u w = *(const LAS v2u*)(c.lds + off + (n ? c.d1 : c.d0)); return (f4){bflo(w.x), bfhi(w.x), bflo(w.y), bfhi(w.y)}; }
template <int MODE> __device__ __forceinline__ f4 tri(const Ctx& c, const int n, const f4 d) {
    const int b = c.b0i + 16 * n; f4 o;
#pragma unroll
    for (int r = 0; r < 4; ++r) { const int a = c.ai + r; const bool keep = MODE == 0 ? a < b : (MODE == 1 ? a <= b : a > b); o[r] = keep ? d[r] : 0.f; }
    return o; }
struct FA { bf16x8 v[2]; };
struct FB { bf16x8 v[2][2]; };
__device__ __forceinline__ FA lda(const Ctx& c, const int off) { const LAS unsigned char* p = c.lds + off + c.am * 2048 + c.fbase; FA f; f.v[0] = *(const LAS bf16x8*)p; f.v[1] = *(const LAS bf16x8*)(p + 1024); return f; }
__device__ __forceinline__ FB ldb(const Ctx& c, const int off) { const LAS unsigned char* p = c.lds + off + (c.b0i >> 4) * 2048 + c.fbase; FB f;
#pragma unroll
    for (int n = 0; n < 2; ++n) { f.v[n][0] = *(const LAS bf16x8*)(p + n * 2048); f.v[n][1] = *(const LAS bf16x8*)(p + n * 2048 + 1024); }
    return f; }
__device__ __forceinline__ void mmf(f4 (&acc)[2], const FA& a, const FB& b) {
#pragma unroll
    for (int n = 0; n < 2; ++n) acc[n] = __builtin_amdgcn_mfma_f32_16x16x32_bf16(a.v[0], b.v[n][0], acc[n], 0, 0, 0);
#pragma unroll
    for (int n = 0; n < 2; ++n) acc[n] = __builtin_amdgcn_mfma_f32_16x16x32_bf16(a.v[1], b.v[n][1], acc[n], 0, 0, 0); }
__device__ __forceinline__ void st2(const Ctx& c, const int off, const f4 (&d)[2]) { st_d(c, off, 0, d[0]); st_d(c, off, 1, d[1]); }
template <int MODE> __device__ __forceinline__ void st2tri(const Ctx& c, const int off, const f4 (&d)[2]) { st_d(c, off, 0, tri<MODE>(c, 0, d[0])); st_d(c, off, 1, tri<MODE>(c, 1, d[1])); }
__device__ __forceinline__ void chain_stage(const Ctx& c, const int Pin, const int PTin, const int Pout, const int PTout, const int Tin, const int Tout) {
    const FA aPT = lda(c, PTin), aP = lda(c, Pin); const FB bT = ldb(c, Tin), bP = ldb(c, Pin), bPT = ldb(c, PTin);
    f4 t[2], p[2], pt[2]; t[0] = ld_d(c, Tin, 0); t[1] = ld_d(c, Tin, 1); zero2(p); zero2(pt);
    __builtin_amdgcn_sched_barrier(0);
    mmf(t, aPT, bT); mmf(p, aPT, bP); mmf(pt, aP, bPT);
    st2(c, Tout, t); st2(c, Pout, p); st2(c, PTout, pt); }
}
__device__ __forceinline__ void ph_wkv_chunk(Frame& F) {
    using namespace wk;
    const bf16_t* PK = (const bf16_t*)(F.ws + WS_PK);
    bf16_t* YLOC = (bf16_t*)(F.ws + WS_YLOC); bf16_t* QH = (bf16_t*)(F.ws + WS_QH); bf16_t* PCH = (bf16_t*)(F.ws + WS_PCH); bf16_t* LCH = (bf16_t*)(F.ws + WS_LCH);
    LAS unsigned char* lds = F.lds;
    const int tid = F.tid, lane = F.lane, wave = F.wave, fr = lane & 15, fq = lane >> 4;
    Ctx c; c.lds = lds; c.am = wave >> 1; c.fbase = lds_byte(fr, 8 * fq); c.ai = 16 * (wave >> 1) + 4 * fq; c.b0i = 32 * (wave & 1) + fr;
    c.d0 = lds_byte(c.b0i, c.ai); c.d1 = lds_byte(c.b0i + 16, c.ai);
    constexpr int NIT = BATCH * NH * NCH;
    const LAS unsigned* raw32 = (const LAS unsigned*)(lds + O_RAW);
    LAS f32x2* segs2 = (LAS f32x2*)(lds + O_SEG);
    LAS float* wl = (LAS float*)(lds + O_WL);
    const int jp = tid & 31, sg = tid >> 5;
    v4u rg[6];
#define WC_LOAD(it_) do { const v4u* src_ = (const v4u*)(PK + (size_t)(it_) * 64 * 384); _Pragma("unroll") for (int q = 0; q < 6; ++q) rg[q] = src_[tid + NT * q]; } while (0)
    { const int i0 = F.bid < NIT ? F.bid : NIT - 1; WC_LOAD(i0); }
    __syncthreads();
#pragma unroll
    for (int q = 0; q < 6; ++q) *(LAS v4u*)(lds + O_RAW + (tid + NT * q) * 16) = rg[q];
    __syncthreads();
    for (int it = F.bid; it < NIT; it += F.G) {
        { const int nx = it + F.G < NIT ? it + F.G : it; WC_LOAD(nx); }
        f32x2 cs[4];
        { f32x2 run = (f32x2){0.f, 0.f};
#pragma unroll
          for (int i = 0; i < 4; ++i) { const unsigned w = raw32[(4 * sg + i) * 192 + 32 + jp]; run += (f32x2){bflo(w), bfhi(w)}; cs[i] = run; }
          segs2[sg * 32 + jp] = run; }
        __syncthreads();
        { unsigned rw[4], kw[4], aw[4], bw[4], vw[4];
#pragma unroll
          for (int i = 0; i < 4; ++i) { const LAS unsigned* rp = raw32 + (4 * sg + i) * 192 + jp; rw[i] = rp[0]; kw[i] = rp[64]; aw[i] = rp[96]; bw[i] = rp[128]; vw[i] = rp[160]; }
          f32x2 off = (f32x2){0.f, 0.f}, cl = off;
#pragma unroll
          for (int sgi = 0; sgi < 16; ++sgi) { const f32x2 v = segs2[sgi * 32 + jp]; cl += v; if (sgi < sg) off += v; }
          const f32x2 ecl = (f32x2){__expf(cl.x), __expf(cl.y)};
          if (sg == 0) *(LAS f32x2*)(wl + 2 * jp) = ecl;
          f32x2 ep = (f32x2){__expf(off.x), __expf(off.y)};
          f32x2 atv[4], bhv[4], khv[4];
          const int o0 = lds_byte(4 * sg, 2 * jp);
#pragma unroll
          for (int i = 0; i < 4; ++i) {
              const f32x2 cum = off + cs[i];
              const f32x2 eo = (f32x2){__expf(cum.x), __expf(cum.y)}, en = (f32x2){__builtin_amdgcn_rcpf(eo.x), __builtin_amdgcn_rcpf(eo.y)}, eh = ecl * en;
              const f32x2 r2 = (f32x2){bflo(rw[i]), bfhi(rw[i])}, k2 = (f32x2){bflo(kw[i]), bfhi(kw[i])}, a2 = (f32x2){bflo(aw[i]), bfhi(aw[i])}, b2 = (f32x2){bflo(bw[i]), bfhi(bw[i])};
              atv[i] = a2 * ep; bhv[i] = b2 * eh; khv[i] = k2 * eh; ep = eo;
              const f32x2 bt = b2 * en, kt = k2 * en, rt = r2 * eo;
              *(LAS unsigned*)(lds + O_At + o0 + 64 * i) = pg8::cvt_pk_bf16(atv[i].x, atv[i].y); *(LAS unsigned*)(lds + O_Bt + o0 + 64 * i) = pg8::cvt_pk_bf16(bt.x, bt.y);
              *(LAS unsigned*)(lds + O_Kt + o0 + 64 * i) = pg8::cvt_pk_bf16(kt.x, kt.y); *(LAS unsigned*)(lds + O_Rt + o0 + 64 * i) = pg8::cvt_pk_bf16(rt.x, rt.y); }
          const int ot = lds_byte(2 * jp, 4 * sg);
          *(LAS v2u*)(lds + O_ATr + ot) = (v2u){pg8::cvt_pk_bf16(atv[0].x, atv[1].x), pg8::cvt_pk_bf16(atv[2].x, atv[3].x)}; *(LAS v2u*)(lds + O_ATr + ot + 64) = (v2u){pg8::cvt_pk_bf16(atv[0].y, atv[1].y), pg8::cvt_pk_bf16(atv[2].y, atv[3].y)};
          *(LAS v2u*)(lds + O_BH + ot) = (v2u){pg8::cvt_pk_bf16(bhv[0].x, bhv[1].x), pg8::cvt_pk_bf16(bhv[2].x, bhv[3].x)}; *(LAS v2u*)(lds + O_BH + ot + 64) = (v2u){pg8::cvt_pk_bf16(bhv[0].y, bhv[1].y), pg8::cvt_pk_bf16(bhv[2].y, bhv[3].y)};
          *(LAS v2u*)(lds + O_KH + ot) = (v2u){pg8::cvt_pk_bf16(khv[0].x, khv[1].x), pg8::cvt_pk_bf16(khv[2].x, khv[3].x)}; *(LAS v2u*)(lds + O_KH + ot + 64) = (v2u){pg8::cvt_pk_bf16(khv[0].y, khv[1].y), pg8::cvt_pk_bf16(khv[2].y, khv[3].y)};
          *(LAS v2u*)(lds + O_VT + ot) = (v2u){(vw[0] & 0xffffu) | (vw[1] << 16), (vw[2] & 0xffffu) | (vw[3] << 16)}; *(LAS v2u*)(lds + O_VT + ot + 64) = (v2u){(vw[0] >> 16) | (vw[1] & 0xffff0000u), (vw[2] >> 16) | (vw[3] & 0xffff0000u)}; }
        __syncthreads();
        { const FA aB = lda(c, O_Bt), aA = lda(c, O_At), aK = lda(c, O_Kt); const FB bA = ldb(c, O_At), bB = ldb(c, O_Bt), bR = ldb(c, O_Rt);
          __builtin_amdgcn_sched_barrier(0);
          f4 nn[2], nt[2], ak[2], rb[2], rk[2]; zero2(nn); zero2(nt); zero2(ak); zero2(rb); zero2(rk);
          mmf(nn, aB, bA); mmf(nt, aA, bB); mmf(ak, aK, bA); mmf(rb, aB, bR); mmf(rk, aK, bR);
#pragma unroll
          for (int n = 0; n < 2; ++n) { const f4 m = tri<0>(c, n, nn[n]); st_d(c, O_N, n, m);
              const int b = c.b0i + 16 * n; f4 t1;
#pragma unroll
              for (int r = 0; r < 4; ++r) t1[r] = (c.ai + r == b) ? 1.f : m[r];
              st_d(c, O_T0, n, t1); }
          st2tri<2>(c, O_NT, nt); st2tri<0>(c, O_Aak, ak); st2tri<1>(c, O_Arb, rb); st2tri<1>(c, O_Ark, rk); }
        __syncthreads();
        { const FA aNT = lda(c, O_NT), aN = lda(c, O_N), aAk = lda(c, O_Aak); const FB bN = ldb(c, O_N), bNT = ldb(c, O_NT), bV = ldb(c, O_VT);
          __builtin_amdgcn_sched_barrier(0);
          f4 p[2], pt[2], z[2]; zero2(p); zero2(pt); zero2(z);
          mmf(p, aNT, bN); mmf(pt, aN, bNT); mmf(z, aAk, bV);
          st2(c, O_At, p); st2(c, O_Bt, pt); st2(c, O_Z1T, z); }
        __syncthreads();
        chain_stage(c, O_At, O_Bt, O_N, O_NT, O_T0, O_Kt);
        __syncthreads();
        chain_stage(c, O_N, O_NT, O_At, O_Bt, O_Kt, O_T0);
        __syncthreads();
        chain_stage(c, O_At, O_Bt, O_N, O_NT, O_T0, O_Kt);
        __syncthreads();
        { const FA aPT = lda(c, O_NT), aP = lda(c, O_N); const FB bT = ldb(c, O_Kt), bPT = ldb(c, O_NT);
          f4 t[2], pt[2]; t[0] = ld_d(c, O_Kt, 0); t[1] = ld_d(c, O_Kt, 1); zero2(pt);
          __builtin_amdgcn_sched_barrier(0);
          mmf(t, aPT, bT); mmf(pt, aP, bPT);
          st2(c, O_T0, t); st2(c, O_Bt, pt); }
        __syncthreads();
        { const FA aPT = lda(c, O_Bt); const FB bT = ldb(c, O_T0); f4 t[2]; t[0] = ld_d(c, O_T0, 0); t[1] = ld_d(c, O_T0, 1);
          mmf(t, aPT, bT); st2(c, O_Kt, t); }
        __syncthreads();
        { const FA aT = lda(c, O_Kt); const FB bZ = ldb(c, O_Z1T), bAT = ldb(c, O_ATr);
          f4 u[2], g[2]; zero2(u); zero2(g);
          mmf(u, aT, bZ); mmf(g, aT, bAT);
          st2(c, O_UT, u); st2(c, O_GT, g); }
        __syncthreads();
        { const int bh = it >> 5, ch = it & 31;
          const size_t row0 = (size_t)bh * SEQ + ch * 64;
          const FA aG = lda(c, O_GT), aU = lda(c, O_UT), aV = lda(c, O_VT), aBH = lda(c, O_BH), aKH = lda(c, O_KH);
          const FB bRb = ldb(c, O_Arb), bRk = ldb(c, O_Ark), bBH = ldb(c, O_BH), bU = ldb(c, O_UT), bV = ldb(c, O_VT);
          f4 q[2], y[2], pm[2], lc[2]; q[0] = ld_d(c, O_Rt, 0); q[1] = ld_d(c, O_Rt, 1); zero2(y); zero2(pm); zero2(lc);
          const float w0 = wl[c.b0i], w1 = wl[c.b0i + 16];
          __builtin_amdgcn_sched_barrier(0);
          mmf(q, aG, bRb);
          mmf(y, aU, bRb); mmf(y, aV, bRk);
          mmf(pm, aG, bBH);
          mmf(lc, aBH, bU); mmf(lc, aKH, bV);
#pragma unroll
          for (int n = 0; n < 2; ++n) { const int b = c.b0i + 16 * n;
              *(v2u*)(QH + (row0 + b) * 64 + c.ai) = (v2u){pg8::cvt_pk_bf16(q[n][0], q[n][1]), pg8::cvt_pk_bf16(q[n][2], q[n][3])};
              *(v2u*)(YLOC + (row0 + b) * 64 + c.ai) = (v2u){pg8::cvt_pk_bf16(y[n][0], y[n][1]), pg8::cvt_pk_bf16(y[n][2], y[n][3])};
              f4 o = pm[n]; const float wd = n ? w1 : w0;
#pragma unroll
              for (int r = 0; r < 4; ++r) o[r] += (c.ai + r == b) ? wd : 0.f;
              *(v2u*)(PCH + (size_t)it * 4096 + b * 64 + c.ai) = (v2u){pg8::cvt_pk_bf16(o[0], o[1]), pg8::cvt_pk_bf16(o[2], o[3])};
              *(v2u*)(LCH + (size_t)it * 4096 + b * 64 + c.ai) = (v2u){pg8::cvt_pk_bf16(lc[n][0], lc[n][1]), pg8::cvt_pk_bf16(lc[n][2], lc[n][3])}; } }
        __syncthreads();
#pragma unroll
        for (int q = 0; q < 6; ++q) *(LAS v4u*)(lds + O_RAW + (tid + NT * q) * 16) = rg[q];
        __syncthreads();
    }
#undef WC_LOAD
    __syncthreads();
}
__device__ __forceinline__ void wkv_carry_bh(Frame& F, const int bh) {
    using namespace wk;
    const bf16_t* PT = (const bf16_t*)(F.ws + WS_PCH) + (size_t)bh * NCH * 4096;
    const bf16_t* LC = (const bf16_t*)(F.ws + WS_LCH) + (size_t)bh * NCH * 4096;
    bf16_t* SST = (bf16_t*)(F.ws + WS_SST) + (size_t)bh * NCH * 4096;
    const int lane = F.lane, wave = F.wave, fr = lane & 15, fq = lane >> 4;
    Ctx c; c.lds = F.lds; c.am = wave >> 1; c.fbase = lds_byte(fr, 8 * fq); c.ai = 16 * (wave >> 1) + 4 * fq; c.b0i = 32 * (wave & 1) + fr;
    c.d0 = lds_byte(c.b0i, c.ai); c.d1 = lds_byte(c.b0i + 16, c.ai);
    __syncthreads();
    { const f4 z = (f4){0.f, 0.f, 0.f, 0.f};
#pragma unroll
      for (int n = 0; n < 2; ++n) { st_d(c, 0, n, z); st_d(c, AB, n, z); *(v2u*)(SST + (c.b0i + 16 * n) * 64 + c.ai) = (v2u){0u, 0u}; } }
    const int pofs = (16 * c.am + fr) * 64 + 8 * fq;
    bf16x8 pa0 = *(const bf16x8*)(PT + pofs), pa1 = *(const bf16x8*)(PT + pofs + 32);
    v2u lv0 = *(const v2u*)(LC + c.b0i * 64 + c.ai), lv1 = *(const v2u*)(LC + (c.b0i + 16) * 64 + c.ai);
    __syncthreads();
    for (int ch = 0; ch < NCH - 1; ++ch) {
        const int cur = (ch & 1) * 2 * AB, nxt = 2 * AB - cur;
        const FB sh = ldb(c, cur), sl = ldb(c, cur + AB);
        FA a; a.v[0] = pa0; a.v[1] = pa1;
        f4 acc[2]; acc[0] = (f4){bflo(lv0.x), bfhi(lv0.x), bflo(lv0.y), bfhi(lv0.y)}; acc[1] = (f4){bflo(lv1.x), bfhi(lv1.x), bflo(lv1.y), bfhi(lv1.y)};
        { const int cn = ch + 1 < NCH - 1 ? ch + 1 : NCH - 2;
          const bf16_t* pn = PT + (size_t)cn * 4096; const bf16_t* ln = LC + (size_t)cn * 4096;
          pa0 = *(const bf16x8*)(pn + pofs); pa1 = *(const bf16x8*)(pn + pofs + 32);
          lv0 = *(const v2u*)(ln + c.b0i * 64 + c.ai); lv1 = *(const v2u*)(ln + (c.b0i + 16) * 64 + c.ai); }
        mmf(acc, a, sh); mmf(acc, a, sl);
        bf16_t* so = SST + (size_t)(ch + 1) * 4096;
#pragma unroll
        for (int n = 0; n < 2; ++n) { const f4 d = acc[n];
            const v2u hi = (v2u){pg8::cvt_pk_bf16(d[0], d[1]), pg8::cvt_pk_bf16(d[2], d[3])};
            const f4 lo = (f4){d[0] - bflo(hi.x), d[1] - bfhi(hi.x), d[2] - bflo(hi.y), d[3] - bfhi(hi.y)};
            *(LAS v2u*)(c.lds + nxt + (n ? c.d1 : c.d0)) = hi; st_d(c, nxt + AB, n, lo);
            *(v2u*)(so + (c.b0i + 16 * n) * 64 + c.ai) = hi; }
        __syncthreads();
    }
    __syncthreads();
}
struct PostIn { pg8::bf16x8 qf[2], sf[4][2]; v2u yw[4], rr[4], kk[4], vv[4], gg[4]; };
__device__ __forceinline__ void ph_wkv_post(Frame& F) {
    using pg8::bf16x8;
    typedef float f4 __attribute__((ext_vector_type(4)));
    const bf16_t* PK = (const bf16_t*)(F.ws + WS_PK);
    const bf16_t* GB = (const bf16_t*)(F.ws + WS_G);
    const bf16_t* YLOC = (const bf16_t*)(F.ws + WS_YLOC);
    const bf16_t* QH = (const bf16_t*)(F.ws + WS_QH);
    const bf16_t* SST = (const bf16_t*)(F.ws + WS_SST);
    bf16_t* YC = (bf16_t*)(F.ws + WS_YCAT);
    const int lane = F.lane, wave = F.wave, fr = lane & 15, fq = lane >> 4;
    constexpr int NI = BATCH * NH * 16;
#define POST_LOAD(R, item_) do { const int it_ = (item_); const int bh_ = it_ >> 4, ch_ = it_ & 15, b_ = bh_ / NH, h_ = bh_ % NH; const int tl_ = ch_ * 128 + 16 * wave + fr; \
        const size_t ro_ = (size_t)bh_ * SEQ + tl_, tg_ = (size_t)b_ * SEQ + tl_; const bf16_t* pk_ = PK + ro_ * 384 + 4 * fq; \
        _Pragma("unroll") for (int ks = 0; ks < 2; ++ks) R.qf[ks] = *(const bf16x8*)(QH + ro_ * 64 + 32 * ks + 8 * fq); \
        _Pragma("unroll") for (int m = 0; m < 4; ++m) { \
            _Pragma("unroll") for (int ks = 0; ks < 2; ++ks) R.sf[m][ks] = *(const bf16x8*)(SST + ((size_t)it_ * 2 + (wave >> 2)) * 4096 + (16 * m + fr) * 64 + 32 * ks + 8 * fq); \
            R.yw[m] = *(const v2u*)(YLOC + ro_ * 64 + 16 * m + 4 * fq); R.rr[m] = *(const v2u*)(pk_ + 16 * m); R.kk[m] = *(const v2u*)(pk_ + 128 + 16 * m); R.vv[m] = *(const v2u*)(pk_ + 320 + 16 * m); \
            R.gg[m] = *(const v2u*)(GB + tg_ * C + h_ * HD + 16 * m + 4 * fq); } } while (0)
    PostIn cur;
    { const int i0 = F.bid < NI ? F.bid : NI - 1; POST_LOAD(cur, i0); }
    for (int item = F.bid; item < NI; item += F.G) {
        const int bh = item >> 4, ch = item & 15, b = bh / NH, h = bh % NH;
        const int tl = ch * 128 + 16 * wave + fr;
        const size_t tg = (size_t)b * SEQ + tl;
        PostIn nx;
        { const int nxi = item + F.G < NI ? item + F.G : item; POST_LOAD(nx, nxi); }
        f4 yv[4], lg[4], lb[4], rkv[4];
#pragma unroll
        for (int m = 0; m < 4; ++m) { const int c0 = h * HD + 16 * m + 4 * fq;
            yv[m] = (f4){bflo(cur.yw[m].x), bfhi(cur.yw[m].x), bflo(cur.yw[m].y), bfhi(cur.yw[m].y)};
            lg[m] = *(const f4*)(F.a->in[I_LNXG] + c0); lb[m] = *(const f4*)(F.a->in[I_LNXB] + c0); rkv[m] = *(const f4*)(F.a->in[I_RK] + c0); }
#pragma unroll
        for (int m = 0; m < 4; ++m) { f4 acc = (f4){0.f, 0.f, 0.f, 0.f};
#pragma unroll
            for (int ks = 0; ks < 2; ++ks) acc = __builtin_amdgcn_mfma_f32_16x16x32_bf16(cur.sf[m][ks], cur.qf[ks], acc, 0, 0, 0);
            yv[m] += acc; }
        float sm = 0.f;
#pragma unroll
        for (int m = 0; m < 4; ++m) sm += (yv[m].x + yv[m].y) + (yv[m].z + yv[m].w);
        sm += __shfl_xor(sm, 16); sm += __shfl_xor(sm, 32);
        const float mu = sm * (1.f / HD);
        float s2 = 0.f, bn = 0.f;
#pragma unroll
        for (int m = 0; m < 4; ++m) { yv[m] = yv[m] - mu; s2 += (yv[m].x * yv[m].x + yv[m].y * yv[m].y) + (yv[m].z * yv[m].z + yv[m].w * yv[m].w);
            bn += bflo(cur.rr[m].x) * bflo(cur.kk[m].x) * rkv[m].x + bfhi(cur.rr[m].x) * bfhi(cur.kk[m].x) * rkv[m].y + bflo(cur.rr[m].y) * bflo(cur.kk[m].y) * rkv[m].z + bfhi(cur.rr[m].y) * bfhi(cur.kk[m].y) * rkv[m].w; }
        s2 += __shfl_xor(s2, 16); s2 += __shfl_xor(s2, 32);
        bn += __shfl_xor(bn, 16); bn += __shfl_xor(bn, 32);
        const float rstd = 1.f / sqrtf(s2 * (1.f / HD) + GN_EPS);
#pragma unroll
        for (int m = 0; m < 4; ++m) { const int c0 = h * HD + 16 * m + 4 * fq;
            const float o0 = (yv[m].x * rstd * lg[m].x + lb[m].x + bn * bflo(cur.vv[m].x)) * bflo(cur.gg[m].x), o1 = (yv[m].y * rstd * lg[m].y + lb[m].y + bn * bfhi(cur.vv[m].x)) * bfhi(cur.gg[m].x);
            const float o2 = (yv[m].z * rstd * lg[m].z + lb[m].z + bn * bflo(cur.vv[m].y)) * bflo(cur.gg[m].y), o3 = (yv[m].w * rstd * lg[m].w + lb[m].w + bn * bfhi(cur.vv[m].y)) * bfhi(cur.gg[m].y);
            *(v2u*)(YC + tg * D + c0) = (v2u){pg8::cvt_pk_bf16(o0, o1), pg8::cvt_pk_bf16(o2, o3)}; }
        cur = nx;
    }
#undef POST_LOAD
    __syncthreads();
}
__device__ __forceinline__ void ph_sb_attn_naive(Frame& F) {
    const bf16_t* P = (const bf16_t*)(F.ws + WS_PROJ);
    bf16_t* YC = (bf16_t*)(F.ws + WS_YCAT);
    LAS float* qs = (LAS float*)F.lds + F.wave * 256;
    LAS float* as = qs + 128;
    const int gw = F.bid * NWAVES + F.wave, NGW = F.G * NWAVES, lane = F.lane;
    const float scale = 0.08838834764831845f;
    for (int it = gw; it < T * SBH; it += NGW) {
        const int t = it >> 2, hh = it & 3, b = t / SEQ, tl = t % SEQ;
        const bf16_t* qp = P + (size_t)t * PLD + COL_SBQ + hh * SBD;
        wave_lds_sync();
        qs[lane] = bf2f(qp[lane]); qs[64 + lane] = bf2f(qp[64 + lane]);
        wave_lds_sync();
        float o0 = 0.f, o1 = 0.f, carry = 0.f;
        const int nkb = (tl + 63) >> 6;
        for (int kb = nkb - 1; kb >= 0; --kb) {
            const int s = kb * 64 + lane; const bool valid = s < tl;
            float z = 0.f;
            if (valid) {
                const bf16_t* kp = P + (size_t)(b * SEQ + s) * PLD + COL_SBK + hh * SBD;
#pragma unroll 4
                for (int d = 0; d < SBD; d += 8) { const v4u kv = *(const v4u*)(kp + d); const f32x4 q0 = *(const LAS f32x4*)(qs + d), q1 = *(const LAS f32x4*)(qs + d + 4);
                    z += q0.x * bflo(kv.x) + q0.y * bfhi(kv.x) + q0.z * bflo(kv.y) + q0.w * bfhi(kv.y) + q1.x * bflo(kv.z) + q1.y * bfhi(kv.z) + q1.z * bflo(kv.w) + q1.w * bfhi(kv.w); }
            }
            z *= scale;
            const float sp = softplusf(z);
            const float lk = valid ? -sp : 0.f;
            float x = lk;
#pragma unroll
            for (int o = 1; o < 64; o <<= 1) { const float y = __shfl_down(x, o); if (lane + o < 64) x += y; }
            const float excl = x - lk;
            const float attn = valid ? expf(z - sp + carry + excl) : 0.f;
            carry += __shfl(x, 0);
            wave_lds_sync();
            as[lane] = attn;
            wave_lds_sync();
            const bf16_t* vp = P + (size_t)(b * SEQ + kb * 64) * PLD + COL_SBV + hh * SBD + 2 * lane;
            const int nv = min(64, tl - kb * 64);
            for (int j = 0; j < nv; ++j) { const float a = as[j]; const unsigned vv = *(const unsigned*)(vp + (size_t)j * PLD); o0 += a * bflo(vv); o1 += a * bfhi(vv); }
        }
        *(unsigned*)(YC + (size_t)t * D + C + hh * SBD + 2 * lane) = pk2(o0, o1);
    }
}
__device__ __forceinline__ void vt_tile(const bf16_t* src, int ld, bf16_t* dst, int dld, LAS bf16_t* tl, int lane) {
    constexpr int RS = 136;
#pragma unroll 4
    for (int i = 0; i < 16; ++i) { const int row = i * 4 + (lane >> 4), ch = lane & 15;
        *(LAS v4u*)(tl + row * RS + ch * 8) = *(const v4u*)(src + (size_t)row * ld + ch * 8); }
    wave_lds_sync();
#pragma unroll 4
    for (int it = 0; it < 16; ++it) { const int o = it * 64 + lane, d = o >> 3, ch = o & 7, sgrp = ch >> 2, fqq = ch & 3;
        const LAS bf16_t* c0 = tl + (32 * sgrp + 4 * fqq) * RS + d;
        v4u w;
        w.x = (unsigned)c0[0 * RS] | ((unsigned)c0[1 * RS] << 16); w.y = (unsigned)c0[2 * RS] | ((unsigned)c0[3 * RS] << 16);
        w.z = (unsigned)c0[16 * RS] | ((unsigned)c0[17 * RS] << 16); w.w = (unsigned)c0[18 * RS] | ((unsigned)c0[19 * RS] << 16);
        *(v4u*)(dst + (size_t)d * dld + 8 * ch) = w; }
    wave_lds_sync();
}
__device__ __forceinline__ void ph_vt(Frame& F) {
    const bf16_t* P = (const bf16_t*)(F.ws + WS_PROJ);
    const bf16_t* MKV = (const bf16_t*)(F.ws + WS_MEMKV);
    bf16_t* VTSB = (bf16_t*)(F.ws + WS_VTSB);
    bf16_t* VTMEM = (bf16_t*)(F.ws + WS_VTMEM);
    LAS bf16_t* tl = (LAS bf16_t*)(F.lds + F.wave * 17408);
    const int gw = F.bid * NWAVES + F.wave, NGW = F.G * NWAVES;
    constexpr int N_SB = BATCH * SBH * (SEQ / 64), N_MEM = BATCH * MEMH * (MEML / 64);
    for (int it = gw; it < N_SB + N_MEM; it += NGW) {
        if (it < N_SB) { const int kt = it % (SEQ / 64), bh = it / (SEQ / 64), b = bh / SBH, h = bh % SBH;
            vt_tile(P + (size_t)(b * SEQ + kt * 64) * PLD + COL_SBV + h * SBD, PLD, VTSB + (size_t)bh * SBD * SEQ + kt * 64, SEQ, tl, F.lane); }
        else { const int j = it - N_SB, kt = j % (MEML / 64), bh = j / (MEML / 64), b = bh / MEMH, h = bh % MEMH;
            vt_tile(MKV + (size_t)(b * MEML + kt * 64) * (2 * MEMW) + MEMW + h * MEMD, 2 * MEMW, VTMEM + (size_t)bh * MEMD * MEML + kt * 64, MEML, tl, F.lane); }
    }
    __syncthreads();
}
__device__ __forceinline__ void sb_item(Frame& F, const int b, const int h, const int jq, bf16_t* OUT, const int old_, const int ocol) {
    using pg8::bf16x8; using pg8::lds_byte;
    typedef float f4 __attribute__((ext_vector_type(4)));
    const bf16_t* P = (const bf16_t*)(F.ws + WS_PROJ);
    const bf16_t* VT = (const bf16_t*)(F.ws + WS_VTSB) + (size_t)(b * SBH + h) * SBD * SEQ;
    LAS unsigned char* lds = F.lds;
    const int tid = F.tid, lane = F.lane, wave = F.wave, hf = wave >> 2, qg = wave & 3, fr = lane & 15, fq = lane >> 4, ht = tid & 255;
    const int nt = jq + 1, nh = (nt + 1) >> 1, nl = nt - nh;
    const int my_n = hf ? nl : nh, kt0 = hf ? (jq - nh) : jq;
    const float scale = 0.08838834764831845f * 1.4426950408889634f;
    const bf16_t* kbase = P + (size_t)(b * SEQ) * PLD + COL_SBK + h * SBD;
    int kwoff[4], vwoff[4]; size_t ksrc[4], vsrc[4];
#pragma unroll
    for (int i = 0; i < 4; ++i) { const int pp = ht + 256 * i, r = pp >> 4, c = pp & 15;
        kwoff[i] = (c >> 3) * 8192 + lds_byte(r, (c & 7) * 8); ksrc[i] = (size_t)r * PLD + 8 * c;
        const int d = pp >> 3, c2 = pp & 7;
        vwoff[i] = lds_byte(d, 8 * c2); vsrc[i] = (size_t)d * SEQ + 8 * c2; }
    const int fbase = lds_byte(fr, 8 * fq);
    bf16x8 qf[4];
    { const bf16_t* qp = P + (size_t)(b * SEQ + 64 * jq + 16 * qg + fr) * PLD + COL_SBQ + h * SBD + 8 * fq;
#pragma unroll
      for (int kk = 0; kk < 4; ++kk) qf[kk] = *(const bf16x8*)(qp + 32 * kk); }
    f4 acc_o[8];
#pragma unroll
    for (int i = 0; i < 8; ++i) acc_o[i] = (f4){0.f, 0.f, 0.f, 0.f};
    float carry = 0.f;
    v4u rk[4], rv[4];
#define SB_LOAD(stp) do { const int _kt = kt0 - (stp); _Pragma("unroll") for (int i = 0; i < 4; ++i) { rk[i] = *(const v4u*)(kbase + (size_t)_kt * 64 * PLD + ksrc[i]); rv[i] = *(const v4u*)(VT + (size_t)_kt * 64 + vsrc[i]); } } while (0)
#define SB_WRITE(stg) do { LAS unsigned char* _b = lds + ((stg) * 2 + hf) * 32768; _Pragma("unroll") for (int i = 0; i < 4; ++i) { *(LAS v4u*)(_b + kwoff[i]) = rk[i]; *(LAS v4u*)(_b + 16384 + vwoff[i]) = rv[i]; } } while (0)
    if (0 < my_n) { SB_LOAD(0); SB_WRITE(0); }
    if (1 < my_n) SB_LOAD(1);
    __syncthreads();
    for (int st = 0; st < nh; ++st) {
        if (st < my_n) {
            const LAS unsigned char* kb = lds + ((st & 1) * 2 + hf) * 32768;
            const LAS unsigned char* vb = kb + 16384;
            f4 sc[4];
#pragma unroll
            for (int i = 0; i < 4; ++i) { sc[i] = (f4){0.f, 0.f, 0.f, 0.f};
#pragma unroll
                for (int kk = 0; kk < 4; ++kk) { const bf16x8 kf = *(const LAS bf16x8*)(kb + fbase + i * 2048 + (kk & 1) * 1024 + (kk >> 1) * 8192);
                    sc[i] = __builtin_amdgcn_mfma_f32_16x16x32_bf16(kf, qf[kk], sc[i], 0, 0, 0); } }
            const bool diag = (hf == 0) && (st == 0);
            float av[4][4], tt[4], xx[4];
#pragma unroll
            for (int i = 0; i < 4; ++i) {
                float lk[4];
#pragma unroll
                for (int r = 0; r < 4; ++r) { float z = sc[i][r] * scale; const float e = __builtin_amdgcn_exp2f(-fabsf(z)); float l = -(fmaxf(z, 0.f) + __builtin_amdgcn_logf(1.f + e));
                    if (diag && !((16 * i + 4 * fq + r) < (16 * qg + fr))) { l = 0.f; z = -1.0e30f; }
                    lk[r] = l; sc[i][r] = z; }
                av[i][3] = lk[3]; av[i][2] = lk[2] + av[i][3]; av[i][1] = lk[1] + av[i][2]; av[i][0] = lk[0] + av[i][1];
                const float tot = av[i][0], u = __shfl_xor(tot, 16), t1 = tot + u, v = __shfl_xor(t1, 32);
                tt[i] = t1 + v; xx[i] = ((fq & 1) ? 0.f : u) + ((fq & 2) ? 0.f : v);
            }
            const float y2 = tt[3], y1 = y2 + tt[2], y0 = y1 + tt[1], total = y0 + tt[0];
            xx[0] += y0 + carry; xx[1] += y1 + carry; xx[2] += y2 + carry; xx[3] += carry;
            carry += total;
            bf16x8 pf[2];
#pragma unroll
            for (int sg2 = 0; sg2 < 2; ++sg2) {
                float pv[8];
#pragma unroll
                for (int a = 0; a < 2; ++a)
#pragma unroll
                    for (int r = 0; r < 4; ++r) pv[4 * a + r] = __builtin_amdgcn_exp2f(sc[2 * sg2 + a][r] + av[2 * sg2 + a][r] + xx[2 * sg2 + a]);
                v4u w; w.x = pg8::cvt_pk_bf16(pv[0], pv[1]); w.y = pg8::cvt_pk_bf16(pv[2], pv[3]); w.z = pg8::cvt_pk_bf16(pv[4], pv[5]); w.w = pg8::cvt_pk_bf16(pv[6], pv[7]);
                pf[sg2] = __builtin_bit_cast(bf16x8, w);
            }
#pragma unroll
            for (int ds = 0; ds < 8; ++ds)
#pragma unroll
                for (int sg2 = 0; sg2 < 2; ++sg2) { const bf16x8 vf = *(const LAS bf16x8*)(vb + fbase + ds * 2048 + sg2 * 1024);
                    acc_o[ds] = __builtin_amdgcn_mfma_f32_16x16x32_bf16(vf, pf[sg2], acc_o[ds], 0, 0, 0); }
        }
        if (st + 1 < my_n) SB_WRITE((st + 1) & 1);
        if (st + 2 < my_n) SB_LOAD(st + 2);
        __syncthreads();
    }
#undef SB_LOAD
#undef SB_WRITE
    LAS float* xb = (LAS float*)lds + qg * 2048;
    if (hf) {
#pragma unroll
        for (int ds = 0; ds < 8; ++ds)
#pragma unroll
            for (int r = 0; r < 4; ++r) xb[(ds * 4 + r) * 64 + lane] = acc_o[ds][r];
    }
    __syncthreads();
    if (!hf) {
        const float ec = __builtin_amdgcn_exp2f(carry);
        bf16_t* op = OUT + (size_t)(b * SEQ + 64 * jq + 16 * qg + fr) * old_ + ocol + h * SBD + 4 * fq;
#pragma unroll
        for (int ds = 0; ds < 8; ++ds) { float o[4];
#pragma unroll
            for (int r = 0; r < 4; ++r) o[r] = acc_o[ds][r] + ec * xb[(ds * 4 + r) * 64 + lane];
            *(v2u*)(op + 16 * ds) = (v2u){pg8::cvt_pk_bf16(o[0], o[1]), pg8::cvt_pk_bf16(o[2], o[3])}; }
    }
    __syncthreads();
}
#if DBG
__device__ __forceinline__ void dbg_max(Frame& F, int slot, float v) { if (v > 0.f) atomicMax(F.ctl + CW_DBG + slot, __builtin_bit_cast(unsigned, v)); }
__device__ __forceinline__ void ph_dbg_check(Frame& F) {
    const bf16_t* P = (const bf16_t*)(F.ws + WS_PROJ);
    const bf16_t* VTSB = (const bf16_t*)(F.ws + WS_VTSB);
    const bf16_t* YC = (const bf16_t*)(F.ws + WS_YCAT);
    const bf16_t* DB = (const bf16_t*)(F.ws + WS_DBG);
    const size_t gt = (size_t)F.bid * NT + F.tid, GT = (size_t)F.G * NT;
    float ea = 0.f;
    for (size_t i = gt; i < (size_t)BATCH * SBH * SBD * SEQ; i += GT) {
        const int pos = (int)(i % SEQ), d = (int)((i / SEQ) % SBD), bh = (int)(i / ((size_t)SEQ * SBD)), b = bh / SBH, h = bh % SBH;
        const int s32 = pos >> 5, q = pos & 31, fqq = q >> 3, a = (q >> 2) & 1, r = q & 3, key = 32 * s32 + 16 * a + 4 * fqq + r;
        const float e = fabsf(bf2f(VTSB[i]) - bf2f(P[(size_t)(b * SEQ + key) * PLD + COL_SBV + h * SBD + d]));
        ea = fmaxf(ea, e);
    }
    dbg_max(F, 0, ea);
    float eb = 0.f, ec = 0.f, ed = 0.f, ee = 0.f;
    for (size_t i = gt; i < (size_t)T * SBW; i += GT) {
        const int t = (int)(i / SBW), c = (int)(i % SBW), jq = (t % SEQ) >> 6;
        const float e = fabsf(bf2f(DB[i]) - bf2f(YC[(size_t)t * D + C + c]));
        if (jq == 0) eb = fmaxf(eb, e); else if (jq == 1) ec = fmaxf(ec, e); else if (jq < 4) ed = fmaxf(ed, e); else ee = fmaxf(ee, e);
    }
    dbg_max(F, 1, eb); dbg_max(F, 2, ec); dbg_max(F, 3, ed); dbg_max(F, 4, ee);
}
#endif
__device__ __forceinline__ void mem_item(Frame& F, const int it) {
    using pg8::bf16x8; using pg8::lds_byte;
    typedef float f4 __attribute__((ext_vector_type(4)));
    const bf16_t* P = (const bf16_t*)(F.ws + WS_PROJ);
    const bf16_t* MKV = (const bf16_t*)(F.ws + WS_MEMKV);
    const bf16_t* VTM = (const bf16_t*)(F.ws + WS_VTMEM);
    bf16_t* YC = (bf16_t*)(F.ws + WS_YCAT);
    LAS unsigned char* lds = F.lds;
    const int tid = F.tid, lane = F.lane, wave = F.wave, fr = lane & 15, fq = lane >> 4;
    const float scale = 0.08838834764831845f;
    const int fbase = lds_byte(fr, 8 * fq);
    {
        const int qt = it & 15, bh = it >> 4, b = bh / MEMH, h = bh % MEMH;
        __syncthreads();
#pragma unroll
        for (int t = 0; t < 4; ++t)
#pragma unroll
            for (int i = 0; i < 2; ++i) { const int pp = tid + 512 * i, r = pp >> 4, c = pp & 15, d = pp >> 3, c2 = pp & 7;
                const v4u kv = *(const v4u*)(MKV + (size_t)(b * MEML + 64 * t + r) * (2 * MEMW) + h * MEMD + 8 * c);
                const v4u vv = *(const v4u*)(VTM + ((size_t)bh * MEMD + d) * MEML + 64 * t + 8 * c2);
                *(LAS v4u*)(lds + t * 16384 + (c >> 3) * 8192 + lds_byte(r, (c & 7) * 8)) = kv;
                *(LAS v4u*)(lds + 65536 + t * 16384 + lds_byte(d, 8 * c2)) = vv; }
        bf16x8 qf[4];
        const int q = b * SEQ + 128 * qt + 16 * wave + fr;
        { const bf16_t* qp = P + (size_t)q * PLD + COL_QM + h * MEMD + 8 * fq;
#pragma unroll
          for (int kk = 0; kk < 4; ++kk) qf[kk] = *(const bf16x8*)(qp + 32 * kk); }
        __syncthreads();
        f4 sc[16];
#pragma unroll
        for (int ti = 0; ti < 16; ++ti) { sc[ti] = (f4){0.f, 0.f, 0.f, 0.f};
#pragma unroll
            for (int kk = 0; kk < 4; ++kk) { const bf16x8 kf = *(const LAS bf16x8*)(lds + (ti >> 2) * 16384 + fbase + (ti & 3) * 2048 + (kk & 1) * 1024 + (kk >> 1) * 8192);
                sc[ti] = __builtin_amdgcn_mfma_f32_16x16x32_bf16(kf, qf[kk], sc[ti], 0, 0, 0); } }
        float mx = -3.0e38f;
#pragma unroll
        for (int ti = 0; ti < 16; ++ti)
#pragma unroll
            for (int r = 0; r < 4; ++r) { sc[ti][r] *= scale * 1.4426950408889634f; mx = fmaxf(mx, sc[ti][r]); }
        mx = fmaxf(mx, __shfl_xor(mx, 16)); mx = fmaxf(mx, __shfl_xor(mx, 32));
        float sum = 0.f;
#pragma unroll
        for (int ti = 0; ti < 16; ++ti)
#pragma unroll
            for (int r = 0; r < 4; ++r) { sc[ti][r] = __builtin_amdgcn_exp2f(sc[ti][r] - mx); sum += sc[ti][r]; }
        sum += __shfl_xor(sum, 16); sum += __shfl_xor(sum, 32);
        const float inv = 1.f / sum;
        f4 acc_o[8];
#pragma unroll
        for (int ds = 0; ds < 8; ++ds) acc_o[ds] = (f4){0.f, 0.f, 0.f, 0.f};
#pragma unroll
        for (int ks = 0; ks < 8; ++ks) {
            v4u w; w.x = pg8::cvt_pk_bf16(sc[2 * ks][0], sc[2 * ks][1]); w.y = pg8::cvt_pk_bf16(sc[2 * ks][2], sc[2 * ks][3]);
            w.z = pg8::cvt_pk_bf16(sc[2 * ks + 1][0], sc[2 * ks + 1][1]); w.w = pg8::cvt_pk_bf16(sc[2 * ks + 1][2], sc[2 * ks + 1][3]);
            const bf16x8 pf = __builtin_bit_cast(bf16x8, w);
#pragma unroll
            for (int ds = 0; ds < 8; ++ds) { const bf16x8 vf = *(const LAS bf16x8*)(lds + 65536 + (ks >> 1) * 16384 + fbase + ds * 2048 + (ks & 1) * 1024);
                acc_o[ds] = __builtin_amdgcn_mfma_f32_16x16x32_bf16(vf, pf, acc_o[ds], 0, 0, 0); }
        }
        bf16_t* op = YC + (size_t)q * D + C + SBW + h * MEMD + 4 * fq;
#pragma unroll
        for (int ds = 0; ds < 8; ++ds)
            *(v2u*)(op + 16 * ds) = (v2u){pg8::cvt_pk_bf16(acc_o[ds][0] * inv, acc_o[ds][1] * inv), pg8::cvt_pk_bf16(acc_o[ds][2] * inv, acc_o[ds][3] * inv)};
    }
    __syncthreads();
}
__device__ __forceinline__ void sb128_item(Frame& F, const int b, const int h, const int jt) {
    using pg8::bf16x8; using pg8::lds_byte;
    typedef float f4 __attribute__((ext_vector_type(4)));
    const bf16_t* P = (const bf16_t*)(F.ws + WS_PROJ);
    const bf16_t* VT = (const bf16_t*)(F.ws + WS_VTSB) + (size_t)(b * SBH + h) * SBD * SEQ;
    bf16_t* YC = (bf16_t*)(F.ws + WS_YCAT);
    LAS unsigned char* lds = F.lds;
    volatile LAS float* cmax = (volatile LAS float*)(lds + 65536);
    const int tid = F.tid, lane = F.lane, wave = F.wave, fr = lane & 15, fq = lane >> 4;
    const float scale = 0.08838834764831845f * 1.4426950408889634f;
    const bf16_t* kbase = P + (size_t)(b * SEQ) * PLD + COL_SBK + h * SBD;
    int kwoff[2], vwoff[2]; size_t ksrc[2], vsrc[2];
#pragma unroll
    for (int i = 0; i < 2; ++i) { const int pp = tid + 512 * i, r = pp >> 4, c = pp & 15;
        kwoff[i] = (c >> 3) * 8192 + lds_byte(r, (c & 7) * 8); ksrc[i] = (size_t)r * PLD + 8 * c;
        const int d = pp >> 3, c2 = pp & 7;
        vwoff[i] = lds_byte(d, 8 * c2); vsrc[i] = (size_t)d * SEQ + 8 * c2; }
    const int fbase = lds_byte(fr, 8 * fq);
    bf16x8 qf[4];
    { const bf16_t* qp = P + (size_t)(b * SEQ + 128 * jt + 16 * wave + fr) * PLD + COL_SBQ + h * SBD + 8 * fq;
#pragma unroll
      for (int kk = 0; kk < 4; ++kk) qf[kk] = *(const bf16x8*)(qp + 32 * kk); }
    f4 acc_o[8];
#pragma unroll
    for (int i = 0; i < 8; ++i) acc_o[i] = (f4){0.f, 0.f, 0.f, 0.f};
    float carry = 0.f;
    v4u rk[2], rv[2];
    const int ktop = 2 * jt + 1;
#define S8_LOAD(kt_) do { const int _kt = (kt_) > 0 ? (kt_) : 0; _Pragma("unroll") for (int i = 0; i < 2; ++i) { rk[i] = *(const v4u*)(kbase + (size_t)_kt * 64 * PLD + ksrc[i]); rv[i] = *(const v4u*)(VT + (size_t)_kt * 64 + vsrc[i]); } } while (0)
#define S8_WRITE(stg) do { LAS unsigned char* _b = lds + (stg) * 32768; _Pragma("unroll") for (int i = 0; i < 2; ++i) { *(LAS v4u*)(_b + kwoff[i]) = rk[i]; *(LAS v4u*)(_b + 16384 + vwoff[i]) = rv[i]; } } while (0)
    __syncthreads();
    S8_LOAD(ktop); S8_WRITE(0); S8_LOAD(ktop - 1);
    __syncthreads();
    for (int st = 0; st <= ktop; ++st) {
        const int kt = ktop - st;
        const int rel = kt - 2 * jt;
        const bool active = !(rel == 1 && wave < 4);
        if (active) {
            const LAS unsigned char* kb = lds + (st & 1) * 32768;
            const LAS unsigned char* vb = kb + 16384;
            f4 sc[4];
#pragma unroll
            for (int i = 0; i < 4; ++i) { sc[i] = (f4){0.f, 0.f, 0.f, 0.f};
#pragma unroll
                for (int kk = 0; kk < 4; ++kk) { const bf16x8 kf = *(const LAS bf16x8*)(kb + fbase + i * 2048 + (kk & 1) * 1024 + (kk >> 1) * 8192);
                    sc[i] = __builtin_amdgcn_mfma_f32_16x16x32_bf16(kf, qf[kk], sc[i], 0, 0, 0); } }
            const bool diag = rel >= 0;
            float av[4][4], tt[4], xx[4];
#pragma unroll
            for (int i = 0; i < 4; ++i) {
                float lk[4];
#pragma unroll
                for (int r = 0; r < 4; ++r) { float z = sc[i][r] * scale; const float e = __builtin_amdgcn_exp2f(-fabsf(z)); float l = -(fmaxf(z, 0.f) + __builtin_amdgcn_logf(1.f + e));
                    if (diag && !((64 * rel + 16 * i + 4 * fq + r) < (16 * wave + fr))) { l = 0.f; z = -1.0e30f; }
                    lk[r] = l; sc[i][r] = z; }
                av[i][3] = lk[3]; av[i][2] = lk[2] + av[i][3]; av[i][1] = lk[1] + av[i][2]; av[i][0] = lk[0] + av[i][1];
                const float tot = av[i][0], u = __shfl_xor(tot, 16), t1 = tot + u, v = __shfl_xor(t1, 32);
                tt[i] = t1 + v; xx[i] = ((fq & 1) ? 0.f : u) + ((fq & 2) ? 0.f : v);
            }
            const float y2 = tt[3], y1 = y2 + tt[2], y0 = y1 + tt[1], total = y0 + tt[0];
            xx[0] += y0 + carry; xx[1] += y1 + carry; xx[2] += y2 + carry; xx[3] += carry;
            carry += total;
            bf16x8 pf[2];
#pragma unroll
            for (int sg2 = 0; sg2 < 2; ++sg2) {
                float pv[8];
#pragma unroll
                for (int a = 0; a < 2; ++a)
#pragma unroll
                    for (int r = 0; r < 4; ++r) pv[4 * a + r] = __builtin_amdgcn_exp2f(sc[2 * sg2 + a][r] + av[2 * sg2 + a][r] + xx[2 * sg2 + a]);
                v4u w; w.x = pg8::cvt_pk_bf16(pv[0], pv[1]); w.y = pg8::cvt_pk_bf16(pv[2], pv[3]); w.z = pg8::cvt_pk_bf16(pv[4], pv[5]); w.w = pg8::cvt_pk_bf16(pv[6], pv[7]);
                pf[sg2] = __builtin_bit_cast(bf16x8, w);
            }
#pragma unroll
            for (int ds = 0; ds < 8; ++ds)
#pragma unroll
                for (int sg2 = 0; sg2 < 2; ++sg2) { const bf16x8 vf = *(const LAS bf16x8*)(vb + fbase + ds * 2048 + sg2 * 1024);
                    acc_o[ds] = __builtin_amdgcn_mfma_f32_16x16x32_bf16(vf, pf[sg2], acc_o[ds], 0, 0, 0); }
        }
        { float cm = (128 * jt + 16 * wave + fr == 0) ? -1.0e30f : carry;
          cm = wave_max(cm);
          if (lane == 0) cmax[(st & 1) * 8 + wave] = cm; }
        S8_WRITE((st + 1) & 1);
        S8_LOAD(kt - 2);
        __syncthreads();
        float gm = cmax[(st & 1) * 8];
#pragma unroll
        for (int w = 1; w < 8; ++w) gm = fmaxf(gm, cmax[(st & 1) * 8 + w]);
        if (gm <= -140.f) break;
    }
#undef S8_LOAD
#undef S8_WRITE
    bf16_t* op = YC + (size_t)(b * SEQ + 128 * jt + 16 * wave + fr) * D + C + h * SBD + 4 * fq;
#pragma unroll
    for (int ds = 0; ds < 8; ++ds)
        *(v2u*)(op + 16 * ds) = (v2u){pg8::cvt_pk_bf16(acc_o[ds][0], acc_o[ds][1]), pg8::cvt_pk_bf16(acc_o[ds][2], acc_o[ds][3])};
}
__device__ __forceinline__ void ph_mix(Frame& F) {
    for (int bh = F.bid; bh < BATCH * NH; bh += F.G) wkv_carry_bh(F, bh);
    volatile LAS int* qslot = (volatile LAS int*)(F.lds + 139264);
    constexpr int N_SB = BATCH * SBH * 16, N_MEM = BATCH * MEMH * (SEQ / 128);
    int nxt = 0;
    if (F.tid == 0) nxt = (int)atomicAdd(F.ctl + CW_Q, 1u);
    for (;;) {
        __syncthreads();
        if (F.tid == 0) *qslot = nxt;
        __syncthreads();
        const int i = *qslot;
        if (i >= N_SB + N_MEM) break;
        if (F.tid == 0) nxt = (int)atomicAdd(F.ctl + CW_Q, 1u);
        if (i < N_SB) { const int jt = 15 - (i >> 4), bh = i & 15;
            sb128_item(F, bh / SBH, bh % SBH, jt); }
        else mem_item(F, i - N_SB);
    }
    __syncthreads();
}
struct EpiOut {
    static constexpr bool PERM = false, AFTER_DRAIN = false;
    bf16_t* Z; const bf16_t* H;
    __device__ __forceinline__ void operator()(const pg8::f32x4 (&acc)[2][2][4][2], const pg8::Unit& u, int wr, int wc, int fr, int fq) const {
        const int row0 = u.pm * 256 + wr * 64 + fr, col0 = u.pn * 256 + wc * 32 + 4 * fq;
#pragma unroll
        for (int ai = 0; ai < 2; ++ai)
#pragma unroll
            for (int m = 0; m < 4; ++m) { const size_t ro = (size_t)(row0 + ai * 128 + m * 16) * D + col0;
#pragma unroll
                for (int bj = 0; bj < 2; ++bj)
#pragma unroll
                    for (int n = 0; n < 2; ++n) { const v2u hb = *(const v2u*)(H + ro + bj * 128 + n * 16); const f32x4 h = (f32x4){bflo(hb.x), bfhi(hb.x), bflo(hb.y), bfhi(hb.y)}; const f32x4 z = h * ALPHA + acc[ai][bj][m][n]; *(v2u*)(Z + ro + bj * 128 + n * 16) = (v2u){pg8::cvt_pk_bf16(z[0], z[1]), pg8::cvt_pk_bf16(z[2], z[3])}; } }
    }
};
__device__ __forceinline__ void ph_outproj(Frame& F) {
    pg8::Gemm g{(const bf16_t*)(F.ws + WS_YCAT), (const bf16_t*)(F.ws + WS_WOUTT), T, D, D};
    pg8::StaticOrder S; S.init(T, D, F.G, F.bid);
    EpiOut E{(bf16_t*)(F.ws + WS_Z1), (const bf16_t*)(F.ws + WS_HB)};
    pg8::gemm_phase<EpiOut, pg8::StaticOrder, false>(F.lds, g, S, E, nullptr);
    __syncthreads();
}
__device__ __forceinline__ void ph_ln1_router(Frame& F) {
    using pg8::bf16x8;
    typedef float f4 __attribute__((ext_vector_type(4)));
    constexpr int TI = 32, RS2 = 1024 + 8;
    const bf16_t* Z1 = (const bf16_t*)(F.ws + WS_Z1);
    bf16_t* H1B = (bf16_t*)(F.ws + WS_H1B);
    const bf16_t* WR = (const bf16_t*)(F.ws + WS_WRT);
    int* LIST = (int*)(F.ws + WS_LIST);
    float* LISTW = (float*)(F.ws + WS_LISTW);
    LAS bf16_t* Ahi = (LAS bf16_t*)F.lds;
    LAS bf16_t* Alo = Ahi + TI * RS2;
    LAS float* red = (LAS float*)F.lds;
    LAS float* lg = red + 8 * 5 * 2 * 4 * 64;
    const int tid = F.tid, lane = F.lane, wave = F.wave, fr = lane & 15, fq = lane >> 4;
    const float* G1 = F.a->in[I_LN1G]; const float* B1 = F.a->in[I_LN1B];
    for (int item = F.bid; item < T / TI; item += F.G) {
        const int t0 = item * TI;
        __syncthreads();
        bf16x8 wq[2][10];
        const char* wb = (const char*)WR + (size_t)__builtin_amdgcn_readfirstlane(wave) * (4 * 5 * 1024);
        int lz = lane; asm volatile("" : "+v"(lz));
        const unsigned lo16 = (unsigned)lz * 16u;
        const unsigned lo8 = (unsigned)lz * 8u;
        const size_t rowb = (size_t)(t0 + 4 * __builtin_amdgcn_readfirstlane(wave)) * (D * 2);
        const char* zb = (const char*)Z1 + rowb; char* hb = (char*)H1B + rowb;
#define RT_WLOAD(slot, s_) do { _Pragma("unroll") for (int n = 0; n < 5; ++n) { const int co_ = ((32 * ((s_) >> 2) + ((s_) & 3)) * 5 + n) * 1024; \
            wq[slot][2 * n] = *(const bf16x8*)(wb + co_ + lo16); wq[slot][2 * n + 1] = *(const bf16x8*)(wb + 80 * D * 2 + co_ + lo16); } } while (0)
        float mean[4], rstd[4]; v2u zh[4][4];
        {   v2u zc[4][8];
#pragma unroll
            for (int rr = 0; rr < 4; ++rr)
#pragma unroll
                for (int j = 0; j < 8; ++j) zc[rr][j] = *(const v2u*)(zb + rr * (D * 2) + j * 512 + lo8);
#pragma unroll
            for (int rr = 0; rr < 4; ++rr) { float sm = 0.f;
#pragma unroll
                for (int j = 0; j < 8; ++j) sm += (bflo(zc[rr][j].x) + bfhi(zc[rr][j].x)) + (bflo(zc[rr][j].y) + bfhi(zc[rr][j].y));
                mean[rr] = wave_sum(sm) * (1.f / D);
                float s2 = 0.f;
#pragma unroll
                for (int j = 0; j < 8; ++j) { const float a0 = bflo(zc[rr][j].x) - mean[rr], a1 = bfhi(zc[rr][j].x) - mean[rr], a2 = bflo(zc[rr][j].y) - mean[rr], a3 = bfhi(zc[rr][j].y) - mean[rr]; s2 += (a0 * a0 + a1 * a1) + (a2 * a2 + a3 * a3); }
                rstd[rr] = 1.f / sqrtf(wave_sum(s2) * (1.f / D) + LN_EPS);
#pragma unroll
                for (int j = 0; j < 4; ++j) zh[rr][j] = zc[rr][j]; }
        }
        __builtin_amdgcn_sched_barrier(0);
        RT_WLOAD(0, 0); RT_WLOAD(1, 1);
        f4 acc[5][2];
#pragma unroll
        for (int hf = 0; hf < 2; ++hf) {
            if (hf) {
#pragma unroll
                for (int rr = 0; rr < 4; ++rr)
#pragma unroll
                    for (int j = 0; j < 4; ++j) zh[rr][j] = *(const v2u*)(zb + rr * (D * 2) + 2048 + j * 512 + lo8);
                __syncthreads();
            }
#pragma unroll
            for (int j = 0; j < 4; ++j) {
                const f32x4 gg = *(const f32x4*)((const char*)G1 + (4 * hf + j) * 1024 + lo16), bb = *(const f32x4*)((const char*)B1 + (4 * hf + j) * 1024 + lo16);
#pragma unroll
                for (int rr = 0; rr < 4; ++rr) { const int row = 4 * wave + rr; const v2u z = zh[rr][j];
                    const f32x4 v = ((f32x4){bflo(z.x), bfhi(z.x), bflo(z.y), bfhi(z.y)} - mean[rr]) * rstd[rr] * gg + bb;
                    const v2u hi = (v2u){pg8::cvt_pk_bf16(v.x, v.y), pg8::cvt_pk_bf16(v.z, v.w)};
                    const v2u lo = (v2u){pg8::cvt_pk_bf16(v.x - bflo(hi.x), v.y - bfhi(hi.x)), pg8::cvt_pk_bf16(v.z - bflo(hi.y), v.w - bfhi(hi.y))};
                    *(v2u*)(hb + rr * (D * 2) + (4 * hf + j) * 512 + lo8) = hi;
                    *(LAS v2u*)(Ahi + row * RS2 + 4 * (lane + 64 * j)) = hi;
                    *(LAS v2u*)(Alo + row * RS2 + 4 * (lane + 64 * j)) = lo; }
            }
            __syncthreads();
            if (hf == 0) {
#pragma unroll
                for (int n = 0; n < 5; ++n) { acc[n][0] = (f4){0.f, 0.f, 0.f, 0.f}; acc[n][1] = acc[n][0]; } }
#pragma unroll
            for (int ks = 0; ks < 4; ++ks) {
                const int s_ = 4 * hf + ks, k = 128 * wave + 32 * ks + 8 * fq;
                bf16x8 bh[2], bl[2];
#pragma unroll
                for (int tt = 0; tt < 2; ++tt) { bh[tt] = *(const LAS bf16x8*)(Ahi + (16 * tt + fr) * RS2 + k); bl[tt] = *(const LAS bf16x8*)(Alo + (16 * tt + fr) * RS2 + k); }
#pragma unroll
                for (int n = 0; n < 5; ++n) { const bf16x8 wh = wq[s_ & 1][2 * n], wl = wq[s_ & 1][2 * n + 1];
#pragma unroll
                    for (int tt = 0; tt < 2; ++tt) {
                        acc[n][tt] = __builtin_amdgcn_mfma_f32_16x16x32_bf16(wh, bh[tt], acc[n][tt], 0, 0, 0);
                        acc[n][tt] = __builtin_amdgcn_mfma_f32_16x16x32_bf16(wl, bh[tt], acc[n][tt], 0, 0, 0);
                        acc[n][tt] = __builtin_amdgcn_mfma_f32_16x16x32_bf16(wh, bl[tt], acc[n][tt], 0, 0, 0); } }
                __builtin_amdgcn_sched_barrier(0);
                if (s_ + 2 < 8) { if ((s_ & 1) == 0) RT_WLOAD(0, s_ + 2); else RT_WLOAD(1, s_ + 2); }
                __builtin_amdgcn_sched_barrier(0);
            }
        }
#undef RT_WLOAD
        __syncthreads();
#pragma unroll
        for (int n = 0; n < 5; ++n)
#pragma unroll
            for (int tt = 0; tt < 2; ++tt)
#pragma unroll
                for (int r = 0; r < 4; ++r) red[(((wave * 5 + n) * 2 + tt) * 4 + r) * 64 + lane] = acc[n][tt][r];
        __syncthreads();
        for (int idx = tid; idx < 5 * 2 * 4 * 64; idx += NT) {
            const int l = idx & 63, q = idx >> 6, r = q & 3, tt = (q >> 2) & 1, n = q >> 3;
            float sm = 0.f;
#pragma unroll
            for (int w = 0; w < 8; ++w) sm += red[(((w * 5 + n) * 2 + tt) * 4 + r) * 64 + l];
            lg[(16 * tt + (l & 15)) * 80 + 16 * n + 4 * (l >> 4) + r] = sm;
        }
        __syncthreads();
        if (tid < TI) {
            const int t = t0 + tid;
            const LAS float* lp = lg + tid * 80;
            float gl[NG];
            { const f32x4 g0 = *(const f32x4*)(F.a->in[I_RGB]), g1 = *(const f32x4*)(F.a->in[I_RGB] + 4);
              const float gb[NG] = {g0.x, g0.y, g0.z, g0.w, g1.x, g1.y, g1.z, g1.w};
#pragma unroll
              for (int j = 0; j < NG; ++j) gl[j] = lp[j] + gb[j]; }
            int gi = 0; float gm = gl[0];
#pragma unroll
            for (int j = 1; j < NG; ++j) if (gl[j] > gm) { gm = gl[j]; gi = j; }
            float gs = 0.f;
#pragma unroll
            for (int j = 0; j < NG; ++j) gs += expf(gl[j] - gm);
            const float gw_ = 1.f / gs;
            float v0 = -3.0e38f, v1 = -3.0e38f; int i0 = 0, i1 = 0;
            const f32x4 e0 = *(const f32x4*)(F.a->in[I_REB] + gi * EPG), e1v = *(const f32x4*)(F.a->in[I_REB] + gi * EPG + 4);
            const float eb[EPG] = {e0.x, e0.y, e0.z, e0.w, e1v.x, e1v.y, e1v.z, e1v.w};
#pragma unroll
            for (int j = 0; j < EPG; ++j) {
                const float l = lp[NG + gi * EPG + j] + eb[j];
                if (l > v0) { v1 = v0; i1 = i0; v0 = l; i0 = j; } else if (l > v1) { v1 = l; i1 = j; }
            }
            const float e1 = expf(v1 - v0);
            const float w0 = gw_ / (1.f + e1), w1 = gw_ * e1 / (1.f + e1);
            const int ex0 = gi * EPG + i0, ex1 = gi * EPG + i1;
            const unsigned p0 = atomicAdd(F.ctl + CW_CNT + ex0, 1u);
            LIST[ex0 * LISTCAP + p0] = t * 2; LISTW[ex0 * LISTCAP + p0] = w0;
            const unsigned p1 = atomicAdd(F.ctl + CW_CNT + ex1, 1u);
            LIST[ex1 * LISTCAP + p1] = t * 2 + 1; LISTW[ex1 * LISTCAP + p1] = w1;
        }
    }
    __syncthreads();
}
namespace sg {
using pg8::bf16x8; using pg8::lds_byte;
typedef float acc_t __attribute__((ext_vector_type(4)));
constexpr int MT = 5;
constexpr int A_BUF = 4 * MT * 2048, B_BUF = 16384, A_OFF = 0, B_OFF = 2 * A_BUF;

template <class Maker, int LDB>
__device__ __forceinline__ void run_units(LAS unsigned char* lds, const Maker& mk, const int nk, const int nrounds, const int tid) {
    typedef typename Maker::AP AP; typedef typename Maker::BP BP; typedef typename Maker::Epi Epi;
    AP ap; BP bp; Epi ep;
    int r = 0;
    bool has = false;
    while (r < nrounds && !(has = mk(r, ap, bp, ep))) ++r;
    if (!has) return;
    const int wid = __builtin_amdgcn_readfirstlane(tid >> 6), lane = tid & 63, wr = wid >> 1, wc = wid & 1, fr = lane & 15, fq = lane >> 4;
    const int awoff = (tid >> 7) * 2048 + lds_byte((tid >> 3) & 15, 8 * (tid & 7));
    const int kq = tid >> 5, nq = tid & 31;
    const int bwoff0 = lds_byte(bp.rho(4 * nq), 4 * kq);
    const int aoff = wr * 2048 + lds_byte(fr, fq * 8);
    const int boff = lds_byte(wc * 64 + fr, fq * 8);
    unsigned aoffs[MT];
    const bf16_t* abase; const float* bsrc; constexpr size_t ldb = LDB;
#define SG_SETUP(ap_, bp_) do { _Pragma("unroll") for (int i = 0; i < MT; ++i) aoffs[i] = (ap_).row((tid >> 3) + 64 * i) + 8 * (tid & 7); \
        abase = (ap_).base(); bsrc = (bp_).ptr(4 * nq) + (size_t)(4 * kq) * ldb; } while (0)
    SG_SETUP(ap, bp);
    acc_t acc[MT][4];
#pragma unroll
    for (int m = 0; m < MT; ++m)
#pragma unroll
        for (int n = 0; n < 4; ++n) acc[m][n] = (acc_t){0.f, 0.f, 0.f, 0.f};
    v4u ra0[MT]; f32x4 rb0[4], rb1[4];
#define SG_LOADA(ra, kt) do { _Pragma("unroll") for (int i = 0; i < MT; ++i) ra[i] = *(const v4u*)(abase + aoffs[i] + (size_t)(kt) * 64); } while (0)
#define SG_LOADB(rb, kt) do { _Pragma("unroll") for (int j = 0; j < 4; ++j) rb[j] = __builtin_nontemporal_load((const f32x4*)(bsrc + ((size_t)(kt) * 64 + j) * ldb)); } while (0)
#define SG_WRITEA(ra, buf, w5) do { _Pragma("unroll") for (int i = 0; i < MT - 1; ++i) *(LAS v4u*)(lds + A_OFF + (buf) * A_BUF + i * 8192 + awoff) = ra[i]; \
        if (w5) *(LAS v4u*)(lds + A_OFF + (buf) * A_BUF + (MT - 1) * 8192 + awoff) = ra[MT - 1]; } while (0)
#define SG_WRITEB(rb, buf) do { _Pragma("unroll") for (int c = 0; c < 4; ++c) { v2u w; w.x = pg8::cvt_pk_bf16(rb[0][c], rb[1][c]); w.y = pg8::cvt_pk_bf16(rb[2][c], rb[3][c]); \
            *(LAS v2u*)(lds + B_OFF + (buf) * B_BUF + bwoff0 + 64 * c) = w; } } while (0)
#define SG_COMPUTE(buf) do { _Pragma("unroll") for (int k = 0; k < 2; ++k) { bf16x8 bfr[4]; \
        _Pragma("unroll") for (int n = 0; n < 4; ++n) bfr[n] = *(const LAS bf16x8*)(lds + B_OFF + (buf) * B_BUF + boff + n * 2048 + k * 1024); \
        _Pragma("unroll") for (int m = 0; m < MT - 1; ++m) { const bf16x8 af = *(const LAS bf16x8*)(lds + A_OFF + (buf) * A_BUF + aoff + m * 8192 + k * 1024); \
            _Pragma("unroll") for (int n = 0; n < 4; ++n) acc[m][n] = __builtin_amdgcn_mfma_f32_16x16x32_bf16(bfr[n], af, acc[m][n], 0, 0, 0); } \
        if (h5) { const bf16x8 af = *(const LAS bf16x8*)(lds + A_OFF + (buf) * A_BUF + aoff + (MT - 1) * 8192 + k * 1024); \
            _Pragma("unroll") for (int n = 0; n < 4; ++n) acc[MT - 1][n] = __builtin_amdgcn_mfma_f32_16x16x32_bf16(bfr[n], af, acc[MT - 1][n], 0, 0, 0); } \
        __builtin_amdgcn_sched_barrier(0); } } while (0)
#define SG_FLAGS(ap_, w5_, h5_) do { const int nv_ = __builtin_amdgcn_readfirstlane((ap_).nvalid); w5_ = nv_ > 64 * (MT - 1); h5_ = nv_ > 16 * (wr + 4 * (MT - 1)); } while (0)
    bool w5, h5; SG_FLAGS(ap, w5, h5);
    SG_LOADA(ra0, 0); SG_LOADB(rb0, 0); SG_LOADB(rb1, 1);
    SG_WRITEA(ra0, 0, w5); SG_WRITEB(rb0, 0);
    SG_LOADA(ra0, 1);
    __syncthreads();
    for (;;) {
        int kt = 0;
        for (; kt + 4 < nk; kt += 2) {
            SG_LOADB(rb0, kt + 2); SG_COMPUTE(0); SG_WRITEA(ra0, 1, w5); SG_WRITEB(rb1, 1); SG_LOADA(ra0, kt + 2); __syncthreads();
            SG_LOADB(rb1, kt + 3); SG_COMPUTE(1); SG_WRITEA(ra0, 0, w5); SG_WRITEB(rb0, 0); SG_LOADA(ra0, kt + 3); __syncthreads();
        }
        SG_LOADB(rb0, kt + 2); SG_COMPUTE(0); SG_WRITEA(ra0, 1, w5); SG_WRITEB(rb1, 1); SG_LOADA(ra0, kt + 2); __syncthreads();
        SG_LOADB(rb1, kt + 3); SG_COMPUTE(1); SG_WRITEA(ra0, 0, w5); SG_WRITEB(rb0, 0); SG_LOADA(ra0, kt + 3); __syncthreads();
        AP apn; BP bpn; Epi epn; int rn = r + 1; bool hasn = false;
        while (rn < nrounds && !(hasn = mk(rn, apn, bpn, epn))) ++rn;
        if (!hasn) { apn = ap; bpn = bp; }
        bool w5n, h5n; SG_FLAGS(apn, w5n, h5n);
        unsigned nrow[MT];
#pragma unroll
        for (int i = 0; i < MT; ++i) nrow[i] = apn.row((tid >> 3) + 64 * i);
        int pe[MT]; float pw[MT];
        { int tz = tid; asm volatile("" : "+v"(tz)); ep.pre(pe, pw, __builtin_amdgcn_readfirstlane(tz >> 7), tz & 15); }
        __builtin_amdgcn_sched_barrier(0);
        SG_COMPUTE(0); SG_WRITEA(ra0, 1, w5); SG_WRITEB(rb1, 1);
        __builtin_amdgcn_sched_barrier(0);
#pragma unroll
        for (int i = 0; i < MT; ++i) aoffs[i] = nrow[i] + 8 * (tid & 7);
        abase = apn.base(); bsrc = bpn.ptr(4 * nq) + (size_t)(4 * kq) * ldb;
        __builtin_amdgcn_sched_barrier(0);
        SG_LOADA(ra0, 0); SG_LOADB(rb0, 0); __syncthreads();
        SG_LOADB(rb1, 1); SG_COMPUTE(1); SG_WRITEA(ra0, 0, w5n); SG_WRITEB(rb0, 0); SG_LOADA(ra0, 1);
        { int tz = tid; asm volatile("" : "+v"(tz));
          const int wz = __builtin_amdgcn_readfirstlane(tz >> 6), lz = tz & 63;
          ep.fin(acc, pe, pw, wz >> 1, wz & 1, lz & 15, lz >> 4); }
        __syncthreads();
        if (!hasn) break;
#pragma unroll
        for (int m = 0; m < MT; ++m)
#pragma unroll
            for (int n = 0; n < 4; ++n) acc[m][n] = (acc_t){0.f, 0.f, 0.f, 0.f};
        ap = apn; bp = bpn; ep = epn; r = rn; w5 = w5n; h5 = h5n;
    }
#undef SG_FLAGS
#undef SG_SETUP
#undef SG_LOADA
#undef SG_LOADB
#undef SG_WRITEA
#undef SG_WRITEB
#undef SG_COMPUTE
}
}

constexpr int MT_ROWS = 64 * sg::MT;
__device__ __forceinline__ void moe_build_tab(Frame& F, LAS int* tab) {
    __syncthreads();
    if (F.wave == 0) {
        const int e = F.lane, n = (int)F.ctl[CW_CNT + e], ns = (n + MT_ROWS - 1) / MT_ROWS;
        int off = n, so = ns;
#pragma unroll
        for (int d = 1; d < 64; d <<= 1) { const int a = __shfl_up(off, d), b = __shfl_up(so, d); if (e >= d) { off += a; so += b; } }
        tab[e] = n; tab[NE + e] = off - n;
        for (int mt = 0; mt < ns; ++mt) tab[129 + so - ns + mt] = e | (mt << 8);
        if (e == 63) tab[128] = so;
    }
    __syncthreads();
}
__device__ __forceinline__ bool moe_unit(const int G, const int bid, const LAS int* tab, int r, int& e, int& mt, int& nt) {
    int slot;
    if (G == 256) { const int x = bid & 7, j = bid >> 3; slot = r * 16 + (j >> 4) * 8 + x; nt = j & 15; }
    else { const int u = r * G + bid; slot = u >> 4; nt = u & 15; }
    if (slot >= tab[128]) return false;
    const int sv = tab[129 + slot]; e = sv & 255; mt = sv >> 8; return true;
}
struct APGather { const bf16_t* X; const int* list; int nvalid;
    __device__ __forceinline__ const bf16_t* base() const { return X; }
    __device__ __forceinline__ unsigned row(int r) const { const int rr = r < nvalid ? r : nvalid - 1; return (unsigned)(list[rr] >> 1) * (unsigned)D; } };
struct APPlain { const bf16_t* X; int ld; int nvalid;
    __device__ __forceinline__ const bf16_t* base() const { return X; }
    __device__ __forceinline__ unsigned row(int r) const { const int rr = r < nvalid ? r : nvalid - 1; return (unsigned)rr * (unsigned)ld; } };
struct BPUp { const float* Wg; const float* Wu; int ldb;
    __device__ __forceinline__ const float* ptr(int nu4) const { return nu4 < 64 ? Wg + nu4 : Wu + (nu4 - 64); }
    __device__ __forceinline__ int rho(int nu) const { const int j = nu & 63, h = nu >> 6; return 64 * (j >> 5) + 32 * h + (j & 31); } };
struct BPDown { const float* W; int ldb;
    __device__ __forceinline__ const float* ptr(int nu4) const { return W + nu4; }
    __device__ __forceinline__ int rho(int nu) const { return nu; } };
struct EpiUp { bf16_t* H; int nvalid;
    __device__ __forceinline__ void pre(int (&)[sg::MT], float (&)[sg::MT], int, int) const {}
    __device__ __forceinline__ void fin(const sg::acc_t (&acc)[sg::MT][4], const int (&)[sg::MT], const float (&)[sg::MT], int wr, int wc, int fr, int fq) const { (*this)(acc, wr, wc, fr, fq); }
    template <int NM> __device__ __forceinline__ void runi(const sg::acc_t (&acc)[sg::MT][4], int wr, int wc, int fr, int fq) const {
#pragma unroll
        for (int m = 0; m < NM; ++m) { const int row = 16 * (wr + 4 * m) + fr;
            if (row < nvalid) {
#pragma unroll
                for (int n = 0; n < 2; ++n) { const sg::acc_t g = acc[m][n], u = acc[m][n + 2]; float h[4];
#pragma unroll
                    for (int j = 0; j < 4; ++j) h[j] = g[j] * __builtin_amdgcn_rcpf(1.f + __expf(-g[j])) * u[j];
                    *(v2u*)(H + (size_t)row * DE + 32 * wc + 16 * n + 4 * fq) = (v2u){pg8::cvt_pk_bf16(h[0], h[1]), pg8::cvt_pk_bf16(h[2], h[3])}; } } }
    }
    __device__ __forceinline__ void operator()(const sg::acc_t (&acc)[sg::MT][4], int wr, int wc, int fr, int fq) const {
#pragma unroll
        for (int m = 0; m < sg::MT; ++m) { const int row = 16 * (wr + 4 * m) + fr;
            if (row < nvalid) {
#pragma unroll
                for (int n = 0; n < 2; ++n) { const sg::acc_t g = acc[m][n], u = acc[m][n + 2]; float h[4];
#pragma unroll
                    for (int j = 0; j < 4; ++j) h[j] = g[j] * __builtin_amdgcn_rcpf(1.f + __expf(-g[j])) * u[j];
                    *(v2u*)(H + (size_t)row * DE + 32 * wc + 16 * n + 4 * fq) = (v2u){pg8::cvt_pk_bf16(h[0], h[1]), pg8::cvt_pk_bf16(h[2], h[3])}; } } }
    }
};
struct EpiDown { bf16_t* YS; const int* list; const float* lw; int nvalid, n0;
    template <int NM> __device__ __forceinline__ void runi(const sg::acc_t (&acc)[sg::MT][4], int wr, int wc, int fr, int fq) const {
#pragma unroll
        for (int m = 0; m < NM; ++m) { const int row = 16 * (wr + 4 * m) + fr;
            if (row < nvalid) { const int e = list[row]; const float w = lw[row]; bf16_t* dst = YS + (size_t)e * D + n0 + 64 * wc + 4 * fq;
#pragma unroll
                for (int n = 0; n < 4; ++n) *(v2u*)(dst + 16 * n) = (v2u){pg8::cvt_pk_bf16(acc[m][n][0] * w, acc[m][n][1] * w), pg8::cvt_pk_bf16(acc[m][n][2] * w, acc[m][n][3] * w)}; } }
    }
    __device__ __forceinline__ void pre(int (&pe)[sg::MT], float (&pw)[sg::MT], int wr, int fr) const {
#pragma unroll
        for (int m = 0; m < sg::MT; ++m) { const int row = 16 * (wr + 4 * m) + fr, rr = row < nvalid ? row : nvalid - 1; pe[m] = list[rr]; pw[m] = lw[rr]; } }
    __device__ __forceinline__ void fin(const sg::acc_t (&acc)[sg::MT][4], const int (&pe)[sg::MT], const float (&pw)[sg::MT], int wr, int wc, int fr, int fq) const {
#pragma unroll
        for (int m = 0; m < sg::MT; ++m) { const int row = 16 * (wr + 4 * m) + fr;
            if (row < nvalid) { const float w = pw[m]; bf16_t* dst = YS + (size_t)pe[m] * D + n0 + 64 * wc + 4 * fq;
#pragma unroll
                for (int n = 0; n < 4; ++n) *(v2u*)(dst + 16 * n) = (v2u){pg8::cvt_pk_bf16(acc[m][n][0] * w, acc[m][n][1] * w), pg8::cvt_pk_bf16(acc[m][n][2] * w, acc[m][n][3] * w)}; } } }
    __device__ __forceinline__ void operator()(const sg::acc_t (&acc)[sg::MT][4], int wr, int wc, int fr, int fq) const {
#pragma unroll
        for (int m = 0; m < sg::MT; ++m) { const int row = 16 * (wr + 4 * m) + fr;
            if (row < nvalid) { const int e = list[row]; const float w = lw[row]; bf16_t* dst = YS + (size_t)e * D + n0 + 64 * wc + 4 * fq;
#pragma unroll
                for (int n = 0; n < 4; ++n) *(v2u*)(dst + 16 * n) = (v2u){pg8::cvt_pk_bf16(acc[m][n][0] * w, acc[m][n][1] * w), pg8::cvt_pk_bf16(acc[m][n][2] * w, acc[m][n][3] * w)}; } }
    }
};
struct MakerUp { typedef APGather AP; typedef BPUp BP; typedef EpiUp Epi;
    const LAS int* tab; int G, bid; const bf16_t* H1B; const int* LIST; bf16_t* HID; const float* WEG; const float* WEU;
    __device__ __forceinline__ bool operator()(int r, AP& ap, BP& bp, Epi& ep) const {
        int e, mt, nt; if (!moe_unit(G, bid, tab, r, e, mt, nt)) return false;
        const int cnt = tab[e], off = tab[NE + e], nvalid = min(MT_ROWS, cnt - mt * MT_ROWS), n0 = nt * 64;
        ap = AP{H1B, LIST + e * LISTCAP + mt * MT_ROWS, nvalid};
        bp = BP{WEG + (size_t)e * D * DE + n0, WEU + (size_t)e * D * DE + n0, DE};
        ep = Epi{HID + (size_t)(off + mt * MT_ROWS) * DE + n0, nvalid};
        return true; } };
__device__ __forceinline__ void ph_moe_up(Frame& F) {
    LAS int* tab = (LAS int*)(F.lds + 131072);
    moe_build_tab(F, tab);
    const MakerUp mk{tab, F.G, F.bid, (const bf16_t*)(F.ws + WS_H1B), (const int*)(F.ws + WS_LIST), (bf16_t*)(F.ws + WS_HID), F.a->in[I_WEG], F.a->in[I_WEU]};
    sg::run_units<MakerUp, DE>(F.lds, mk, D / 64, (tab[128] * 16 + F.G - 1) / F.G + 1, F.tid);
    __syncthreads();
}
struct MakerDown { typedef APPlain AP; typedef BPDown BP; typedef EpiDown Epi;
    const LAS int* tab; int G, bid; const bf16_t* HID; const int* LIST; const float* LISTW; bf16_t* YS; const float* WED;
    __device__ __forceinline__ bool operator()(int r, AP& ap, BP& bp, Epi& ep) const {
        int e, mt, nt; if (!moe_unit(G, bid, tab, r, e, mt, nt)) return false;
        const int cnt = tab[e], off = tab[NE + e], nvalid = min(MT_ROWS, cnt - mt * MT_ROWS), n0 = nt * 128;
        ap = AP{HID + (size_t)(off + mt * MT_ROWS) * DE, DE, nvalid};
        bp = BP{WED + (size_t)e * DE * D + n0, D};
        ep = Epi{YS, LIST + e * LISTCAP + mt * MT_ROWS, LISTW + e * LISTCAP + mt * MT_ROWS, nvalid, n0};
        return true; } };
__device__ __forceinline__ void ph_moe_down(Frame& F) {
    LAS int* tab = (LAS int*)(F.lds + 131072);
    moe_build_tab(F, tab);
    const MakerDown mk{tab, F.G, F.bid, (const bf16_t*)(F.ws + WS_HID), (const int*)(F.ws + WS_LIST), (const float*)(F.ws + WS_LISTW), (bf16_t*)(F.ws + WS_YS), F.a->in[I_WED]};
    sg::run_units<MakerDown, D>(F.lds, mk, DE / 64, (tab[128] * 16 + F.G - 1) / F.G + 1, F.tid);
    __syncthreads();
}
__device__ __forceinline__ void ph_ln2(Frame& F) {
    const bf16_t* H1B = (const bf16_t*)(F.ws + WS_H1B);
    const bf16_t* YS = (const bf16_t*)(F.ws + WS_YS);
    const int gw = F.bid * NWAVES + F.wave, NGW = F.G * NWAVES;
    v2u hc[8], ac[8], cc[8];
#define LN2_LOAD(row_) do { const v2u* hr_ = (const v2u*)(H1B + (size_t)(row_) * D); const v2u* y0_ = (const v2u*)(YS + (size_t)(row_) * 2 * D); const v2u* y1_ = y0_ + D / 4; \
        _Pragma("unroll") for (int j = 0; j < 8; ++j) { hc[j] = hr_[F.lane + 64 * j]; ac[j] = y0_[F.lane + 64 * j]; cc[j] = y1_[F.lane + 64 * j]; } } while (0)
    { const int r0 = gw < T ? gw : T - 1; LN2_LOAD(r0); }
    for (int row = gw; row < T; row += NGW) {
        f32x4 v[8];
#pragma unroll
        for (int j = 0; j < 8; ++j) { const v2u h = hc[j], a = ac[j], c = cc[j];
            v[j] = (f32x4){bflo(h.x) * ALPHA + (bflo(a.x) + bflo(c.x)), bfhi(h.x) * ALPHA + (bfhi(a.x) + bfhi(c.x)), bflo(h.y) * ALPHA + (bflo(a.y) + bflo(c.y)), bfhi(h.y) * ALPHA + (bfhi(a.y) + bfhi(c.y))}; }
        { const int nr = row + NGW < T ? row + NGW : row; LN2_LOAD(nr); }
        ln_core(v, F.a->in[I_LN2G], F.a->in[I_LN2B], F.out + (size_t)row * D, F.lane);
    }
#undef LN2_LOAD
}

constexpr int N_PHASES = 13;
__global__ void __launch_bounds__(NT, 2) fwd(Args args) {
    extern __shared__ __attribute__((aligned(16))) unsigned char lds[];
    Frame F;
    F.lds = (LAS unsigned char*)lds;
    F.tid = threadIdx.x; F.lane = (int)__builtin_amdgcn_mbcnt_hi(~0u, __builtin_amdgcn_mbcnt_lo(~0u, 0u)); F.wave = __builtin_amdgcn_readfirstlane(F.tid >> 6);
    F.bid = blockIdx.x; F.G = gridDim.x;
    F.ws = args.ws; F.ctl = (unsigned*)(args.ws + WS_CTL); F.out = args.out;
    F.a = &args;
    volatile LAS unsigned* xbw = (volatile LAS unsigned*)(F.lds + LDS_BYTES - 16);
    if (F.tid == 0) { xbw[0] = 0u; xbw[1] = 0u; xbw[2] = 0u; xbw[3] = 0u; }
    __syncthreads();
    const int lo = args.ph_lo, hi = args.ph_hi;
    XcdBarrier bar; bar.bar = F.ctl + CW_BAR; bar.x = 0; bar.st = xbw;
    if (hi - lo > 1) bar = xcd_barrier_post(F.ctl + CW_BAR, xbw);
#define IN(k) (lo <= (k) && (k) < hi)
#define SEAM(k) do { if (IN(k) && IN((k) + 1)) xcd_barrier(bar); } while (0)
    if (IN(0)) { ph_prologue(F); } SEAM(0);
    if (IN(1)) { ph_proj(F); } SEAM(1);
    if (IN(2)) { ph_rwkv_prep(F); ph_vt(F); } SEAM(2);
    if (IN(3)) { ph_wkv_chunk(F); } SEAM(3);
    if (IN(4)) { ph_mix(F); }
    if (IN(5)) { }
    if (IN(6)) { } SEAM(6);
    if (IN(7)) { ph_wkv_post(F); } SEAM(7);
    if (IN(8)) { ph_outproj(F); } SEAM(8);
    if (IN(9)) { ph_ln1_router(F); } SEAM(9);
    if (IN(10)) { ph_moe_up(F); } SEAM(10);
    if (IN(11)) { ph_moe_down(F); } SEAM(11);
    if (IN(12)) { ph_ln2(F); }
#undef IN
#undef SEAM
}

extern "C" void kernel_launch(void* const* d_in, const int* in_sizes, int n_in, void* d_out, int out_size, void* d_ws, size_t ws_size, hipStream_t stream) {
    static int grid = 0;
    if (grid == 0) {
        if (n_in != 29 || out_size != T * D || ws_size < WS_END) { fprintf(stderr, "kernel_launch: unexpected shapes n_in %d out %d ws %zu (need %zu)\n", n_in, out_size, ws_size, (size_t)WS_END); grid = -1; return; }
        int dev = 0, cus = 0;
        if (hipGetDevice(&dev) != hipSuccess || hipDeviceGetAttribute(&cus, hipDeviceAttributeMultiprocessorCount, dev) != hipSuccess) { grid = -1; return; }
        if (hipFuncSetAttribute((const void*)fwd, hipFuncAttributeMaxDynamicSharedMemorySize, LDS_BYTES) != hipSuccess) { fprintf(stderr, "kernel_launch: hipFuncSetAttribute failed\n"); grid = -1; return; }
        int per_cu = 0;
        if (hipOccupancyMaxActiveBlocksPerMultiprocessor(&per_cu, (const void*)fwd, NT, LDS_BYTES) != hipSuccess || per_cu < 1) fprintf(stderr, "kernel_launch: occupancy query says %d\n", per_cu);
        (void)hipGetLastError();
        grid = cus;
    }
    if (grid < 0) return;
    (void)hipMemsetAsync((char*)d_ws + WS_CTL, 0, CTL_ZERO_BYTES, stream);
    Args a{};
    for (int i = 0; i < 29; ++i) a.in[i] = (const float*)d_in[i];
    a.out = (float*)d_out; a.ws = (unsigned char*)d_ws;
#if MK_N_LAUNCHES == 1
    a.ph_lo = 0; a.ph_hi = N_PHASES;
    hipLaunchKernelGGL(fwd, dim3(grid), dim3(NT), LDS_BYTES, stream, a);
#else
    const int cuts[] = {0, 1, 2, 3, 4, 7, 8, 9, 10, 11, 12, 13};
    for (int i = 0; i + 1 < (int)(sizeof(cuts) / sizeof(int)); ++i) {
        a.ph_lo = cuts[i]; a.ph_hi = cuts[i + 1];
        hipLaunchKernelGGL(fwd, dim3(grid), dim3(NT), LDS_BYTES, stream, a);
    }
#endif
    const hipError_t le = hipPeekAtLastError();
    if (le != hipSuccess) fprintf(stderr, "kernel_launch: launch failed: %s\n", hipGetErrorName(le));
}
```

```cpp
#include <hip/hip_runtime.h>
#include <cstdio>
#include <cstdint>

#ifndef DBG
#define DBG 0
#endif
#ifndef MK_N_LAUNCHES
#define MK_N_LAUNCHES 1
#endif

#define LAS __attribute__((address_space(3)))
typedef float f32x4 __attribute__((ext_vector_type(4)));
typedef float f32x2 __attribute__((ext_vector_type(2)));
typedef unsigned short bf16_t;
typedef unsigned v4u __attribute__((ext_vector_type(4)));
typedef unsigned v2u __attribute__((ext_vector_type(2)));

constexpr int BATCH = 4, SEQ = 2048, T = BATCH * SEQ, D = 2048, C = 1024, NH = 16, HD = 64;
constexpr int DR = 64, AR = 64, GR = 160, LOWR = DR + AR + GR;
constexpr int RWKV_COLS = 3 * C + LOWR;
constexpr int SBW = 512, SBH = 4, SBD = 128, MEMW = 512, MEMH = 4, MEMD = 128, MEML = 256;
constexpr int IN_COLS = RWKV_COLS + 3 * SBW + MEMW;
constexpr int PLD = 5632;
constexpr int COL_R = 0, COL_K = C, COL_V = 2 * C, COL_DL = 3 * C, COL_SBQ = RWKV_COLS, COL_SBK = RWKV_COLS + SBW, COL_SBV = RWKV_COLS + 2 * SBW, COL_QM = RWKV_COLS + 3 * SBW;
constexpr int NG = 8, EPG = 8, NE = 64, DE = 1024;
constexpr float ALPHA = 1.18920711500272f;
constexpr float LN_EPS = 1e-5f, GN_EPS = 64e-5f;
constexpr int NT = 512, NWAVES = 8;
constexpr int LISTCAP = 8192;

constexpr size_t MiB = 1u << 20;
constexpr size_t WS_CTL = 0, CTL_ZERO_BYTES = 32768;
constexpr size_t WS_H32 = 2 * MiB;
constexpr size_t WS_HB = WS_H32 + 64 * MiB;
constexpr size_t WS_MEMB = WS_HB + 32 * MiB;
constexpr size_t WS_WINT = WS_MEMB + 4 * MiB;
constexpr size_t WS_WMKVT = WS_WINT + 22 * MiB;
constexpr size_t WS_WOUTT = WS_WMKVT + 4 * MiB;
constexpr size_t WS_PROJ = WS_WOUTT + 8 * MiB;
constexpr size_t WS_MEMKV = WS_PROJ + 88 * MiB;
constexpr size_t WS_PK = WS_MEMKV + 2 * MiB;
constexpr size_t WS_G = WS_PK + 96 * MiB;
constexpr size_t WS_YLOC = WS_G + 16 * MiB;
constexpr size_t WS_QH = WS_YLOC + 32 * MiB;
constexpr size_t WS_WLOWT = WS_QH + 32 * MiB + 48 * MiB;
constexpr size_t WS_WRT = WS_WLOWT + 1 * MiB;
constexpr size_t WS_Y = WS_WLOWT;
constexpr size_t WS_YCAT = WS_Y + 32 * MiB;
constexpr size_t WS_Z1 = WS_YLOC;
constexpr size_t WS_H1 = WS_YCAT + 64 * MiB;
constexpr size_t WS_LIST = WS_H1 + 64 * MiB;
constexpr size_t WS_LISTW = WS_LIST + 2 * MiB;
constexpr size_t WS_H1B_OLD = WS_LISTW + 2 * MiB;
constexpr size_t WS_HID = WS_PROJ;
constexpr size_t WS_YS = WS_PK;
constexpr size_t WS_VTSB = WS_H1B_OLD + 32 * MiB;
constexpr size_t WS_VTMEM = WS_VTSB + 8 * MiB;
constexpr size_t WS_DBG = WS_VTMEM + 2 * MiB;
constexpr int NCH = 32;
constexpr size_t WS_PCH = WS_DBG + 64 * MiB;
constexpr size_t WS_LCH = WS_PCH + 32 * MiB;
constexpr size_t WS_SST = WS_LCH + 32 * MiB;
constexpr size_t WS_H1B = WS_PCH;
constexpr size_t WS_END = WS_SST + 32 * MiB;
constexpr int CW_CNT = 64;
constexpr int CW_Q = 160;
constexpr int CW_Q2 = 161;
constexpr int CW_DBG = 128;
constexpr int CW_BAR = 4096;

constexpr int LDS_BYTES = 147456;

#define XB_TMO      128
#define XB_XCNT(j)  (256  + 64 * (j))
#define XB_XSUB(j)  (1280 + 64 * (j))
#define XB_XGEN(j)  (2304 + 64 * (j))
#define XB_TOP      3328
#define XB_TOPGEN   3392
#define XCD_BAR_WORDS 3456
#define XB_SPIN_CAP (1u << 18)

__device__ __forceinline__ unsigned xb_ld(unsigned* p)              { return __hip_atomic_load(p, __ATOMIC_RELAXED, __HIP_MEMORY_SCOPE_AGENT); }
__device__ __forceinline__ unsigned xb_add(unsigned* p, unsigned v) { return __hip_atomic_fetch_add(p, v, __ATOMIC_RELAXED, __HIP_MEMORY_SCOPE_AGENT); }
__device__ __forceinline__ unsigned xb_xcc_id() { return (unsigned)__builtin_amdgcn_s_getreg((3 << 11) | 20) & 0xFu; }
#define XB_SPIN(cond, bar) do { unsigned _sp = 0; while (cond) { __builtin_amdgcn_s_sleep(1); \
    if ((++_sp & 255u) == 0u) { if (xb_ld(&(bar)[XB_TMO])) break; if (_sp > XB_SPIN_CAP) { atomicAdd(&(bar)[XB_TMO], 1u); break; } } } } while (0)

struct XcdBarrier { unsigned* bar; unsigned x; volatile LAS unsigned* st; };

__device__ __forceinline__ XcdBarrier xcd_barrier_post(unsigned* bar, volatile LAS unsigned* st) {
    XcdBarrier b; b.bar = bar; b.x = xb_xcc_id(); b.st = st;
    if (threadIdx.x == 0) (void)xb_add(&bar[XB_XCNT(b.x)], 1u);
    return b;
}
__device__ __forceinline__ void xcd_barrier_complete(unsigned* bar, unsigned x, unsigned& nloc, unsigned& nx) {
    const unsigned G = gridDim.x * gridDim.y * gridDim.z;
    unsigned sum, cnt, mine, sp = 0u;
    for (;;) {
        sum = 0u; cnt = 0u; mine = 0u;
#pragma unroll
        for (unsigned j = 0; j < 16; ++j) { const unsigned c = xb_ld(&bar[XB_XCNT(j)]); sum += c; cnt += (c > 0u) ? 1u : 0u; mine = (j == x) ? c : mine; }
        if (sum == G) break;
        __builtin_amdgcn_s_sleep(1);
        if ((++sp & 255u) == 0u) { if (xb_ld(&bar[XB_TMO])) break; if (sp > XB_SPIN_CAP) { atomicAdd(&bar[XB_TMO], 1u); break; } }
    }
    nloc = mine > 0u ? mine : 1u; nx = cnt > 0u ? cnt : 1u;
}
__device__ __forceinline__ void xcd_barrier(const XcdBarrier& b) {
    asm volatile("s_waitcnt vmcnt(0)" ::: "memory");
    __syncthreads();
    if (threadIdx.x == 0) {
        unsigned* bar = b.bar;
        __builtin_amdgcn_s_waitcnt(0);
        unsigned nloc = b.st[0], nx = b.st[1];
        if (nloc == 0u) { xcd_barrier_complete(bar, b.x, nloc, nx); b.st[0] = nloc; b.st[1] = nx; }
        const unsigned old = xb_add(&bar[XB_XSUB(b.x)], 1u);
        const unsigned gen = old / nloc;
        if (old + 1u == (gen + 1u) * nloc) {
            __builtin_amdgcn_fence(__ATOMIC_RELEASE, "agent");
            asm volatile("s_waitcnt vmcnt(0)" ::: "memory");
            const unsigned og = xb_add(&bar[XB_TOP], 1u);
            const unsigned tg = og / nx;
            if (og + 1u == (tg + 1u) * nx) xb_add(&bar[XB_TOPGEN], 1u);
            else XB_SPIN(xb_ld(&bar[XB_TOPGEN]) == tg, bar);
            __builtin_amdgcn_fence(__ATOMIC_ACQUIRE, "agent");
            xb_add(&bar[XB_XGEN(b.x)], 1u);
            asm volatile("s_waitcnt vmcnt(0)" ::: "memory");
        } else {
            XB_SPIN(xb_ld(&bar[XB_XGEN(b.x)]) == gen, bar);
            __builtin_amdgcn_fence(__ATOMIC_ACQUIRE, "agent");
            asm volatile("s_waitcnt vmcnt(0)" ::: "memory");
        }
    }
    __syncthreads();
}

__device__ __forceinline__ float wave_sum(float v) {
#pragma unroll
    for (int o = 1; o < 64; o <<= 1) v += __shfl_xor(v, o);
    return v;
}
__device__ __forceinline__ float wave_max(float v) {
#pragma unroll
    for (int o = 1; o < 64; o <<= 1) v = fmaxf(v, __shfl_xor(v, o));
    return v;
}
__device__ __forceinline__ float softplusf(float x) { return fmaxf(x, 0.f) + log1pf(expf(-fabsf(x))); }
__device__ __forceinline__ float sigmoidf(float x) { return 1.f / (1.f + expf(-x)); }
__device__ __forceinline__ float fsigmoid(float x) { return __builtin_amdgcn_rcpf(1.f + __expf(-x)); }
__device__ __forceinline__ float fsoftplus(float x) { return fmaxf(x, 0.f) + __logf(1.f + __expf(-fabsf(x))); }
__device__ __forceinline__ float ftanh(float x) { const float e = __expf(-2.f * fabsf(x)); const float t = (1.f - e) * __builtin_amdgcn_rcpf(1.f + e); return x < 0.f ? -t : t; }
__device__ __forceinline__ void wave_lds_sync() { asm volatile("s_waitcnt lgkmcnt(0)" ::: "memory"); __builtin_amdgcn_wave_barrier(); }

__device__ __forceinline__ unsigned f2bf(float f) { unsigned u = __builtin_bit_cast(unsigned, f); return (u + 0x7fffu + ((u >> 16) & 1u)) >> 16; }
__device__ __forceinline__ unsigned pk2(float lo, float hi) { return f2bf(lo) | (f2bf(hi) << 16); }
__device__ __forceinline__ float bf2f(bf16_t b) { return __builtin_bit_cast(float, (unsigned)b << 16); }
__device__ __forceinline__ float bflo(unsigned w) { return __builtin_bit_cast(float, w << 16); }
__device__ __forceinline__ float bfhi(unsigned w) { return __builtin_bit_cast(float, w & 0xffff0000u); }
#define LDS_WAIT() asm volatile("s_waitcnt lgkmcnt(0)" ::: "memory")

namespace pg8 {
#define PG8_LAS __attribute__((address_space(3)))
typedef unsigned short bf16_t;
typedef short bf16x8 __attribute__((ext_vector_type(8)));
typedef float f32x4 __attribute__((ext_vector_type(4)));
typedef unsigned u32x4 __attribute__((ext_vector_type(4)));
constexpr int BM = 256, BK = 64, HALF = 128, HTB = HALF * BK * 2  , STAGE_BYTES = 8 * HTB, NXCD = 8, WGM = 8;

__host__ __device__ __forceinline__ int lds_byte(int r, int c) { const int st = (r >> 4) * 2 + (c >> 5), rr = r & 15, cc = c & 31, ob = rr * 64 + cc * 2; return st * 1024 + (ob ^ (((ob >> 9) & 1) << 5)); }
__host__ __device__ __forceinline__ void stage_rc(int b, int& R, int& C) { const int st = b / 1024, sb = b % 1024, swz = sb ^ (((sb >> 9) & 1) << 5); R = (st >> 1) * 16 + swz / 64; C = (st & 1) * 32 + (swz % 64) / 2; }
__host__ __device__ __forceinline__ int perm32(int rho) { const int n = rho >> 4, i = rho & 15; return 8 * (i >> 2) + 4 * n + (i & 3); }

struct Unit { int pm, pn; };
struct Gemm { const bf16_t* A; const bf16_t* Bt; int M, N, K; };

struct StaticOrder {
    int nM, nN, nwg, G, c;
    __host__ __device__ void init(int M, int N, int G_, int c_) { nM = M / BM; nN = N / BM; nwg = nM * nN; G = G_; c = c_; }
    __host__ __device__ bool next(int i, Unit& u) const {
        const long L = (long)i * G + c; if (L >= nwg) return false;
        int wgid = (int)L; { const int q = nwg / NXCD, r = nwg % NXCD, xcd = wgid % NXCD, off = wgid / NXCD; wgid = (xcd < r ? xcd * (q + 1) : r * (q + 1) + (xcd - r) * q) + off; }
        const int nig = WGM * nN, gid = wgid / nig, fm = gid * WGM, gsz = (nM - fm) < WGM ? (nM - fm) : WGM;
        u.pm = fm + ((wgid % nig) % gsz); u.pn = (wgid % nig) / gsz; return true;
    }
    __device__ __forceinline__ void a_ready(const Unit&) const {}
    __device__ __forceinline__ void done(const Unit&) const {}
};
typedef __bf16 bf16x2_t __attribute__((ext_vector_type(2))); typedef float cvt_f32x2 __attribute__((ext_vector_type(2)));
__device__ __forceinline__ unsigned cvt_pk_bf16(float lo, float hi) { const cvt_f32x2 v = {lo, hi}; return __builtin_bit_cast(unsigned, __builtin_convertvector(v, bf16x2_t)); }


template <class Epi, class Sched, bool STAMP = false>
__device__ __forceinline__ void gemm_phase(PG8_LAS unsigned char* lds, const Gemm g, const Sched& S, const Epi& E, unsigned long long* stamps) {
    const int tid = threadIdx.x, wid = __builtin_amdgcn_readfirstlane(tid >> 6), lane = tid & 63, wr = wid >> 2, wc = wid & 3, fr = lane & 15, fq = lane >> 4;
    const int K = g.K, nt = K / BK;
    int ts_lo = 0, ts_hi = 0, nts = 0; const unsigned long long rt_entry = STAMP ? (unsigned long long)wall_clock64() : 0ull;
#define PG8_STAMP() do { if (STAMP && wid == 0 && nts < 64) { const unsigned long long _c = (unsigned long long)clock64(); \
        ts_lo = (lane == nts) ? (int)(unsigned)_c : ts_lo; ts_hi = (lane == nts) ? (int)(unsigned)(_c >> 32) : ts_hi; ++nts; } } while (0)
    PG8_STAMP();
    unsigned voffA[2], voffB[2];
#pragma unroll
    for (int i = 0; i < 2; ++i) { int R, C; stage_rc(tid * 16 + i * 8192, R, C); const int Rb = Epi::PERM ? ((R & ~31) + perm32(R & 31)) : R;
        voffA[i] = (unsigned)(R * K + C) * 2u; voffB[i] = (unsigned)(Rb * K + C) * 2u; }
    const size_t kstep = (size_t)(BK * 2);
    const size_t hstep = (size_t)HALF * K * 2;
    const size_t tstep = 2 * hstep;
    const unsigned ldsw = (unsigned)wid * 1024u;
    const int aoff = lds_byte(wr * 64 + fr, fq * 8), boff = lds_byte(wc * 32 + fr, fq * 8);
#define PG8_SA(b, h) (((b) * 2 + (h)) * HTB)
#define PG8_SB(b, h) ((4 + (b) * 2 + (h)) * HTB)
#define PG8_STAGE(bufoff, gbase, voff) do { _Pragma("unroll") for (int _i = 0; _i < 2; ++_i) \
        __builtin_amdgcn_global_load_lds((const unsigned*)((const char*)(gbase) + (voff)[_i]), (PG8_LAS unsigned*)(lds + (bufoff) + ldsw + _i * 8192), 16, 0, 0); } while (0)
#define PG8_LDA(dst, b, h) do { _Pragma("unroll") for (int m = 0; m < 4; ++m) _Pragma("unroll") for (int k = 0; k < 2; ++k) dst[m][k] = *(const PG8_LAS bf16x8*)(lds + PG8_SA(b, h) + aoff + m * 2048 + k * 1024); } while (0)
#define PG8_LDB(dst, b, h) do { _Pragma("unroll") for (int n = 0; n < 2; ++n) _Pragma("unroll") for (int k = 0; k < 2; ++k) dst[n][k] = *(const PG8_LAS bf16x8*)(lds + PG8_SB(b, h) + boff + n * 2048 + k * 1024); } while (0)
#define PG8_MMA(ai, bj, At, Bt) do { __builtin_amdgcn_s_setprio(1); _Pragma("unroll") for (int m = 0; m < 4; ++m) _Pragma("unroll") for (int n = 0; n < 2; ++n) _Pragma("unroll") for (int k = 0; k < 2; ++k) \
        acc[ai][bj][m][n] = __builtin_amdgcn_mfma_f32_16x16x32_bf16(Bt[n][k], At[m][k], acc[ai][bj][m][n], 0, 0, 0); __builtin_amdgcn_s_setprio(0); } while (0)
#define PG8_WAIT_V(n) asm volatile("s_waitcnt vmcnt(" #n ")" ::: "memory")
#define PG8_WAIT_L(n) asm volatile("s_waitcnt lgkmcnt(" #n ")" ::: "memory")
#define PG8_BAR __builtin_amdgcn_s_barrier()
#define PG8_SCHED __builtin_amdgcn_sched_barrier(0)
    Unit cur, nxt; int ui = 0;
    if (!S.next(0, cur)) return;
    f32x4 acc[2][2][4][2];
#pragma unroll
    for (int a = 0; a < 2; ++a)
#pragma unroll
        for (int b = 0; b < 2; ++b)
#pragma unroll
            for (int m = 0; m < 4; ++m)
#pragma unroll
                for (int n = 0; n < 2; ++n) acc[a][b][m][n] = (f32x4){0.f, 0.f, 0.f, 0.f};
    bf16x8 At[4][2], B0[2][2], B1[2][2];
    const char* cA = (const char*)g.A + (size_t)cur.pm * tstep; const char* cB = (const char*)g.Bt + (size_t)cur.pn * tstep;
    S.a_ready(cur);
    PG8_STAGE(PG8_SB(0, 0), cB, voffB); PG8_STAGE(PG8_SA(0, 0), cA, voffA); PG8_STAGE(PG8_SB(0, 1), cB + hstep, voffB); PG8_STAGE(PG8_SA(0, 1), cA + hstep, voffA);
    if (wr == 1) PG8_BAR;
    PG8_WAIT_V(4); PG8_BAR;
    PG8_STAGE(PG8_SB(1, 0), cB + kstep, voffB); PG8_STAGE(PG8_SA(1, 0), cA + kstep, voffA); PG8_STAGE(PG8_SB(1, 1), cB + hstep + kstep, voffB);
    PG8_WAIT_V(6); PG8_BAR;
    PG8_STAMP();
    for (;;) {
        const bool has_next = S.next(ui + 1, nxt);
        const char* nA = has_next ? (const char*)g.A + (size_t)nxt.pm * tstep : cA; const char* nB = has_next ? (const char*)g.Bt + (size_t)nxt.pn * tstep : cB;
        for (int t = 0; t < nt; t += 2) {
            const bool last = (t == nt - 2);
            const char* a1 = cA + (size_t)(t + 1) * kstep;
            const char* a2 = last ? nA : cA + (size_t)(t + 2) * kstep; const char* b2 = last ? nB : cB + (size_t)(t + 2) * kstep;
            const char* a3 = a2 + kstep; const char* b3 = b2 + kstep;
            if (last && has_next) S.a_ready(nxt);
            PG8_LDB(B0, 0, 0); PG8_SCHED; PG8_LDA(At, 0, 0); PG8_STAGE(PG8_SA(1, 1), a1 + hstep, voffA);
            PG8_WAIT_L(8); PG8_BAR; PG8_WAIT_L(0); PG8_MMA(0, 0, At, B0); PG8_BAR; PG8_SCHED;
            PG8_LDB(B1, 0, 1); PG8_STAGE(PG8_SB(0, 0), b2, voffB);
            PG8_BAR; PG8_WAIT_L(0); PG8_MMA(0, 1, At, B1); PG8_BAR;
            PG8_LDA(At, 0, 1); PG8_STAGE(PG8_SA(0, 0), a2, voffA);
            PG8_BAR; PG8_WAIT_L(0); PG8_MMA(1, 0, At, B0); PG8_BAR; PG8_SCHED;
            PG8_STAGE(PG8_SB(0, 1), b2 + hstep, voffB);
            PG8_WAIT_V(6); PG8_BAR; PG8_MMA(1, 1, At, B1); PG8_BAR;
            PG8_LDB(B0, 1, 0); PG8_SCHED; PG8_LDA(At, 1, 0); PG8_STAGE(PG8_SA(0, 1), a2 + hstep, voffA);
            PG8_WAIT_L(8); PG8_BAR; PG8_WAIT_L(0); PG8_MMA(0, 0, At, B0); PG8_BAR; PG8_SCHED;
            PG8_LDB(B1, 1, 1); PG8_STAGE(PG8_SB(1, 0), b3, voffB);
            PG8_BAR; PG8_WAIT_L(0); PG8_MMA(0, 1, At, B1); PG8_BAR;
            PG8_LDA(At, 1, 1); PG8_STAGE(PG8_SA(1, 0), a3, voffA);
            PG8_BAR; PG8_WAIT_L(0); PG8_MMA(1, 0, At, B0); PG8_BAR; PG8_SCHED;
            PG8_STAGE(PG8_SB(1, 1), b3 + hstep, voffB);
            PG8_WAIT_V(6); PG8_BAR; PG8_MMA(1, 1, At, B1); PG8_BAR;
        }
        PG8_STAMP();
        if constexpr (!Epi::AFTER_DRAIN) { E(acc, cur, wr, wc, fr, fq); S.done(cur); }
        PG8_STAMP();
        if (!has_next) break;
#pragma unroll
        for (int a = 0; a < 2; ++a)
#pragma unroll
            for (int b = 0; b < 2; ++b)
#pragma unroll
                for (int m = 0; m < 4; ++m)
#pragma unroll
                    for (int n = 0; n < 2; ++n) acc[a][b][m][n] = (f32x4){0.f, 0.f, 0.f, 0.f};
        cur = nxt; cA = nA; cB = nB; ++ui;
    }
    PG8_WAIT_V(0);
    if (wr == 0) PG8_BAR;
    PG8_BAR;
    if constexpr (Epi::AFTER_DRAIN) { E.fused(acc, cur, wr, wc, fr, fq, lds, wid, lane); S.done(cur); }
    PG8_STAMP();
    if (STAMP && wid == 0) { stamps[lane] = lane < nts ? (((unsigned long long)(unsigned)ts_hi << 32) | (unsigned)ts_lo) : 0ull;
        if (lane == 62) stamps[62] = rt_entry; if (lane == 63) stamps[63] = (unsigned long long)wall_clock64(); }
#undef PG8_STAMP
#undef PG8_SA
#undef PG8_SB
#undef PG8_STAGE
#undef PG8_LDA
#undef PG8_LDB
#undef PG8_MMA
#undef PG8_WAIT_V
#undef PG8_WAIT_L
#undef PG8_BAR
#undef PG8_SCHED
}
}


struct Args { const float* in[29]; float* out; unsigned char* ws; int ph_lo, ph_hi; };
struct Frame {
    LAS unsigned char* lds;
    int tid, lane, wave, bid, G;
    unsigned* ctl;
    const Args* a;
    float* out;
    unsigned char* ws;
};
enum { I_X = 0, I_MEM, I_LNIN_G, I_LNIN_B, I_WIN, I_MU, I_W0, I_WDEC, I_A0, I_WA, I_WG, I_KK, I_KA, I_RK, I_LNXG, I_LNXB, I_WMEMKV, I_WOUT, I_LN1G, I_LN1B,
       I_RG, I_RGB, I_RE, I_REB, I_WEG, I_WEU, I_WED, I_LN2G, I_LN2B };

template <class AF, class EF>
__device__ __forceinline__ void gemm_naive(Frame& F, int M, int N, int K, const AF arow, const float* B, int ldb, const EF epi, int tile_base) {
    LAS float* As = (LAS float*)F.lds;
    LAS float* Bs = As + 16 * 132;
    const int tid = F.tid;
    const int tm = (M + 127) / 128, tn = (N + 63) / 64, nt = tm * tn;
    const int ty = tid >> 4, tx = tid & 15;
    const int lr = tid >> 2, lk = (tid & 3) * 4;
    const int bk = (tid >> 4) & 15, bc = (tid & 15) * 4;
    for (int lt = 0; lt < nt; ++lt) {
        if ((tile_base + lt) % F.G != F.bid) continue;
        const int m0 = (lt / tn) * 128, n0 = (lt % tn) * 64;
        const float* ap = (m0 + lr < M) ? arow(m0 + lr) : nullptr;
        const bool bok = (tid < 256) && (n0 + bc < N);
        float acc[4][4];
#pragma unroll
        for (int i = 0; i < 4; ++i)
#pragma unroll
            for (int j = 0; j < 4; ++j) acc[i][j] = 0.f;
        for (int k0 = 0; k0 < K; k0 += 16) {
            f32x4 av = (f32x4){0.f, 0.f, 0.f, 0.f}, bv = (f32x4){0.f, 0.f, 0.f, 0.f};
            if (ap) av = *(const f32x4*)(ap + k0 + lk);
            if (bok) bv = *(const f32x4*)(B + (size_t)(k0 + bk) * ldb + n0 + bc);
            __syncthreads();
            As[(lk + 0) * 132 + lr] = av.x; As[(lk + 1) * 132 + lr] = av.y; As[(lk + 2) * 132 + lr] = av.z; As[(lk + 3) * 132 + lr] = av.w;
            if (tid < 256) *(LAS f32x4*)(Bs + bk * 64 + bc) = bv;
            __syncthreads();
#pragma unroll
            for (int k = 0; k < 16; ++k) {
                const f32x4 a = *(const LAS f32x4*)(As + k * 132 + ty * 4);
                const f32x4 b = *(const LAS f32x4*)(Bs + k * 64 + tx * 4);
#pragma unroll
                for (int i = 0; i < 4; ++i)
#pragma unroll
                    for (int j = 0; j < 4; ++j) acc[i][j] += a[i] * b[j];
            }
        }
#pragma unroll
        for (int i = 0; i < 4; ++i) {
            const int r = m0 + ty * 4 + i, c = n0 + tx * 4;
            if (r < M && c < N) epi(r, c, (f32x4){acc[i][0], acc[i][1], acc[i][2], acc[i][3]});
        }
    }
    __syncthreads();
}
struct ARowPlain { const float* A; int lda; __device__ __forceinline__ const float* operator()(int r) const { return A + (size_t)r * lda; } };
struct ARowList { const float* A; int lda; const int* list; __device__ __forceinline__ const float* operator()(int r) const { return A + (size_t)(list[r] >> 1) * lda; } };
struct ARowOff { const float* A; int lda; __device__ __forceinline__ const float* operator()(int r) const { return A + (size_t)r * lda; } };
struct EpiStore { float* Cm; int ldc; __device__ __forceinline__ void operator()(int r, int c, f32x4 v) const { *(f32x4*)(Cm + (size_t)r * ldc + c) = v; } };
struct EpiResid { float* Cm; const float* R; int ldc; float alpha; __device__ __forceinline__ void operator()(int r, int c, f32x4 v) const {
    const f32x4 h = *(const f32x4*)(R + (size_t)r * ldc + c); *(f32x4*)(Cm + (size_t)r * ldc + c) = h * alpha + v; } };
struct EpiSilu { float* Hd; const float* Gt; int ldc; __device__ __forceinline__ void operator()(int r, int c, f32x4 u) const {
    const f32x4 g = *(const f32x4*)(Gt + (size_t)r * ldc + c); f32x4 o;
#pragma unroll
    for (int i = 0; i < 4; ++i) o[i] = g[i] / (1.f + expf(-g[i])) * u[i];
    *(f32x4*)(Hd + (size_t)r * ldc + c) = o; } };
struct EpiScatter { float* YS; const int* list; const float* lw; __device__ __forceinline__ void operator()(int r, int c, f32x4 v) const {
    const int e = list[r]; const float w = lw[r]; *(f32x4*)(YS + (size_t)e * D + c) = v * w; } };

template <bool STORE = true>
__device__ __forceinline__ void ln_core(f32x4 (&v)[8], const float* g, const float* b, float* out, int lane) {
    float s = 0.f;
#pragma unroll
    for (int j = 0; j < 8; ++j) s += (v[j].x + v[j].y) + (v[j].z + v[j].w);
    const float mean = wave_sum(s) * (1.f / D);
    float s2 = 0.f;
#pragma unroll
    for (int j = 0; j < 8; ++j) { v[j] = v[j] - mean; s2 += (v[j].x * v[j].x + v[j].y * v[j].y) + (v[j].z * v[j].z + v[j].w * v[j].w); }
    const float rstd = 1.f / sqrtf(wave_sum(s2) * (1.f / D) + LN_EPS);
#pragma unroll
    for (int j = 0; j < 8; ++j) {
        const f32x4 gg = ((const f32x4*)g)[lane + 64 * j], bb = ((const f32x4*)b)[lane + 64 * j];
        v[j] = v[j] * rstd * gg + bb;
        if (STORE) __builtin_nontemporal_store(v[j], (f32x4*)out + lane + 64 * j);
    }
}

__device__ __forceinline__ void p0_transpose_item(const float* W, int K, int N, bf16_t* WT, LAS float* scr, int item, int lane) {
    const int nblk = N / 32, kb = item / nblk, nb = item % nblk, k0 = 64 * kb, n0 = 32 * nb;
#pragma unroll 8
    for (int i = 0; i < 32; ++i) { const int kk = 2 * i + (lane >> 5); scr[kk * 33 + (lane & 31)] = __builtin_nontemporal_load(W + (size_t)(k0 + kk) * N + n0 + (lane & 31)); }
    LDS_WAIT(); asm volatile("" ::: "memory");
    const int c = lane & 7;
#pragma unroll
    for (int j = 0; j < 4; ++j) { const int n = (lane >> 3) + 8 * j; const LAS float* sp = scr + (8 * c) * 33 + n;
        v4u o; o.x = pk2(sp[0 * 33], sp[1 * 33]); o.y = pk2(sp[2 * 33], sp[3 * 33]); o.z = pk2(sp[4 * 33], sp[5 * 33]); o.w = pk2(sp[6 * 33], sp[7 * 33]);
        *(v4u*)(WT + (size_t)(n0 + n) * K + k0 + 8 * c) = o; }
    LDS_WAIT(); asm volatile("" ::: "memory");
}
__device__ __forceinline__ void ph_prologue(Frame& F) {
    bf16_t* HB = (bf16_t*)(F.ws + WS_HB);
    bf16_t* MEMB = (bf16_t*)(F.ws + WS_MEMB);
    bf16_t* WINT = (bf16_t*)(F.ws + WS_WINT);
    bf16_t* WMKVT = (bf16_t*)(F.ws + WS_WMKVT);
    const int gw = F.bid * NWAVES + F.wave, NGW = F.G * NWAVES;
    LAS float* scr = (LAS float*)(F.lds + F.wave * 16384);
    constexpr int I_IN = (D / 64) * (IN_COLS / 32), I_MKV = (D / 64) * (2 * MEMW / 32);
    for (int it = gw; it < I_IN + I_MKV; it += NGW) {
        int r = it;
        if (r < I_IN) { p0_transpose_item(F.a->in[I_WIN], D, IN_COLS, WINT, scr, r, F.lane); continue; } r -= I_IN;
        p0_transpose_item(F.a->in[I_WMEMKV], D, 2 * MEMW, WMKVT, scr, r, F.lane);
    }
    { bf16_t* WL = (bf16_t*)(F.ws + WS_WLOWT);
      for (int i = F.bid * NT + F.tid; i < C * (LOWR / 8); i += F.G * NT) { const int c = i % C, kc = i / C, k0 = kc * 8;
          const float* src; int kk0;
          if (k0 < DR) { src = F.a->in[I_WDEC]; kk0 = k0; } else if (k0 < DR + AR) { src = F.a->in[I_WA]; kk0 = k0 - DR; } else { src = F.a->in[I_WG]; kk0 = k0 - DR - AR; }
          v4u o; o.x = pk2(src[(size_t)(kk0 + 0) * C + c], src[(size_t)(kk0 + 1) * C + c]); o.y = pk2(src[(size_t)(kk0 + 2) * C + c], src[(size_t)(kk0 + 3) * C + c]);
          o.z = pk2(src[(size_t)(kk0 + 4) * C + c], src[(size_t)(kk0 + 5) * C + c]); o.w = pk2(src[(size_t)(kk0 + 6) * C + c], src[(size_t)(kk0 + 7) * C + c]);
          *(v4u*)(WL + (size_t)c * LOWR + k0) = o; } }
    { bf16_t* WR = (bf16_t*)(F.ws + WS_WRT);
      for (int i = F.bid * NT + F.tid; i < 80 * D; i += F.G * NT) { const int k = i % D, col = i / D;
          const float w = col < NG ? F.a->in[I_RG][(size_t)k * NG + col] : (col < NG + NE ? F.a->in[I_RE][(size_t)k * NE + (col - NG)] : 0.f);
          const unsigned hi = f2bf(w); const float rem = w - __builtin_bit_cast(float, hi << 16);
          const size_t fo = ((size_t)((k >> 5) * 5 + (col >> 4)) * 64 + (col & 15) + 16 * ((k >> 3) & 3)) * 8 + (k & 7);
          WR[fo] = (bf16_t)hi; WR[(size_t)80 * D + fo] = (bf16_t)f2bf(rem); } }
    for (size_t i = (size_t)F.bid * NT + F.tid; i < (size_t)(PLD - IN_COLS) * D / 8; i += (size_t)F.G * NT) ((v4u*)(WINT + (size_t)IN_COLS * D))[i] = (v4u){0u, 0u, 0u, 0u};
    for (size_t i = (size_t)F.bid * NT + F.tid; i < (size_t)BATCH * MEML * D / 4; i += (size_t)F.G * NT) {
        const f32x4 v = ((const f32x4*)F.a->in[I_MEM])[i]; ((v2u*)MEMB)[i] = (v2u){pk2(v.x, v.y), pk2(v.z, v.w)}; }
    f32x4 xn[8];
    { const f32x4* xr = (const f32x4*)(F.a->in[I_X] + (size_t)(gw < T ? gw : T - 1) * D);
#pragma unroll
      for (int j = 0; j < 8; ++j) xn[j] = __builtin_nontemporal_load(xr + F.lane + 64 * j); }
    for (int row = gw; row < T; row += NGW) {
        f32x4 v[8];
#pragma unroll
        for (int j = 0; j < 8; ++j) v[j] = xn[j];
        { const f32x4* xr = (const f32x4*)(F.a->in[I_X] + (size_t)(row + NGW < T ? row + NGW : row) * D);
#pragma unroll
          for (int j = 0; j < 8; ++j) xn[j] = __builtin_nontemporal_load(xr + F.lane + 64 * j); }
        ln_core<false>(v, F.a->in[I_LNIN_G], F.a->in[I_LNIN_B], nullptr, F.lane);
#pragma unroll
        for (int j = 0; j < 8; ++j) ((v2u*)(HB + (size_t)row * D))[F.lane + 64 * j] = (v2u){pk2(v[j].x, v[j].y), pk2(v[j].z, v[j].w)};
    }
    __syncthreads();
}
struct ProjOrder {
    int G, c;
    __device__ __forceinline__ bool next(int i, pg8::Unit& u) const {
        constexpr int nM = T / 256, nN = PLD / 256, nwg = nM * nN;
        const int L = i * G + c;
        if (L >= nwg + 16) return false;
        if (L >= nwg) { const int j = L - nwg; u.pm = nM + (j >> 2); u.pn = nN + (j & 3); return true; }
        int wgid = L; { const int q = nwg / pg8::NXCD, r = nwg % pg8::NXCD, xcd = wgid % pg8::NXCD, off = wgid / pg8::NXCD; wgid = (xcd < r ? xcd * (q + 1) : r * (q + 1) + (xcd - r) * q) + off; }
        const int nig = pg8::WGM * nN, gid = wgid / nig, fm = gid * pg8::WGM, gsz = (nM - fm) < pg8::WGM ? (nM - fm) : pg8::WGM;
        u.pm = fm + ((wgid % nig) % gsz); u.pn = (wgid % nig) / gsz; return true;
    }
    __device__ __forceinline__ void a_ready(const pg8::Unit&) const {}
    __device__ __forceinline__ void done(const pg8::Unit&) const {}
};
struct EpiProj {
    static constexpr bool PERM = true, AFTER_DRAIN = false;
    bf16_t* P; bf16_t* MKV;
    __device__ __forceinline__ void operator()(const pg8::f32x4 (&acc)[2][2][4][2], const pg8::Unit& u, int wr, int wc, int fr, int fq) const {
        bf16_t* base; int ldc, row0, col0;
        if (u.pm < T / 256) { base = P; ldc = PLD; row0 = u.pm * 256 + wr * 64 + fr; col0 = u.pn * 256 + wc * 32 + 8 * fq; }
        else { base = MKV; ldc = 2 * MEMW; row0 = (u.pm - T / 256) * 256 + wr * 64 + fr; col0 = (u.pn - PLD / 256) * 256 + wc * 32 + 8 * fq; }
#pragma unroll
        for (int ai = 0; ai < 2; ++ai)
#pragma unroll
            for (int m = 0; m < 4; ++m) { bf16_t* rowp = base + (size_t)(row0 + ai * 128 + m * 16) * ldc + col0;
#pragma unroll
                for (int bj = 0; bj < 2; ++bj) { const pg8::f32x4 v0 = acc[ai][bj][m][0], v1 = acc[ai][bj][m][1];
                    v4u w; w.x = pg8::cvt_pk_bf16(v0[0], v0[1]); w.y = pg8::cvt_pk_bf16(v0[2], v0[3]); w.z = pg8::cvt_pk_bf16(v1[0], v1[1]); w.w = pg8::cvt_pk_bf16(v1[2], v1[3]);
                    *(v4u*)(rowp + bj * 128) = w; } }
    }
};
__device__ __forceinline__ void ph_proj(Frame& F) {
    pg8::Gemm g{(const bf16_t*)(F.ws + WS_HB), (const bf16_t*)(F.ws + WS_WINT), T + BATCH * MEML, PLD + 2 * MEMW, D};
    ProjOrder S{F.G, F.bid};
    EpiProj E{(bf16_t*)(F.ws + WS_PROJ), (bf16_t*)(F.ws + WS_MEMKV)};
    pg8::gemm_phase<EpiProj, ProjOrder, false>(F.lds, g, S, E, nullptr);
    __syncthreads();
    { constexpr int I_OUT = (D / 64) * (D / 32);
      bf16_t* WOUTT = (bf16_t*)(F.ws + WS_WOUTT);
      LAS float* scr = (LAS float*)(F.lds + F.wave * 16384);
      volatile LAS int* qslot = (volatile LAS int*)(F.lds + 139264);
      for (;;) {
          if (F.tid == 0) *qslot = (int)atomicAdd(F.ctl + CW_Q2, 2u * NWAVES);
          __syncthreads();
          const int base = *qslot;
          __syncthreads();
          if (base >= I_OUT) break;
#pragma unroll 1
          for (int q = 0; q < 2; ++q) { const int itq = base + 2 * F.wave + q; if (itq < I_OUT) p0_transpose_item(F.a->in[I_WOUT], D, D, WOUTT, scr, itq, F.lane); }
      } }
    __syncthreads();
}
__device__ __forceinline__ void ph_rwkv_prep(Frame& F) {
    using pg8::bf16x8;
    typedef float f4 __attribute__((ext_vector_type(4)));
    constexpr int AS = 296;
    constexpr int KSL = 1040;
    const bf16_t* P = (const bf16_t*)(F.ws + WS_PROJ);
    const bf16_t* WL = (const bf16_t*)(F.ws + WS_WLOWT);
    bf16_t* PK = (bf16_t*)(F.ws + WS_PK);
    bf16_t* GB = (bf16_t*)(F.ws + WS_G);
    const float* mu = F.a->in[I_MU];
    LAS bf16_t* act = (LAS bf16_t*)F.lds;
    LAS bf16_t* ksl = (LAS bf16_t*)(F.lds + 20480);
    LAS float* par = (LAS float*)(F.lds + 20480 + 66560);
    const int tid = F.tid, lane = F.lane, wave = F.wave, fr = lane & 15, fq = lane >> 4;
    for (int item = F.bid; item < T / 32; item += F.G) {
        const int t0 = item * 32;
        __syncthreads();
        { const int q = tid >> 8, e = (tid & 255) * 4;
          *(LAS f32x4*)(par + q * 1024 + e) = *(const f32x4*)((q ? F.a->in[I_A0] : F.a->in[I_W0]) + e);
          *(LAS f32x4*)(par + (2 + q) * 1024 + e) = *(const f32x4*)((q ? F.a->in[I_KA] : F.a->in[I_KK]) + e); }
        { v4u cu[3], pv[3]; f32x4 m0[3], m1[3];
#pragma unroll
          for (int i = 0; i < 3; ++i) { int idx = tid + NT * i; idx = idx < 32 * 36 ? idx : 32 * 36 - 1;
              const int tt = idx / 36, ch = idx % 36, t = t0 + tt, col = COL_DL + 8 * ch;
              const bf16_t* pc = P + (size_t)t * PLD + col;
              cu[i] = *(const v4u*)pc; pv[i] = *(const v4u*)((t % SEQ) ? pc - PLD : pc);
              m0[i] = *(const f32x4*)(mu + col); m1[i] = *(const f32x4*)(mu + col + 4); }
#pragma unroll
          for (int i = 0; i < 3; ++i) { const int idx = tid + NT * i, tt = idx / 36, ch = idx % 36, t = t0 + tt;
              const bool hp = (t % SEQ) != 0;
              const float c[8] = {bflo(cu[i].x), bfhi(cu[i].x), bflo(cu[i].y), bfhi(cu[i].y), bflo(cu[i].z), bfhi(cu[i].z), bflo(cu[i].w), bfhi(cu[i].w)};
              const float q[8] = {bflo(pv[i].x), bfhi(pv[i].x), bflo(pv[i].y), bfhi(pv[i].y), bflo(pv[i].z), bfhi(pv[i].z), bflo(pv[i].w), bfhi(pv[i].w)};
              const float mm[8] = {m0[i].x, m0[i].y, m0[i].z, m0[i].w, m1[i].x, m1[i].y, m1[i].z, m1[i].w};
              float a[8];
#pragma unroll
              for (int e = 0; e < 8; ++e) { const float xs = c[e] + ((hp ? q[e] : 0.f) - c[e]) * mm[e];
                  a[e] = ch < DR / 8 ? ftanh(xs) : (ch < (DR + AR) / 8 ? xs : fsigmoid(xs)); }
              if (idx < 32 * 36) *(LAS v4u*)(act + tt * AS + 8 * ch) = (v4u){pg8::cvt_pk_bf16(a[0], a[1]), pg8::cvt_pk_bf16(a[2], a[3]), pg8::cvt_pk_bf16(a[4], a[5]), pg8::cvt_pk_bf16(a[6], a[7])}; } }
#pragma unroll 1
        for (int i0 = 0; i0 < 24; i0 += 4) {
            v4u cu[4], pv[4]; f32x4 m0[4], m1[4];
#pragma unroll
            for (int i = 0; i < 4; ++i) { const int idx = tid + NT * (i0 + i), tt = idx / 384, col = 8 * (idx % 384), t = t0 + tt;
                const bf16_t* pc = P + (size_t)t * PLD + col;
                cu[i] = *(const v4u*)pc; pv[i] = *(const v4u*)((t % SEQ) ? pc - PLD : pc);
                m0[i] = *(const f32x4*)(mu + col); m1[i] = *(const f32x4*)(mu + col + 4); }
#pragma unroll
            for (int i = 0; i < 4; ++i) { const int idx = tid + NT * (i0 + i), tt = idx / 384, col = 8 * (idx % 384), t = t0 + tt, b = t / SEQ, tl = t % SEQ;
                const bool hp = tl != 0;
                const float c[8] = {bflo(cu[i].x), bfhi(cu[i].x), bflo(cu[i].y), bfhi(cu[i].y), bflo(cu[i].z), bfhi(cu[i].z), bflo(cu[i].w), bfhi(cu[i].w)};
                const float q[8] = {bflo(pv[i].x), bfhi(pv[i].x), bflo(pv[i].y), bfhi(pv[i].y), bflo(pv[i].z), bfhi(pv[i].z), bflo(pv[i].w), bfhi(pv[i].w)};
                const float mm[8] = {m0[i].x, m0[i].y, m0[i].z, m0[i].w, m1[i].x, m1[i].y, m1[i].z, m1[i].w};
                float o[8];
#pragma unroll
                for (int e = 0; e < 8; ++e) o[e] = c[e] + ((hp ? q[e] : 0.f) - c[e]) * mm[e];
                const v4u w = (v4u){pg8::cvt_pk_bf16(o[0], o[1]), pg8::cvt_pk_bf16(o[2], o[3]), pg8::cvt_pk_bf16(o[4], o[5]), pg8::cvt_pk_bf16(o[6], o[7])};
                const int reg = col >> 10, ch = col & 1023;
                if (reg == 1) *(LAS v4u*)(ksl + tt * KSL + ch) = w;
                else *(v4u*)(PK + ((size_t)(b * NH + (ch >> 6)) * SEQ + tl) * 384 + (reg ? 320 : 0) + (ch & 63)) = w; }
        }
        __syncthreads();
#pragma unroll 1
        for (int hd = 0; hd < 2; ++hd) {
            const int h = 2 * wave + hd;
            f4 ad[2][4], aa[2][4], ag[2][4];
#pragma unroll
            for (int m = 0; m < 2; ++m)
#pragma unroll
                for (int n = 0; n < 4; ++n) { ad[m][n] = (f4){0.f, 0.f, 0.f, 0.f}; aa[m][n] = ad[m][n]; ag[m][n] = ad[m][n]; }
            const LAS bf16_t* arow = act + fr * AS + 8 * fq;
            const bf16_t* wrow = WL + (size_t)(64 * h + fr) * LOWR + 8 * fq;
#pragma unroll
            for (int ks = 0; ks < 9; ++ks) {
                const bf16x8 b0 = *(const LAS bf16x8*)(arow + 32 * ks), b1 = *(const LAS bf16x8*)(arow + 16 * AS + 32 * ks);
#pragma unroll
                for (int n = 0; n < 4; ++n) { const bf16x8 af = *(const bf16x8*)(wrow + (size_t)(16 * n) * LOWR + 32 * ks);
                    if (ks < 2) { ad[0][n] = __builtin_amdgcn_mfma_f32_16x16x32_bf16(af, b0, ad[0][n], 0, 0, 0); ad[1][n] = __builtin_amdgcn_mfma_f32_16x16x32_bf16(af, b1, ad[1][n], 0, 0, 0); }
                    else if (ks < 4) { aa[0][n] = __builtin_amdgcn_mfma_f32_16x16x32_bf16(af, b0, aa[0][n], 0, 0, 0); aa[1][n] = __builtin_amdgcn_mfma_f32_16x16x32_bf16(af, b1, aa[1][n], 0, 0, 0); }
                    else { ag[0][n] = __builtin_amdgcn_mfma_f32_16x16x32_bf16(af, b0, ag[0][n], 0, 0, 0); ag[1][n] = __builtin_amdgcn_mfma_f32_16x16x32_bf16(af, b1, ag[1][n], 0, 0, 0); } }
                if (ks % 3 == 2) __builtin_amdgcn_sched_barrier(0);
            }
#pragma unroll
            for (int m = 0; m < 2; ++m)
#pragma unroll
                for (int n = 0; n < 4; ++n) *(v2u*)(GB + (size_t)(t0 + 16 * m + fr) * C + 64 * h + 16 * n + 4 * fq) = (v2u){pg8::cvt_pk_bf16(ag[m][n][0], ag[m][n][1]), pg8::cvt_pk_bf16(ag[m][n][2], ag[m][n][3])};
            __builtin_amdgcn_sched_barrier(0);
#pragma unroll
            for (int m = 0; m < 2; ++m) {
                const int t = t0 + 16 * m + fr, b = t / SEQ, tl = t % SEQ;
                bf16_t* pk = PK + ((size_t)(b * NH + h) * SEQ + tl) * 384 + 4 * fq;
                const LAS bf16_t* kr = ksl + (16 * m + fr) * KSL + 64 * h + 4 * fq;
                float ks_[4][4], av[4][4], kkr[4][4];
                float ss = 0.f;
#pragma unroll
                for (int n = 0; n < 4; ++n) {
                    const int c0 = 64 * h + 16 * n + 4 * fq;
                    const v2u kc = *(const LAS v2u*)(kr + 16 * n);
                    const f32x4 w0 = *(const LAS f32x4*)(par + c0), a0 = *(const LAS f32x4*)(par + 1024 + c0), kkc = *(const LAS f32x4*)(par + 2048 + c0);
                    const float kcv[4] = {bflo(kc.x), bfhi(kc.x), bflo(kc.y), bfhi(kc.y)};
                    float lw[4];
#pragma unroll
                    for (int r = 0; r < 4; ++r) {
                        ks_[n][r] = kcv[r];
                        const float wl = w0[r] + ad[m][n][r];
                        const float wlog = -fsoftplus(-wl) - 0.5f;
                        lw[r] = -__expf(wlog);
                        av[n][r] = fsigmoid(a0[r] + aa[m][n][r]);
                        kkr[n][r] = ks_[n][r] * kkc[r];
                        ss += kkr[n][r] * kkr[n][r];
                    }
                    *(v2u*)(pk + 16 * n + 64) = (v2u){pg8::cvt_pk_bf16(lw[0], lw[1]), pg8::cvt_pk_bf16(lw[2], lw[3])};
                }
                ss += __shfl_xor(ss, 16); ss += __shfl_xor(ss, 32);
                const float inv = 1.f / fmaxf(sqrtf(ss), 1e-12f);
#pragma unroll
                for (int n = 0; n < 4; ++n) {
                    const int c0 = 64 * h + 16 * n + 4 * fq;
                    const f32x4 kac = *(const LAS f32x4*)(par + 3072 + c0);
                    float kk[4], k2[4], bb[4];
#pragma unroll
                    for (int r = 0; r < 4; ++r) { kk[r] = kkr[n][r] * inv; k2[r] = ks_[n][r] * (1.f + (av[n][r] - 1.f) * kac[r]); bb[r] = kk[r] * av[n][r]; }
                    bf16_t* pn = pk + 16 * n;
                    *(v2u*)(pn + 128) = (v2u){pg8::cvt_pk_bf16(k2[0], k2[1]), pg8::cvt_pk_bf16(k2[2], k2[3])};
                    *(v2u*)(pn + 192) = (v2u){pg8::cvt_pk_bf16(-kk[0], -kk[1]), pg8::cvt_pk_bf16(-kk[2], -kk[3])};
                    *(v2u*)(pn + 256) = (v2u){pg8::cvt_pk_bf16(bb[0], bb[1]), pg8::cvt_pk_bf16(bb[2], bb[3])};
                }
            }
        }
    }
    __syncthreads();
}
__device__ __forceinline__ float dpp_sum8(float x) {
    x += __builtin_bit_cast(float, __builtin_amdgcn_update_dpp(0, __builtin_bit_cast(int, x), 0xB1, 0xF, 0xF, false));
    x += __builtin_bit_cast(float, __builtin_amdgcn_update_dpp(0, __builtin_bit_cast(int, x), 0x4E, 0xF, 0xF, false));
    x += __builtin_bit_cast(float, __builtin_amdgcn_update_dpp(0, __builtin_bit_cast(int, x), 0x141, 0xF, 0xF, false));
    return x;
}
template <bool IDENT>
__device__ __forceinline__ void wkv_steps8(f32x2 (&s)[4][8], const LAS float* buf, float* yout, const int vg, const int kg) {
#pragma unroll 1
    for (int st = 0; st < 8; ++st) {
        const LAS float* vb = buf + st * 384 + kg * 16;
        float sa[4], y[4];
        {
            f32x2 aa[8];
#pragma unroll
            for (int q = 0; q < 4; ++q) { const f32x4 t3 = *(const LAS f32x4*)(vb + 192 + 4 * q); aa[2 * q] = (f32x2){t3.x, t3.y}; aa[2 * q + 1] = (f32x2){t3.z, t3.w}; }
#pragma unroll
            for (int i = 0; i < 4; ++i) {
                f32x2 sa2 = s[i][0] * aa[0];
#pragma unroll
                for (int jp = 1; jp < 8; ++jp) sa2 = s[i][jp] * aa[jp] + sa2;
                sa[i] = sa2.x + sa2.y;
            }
        }
#pragma unroll
        for (int i = 0; i < 4; ++i) sa[i] += __builtin_bit_cast(float, __builtin_amdgcn_update_dpp(0, __builtin_bit_cast(int, sa[i]), 0xB1, 0xF, 0xF, false));
#pragma unroll
        for (int i = 0; i < 4; ++i) sa[i] += __builtin_bit_cast(float, __builtin_amdgcn_update_dpp(0, __builtin_bit_cast(int, sa[i]), 0x4E, 0xF, 0xF, false));
        f32x4 vv;
        if (!IDENT) vv = *(const LAS f32x4*)(buf + st * 384 + 320 + vg * 4);
        f32x2 y2[4];
#pragma unroll
        for (int hf = 0; hf < 2; ++hf) {
            f32x2 rr[4], ww[4], kk2[4], bb[4];
#pragma unroll
            for (int q = 0; q < 2; ++q) {
                const f32x4 t0 = *(const LAS f32x4*)(vb + 8 * hf + 4 * q), t1 = *(const LAS f32x4*)(vb + 64 + 8 * hf + 4 * q), t2 = *(const LAS f32x4*)(vb + 128 + 8 * hf + 4 * q), t4 = *(const LAS f32x4*)(vb + 256 + 8 * hf + 4 * q);
                rr[2 * q] = (f32x2){t0.x, t0.y}; rr[2 * q + 1] = (f32x2){t0.z, t0.w}; ww[2 * q] = (f32x2){t1.x, t1.y}; ww[2 * q + 1] = (f32x2){t1.z, t1.w};
                kk2[2 * q] = (f32x2){t2.x, t2.y}; kk2[2 * q + 1] = (f32x2){t2.z, t2.w}; bb[2 * q] = (f32x2){t4.x, t4.y}; bb[2 * q + 1] = (f32x2){t4.z, t4.w};
            }
#pragma unroll
            for (int i = 0; i < 4; ++i) {
                const f32x2 sav = (f32x2){sa[i], sa[i]};
#pragma unroll
                for (int jq = 0; jq < 4; ++jq) { const int jp = 4 * hf + jq;
                    f32x2 u = sav * bb[jq];
                    if (!IDENT) { const float vi = vv[i]; u = (f32x2){vi, vi} * kk2[jq] + u; }
                    s[i][jp] = s[i][jp] * ww[jq] + u;
                    y2[i] = (jp == 0) ? s[i][jp] * rr[jq] : s[i][jp] * rr[jq] + y2[i];
                }
            }
        }
#pragma unroll
        for (int i = 0; i < 4; ++i) y[i] = y2[i].x + y2[i].y;
#pragma unroll
        for (int i = 0; i < 4; ++i) y[i] += __builtin_bit_cast(float, __builtin_amdgcn_update_dpp(0, __builtin_bit_cast(int, y[i]), 0xB1, 0xF, 0xF, false));
#pragma unroll
        for (int i = 0; i < 4; ++i) y[i] += __builtin_bit_cast(float, __builtin_amdgcn_update_dpp(0, __builtin_bit_cast(int, y[i]), 0x4E, 0xF, 0xF, false));
        if (kg == 0) *(f32x4*)(yout + st * 64) = (f32x4){y[0], y[1], y[2], y[3]};
    }
}
__device__ __forceinline__ void ph_wkv_scan(Frame& F) {
    const bf16_t* PK = (const bf16_t*)(F.ws + WS_PK);
    const int lane = F.lane, wave = F.wave, pr = wave >> 1, role = (wave ^ (wave >> 2)) & 1, vg = lane >> 2, kg = lane & 3, l128 = role * 64 + lane;
    LAS float* pbuf = (LAS float*)(F.lds + pr * 24576);
    int woff[3]; bool isw[3];
#pragma unroll
    for (int j = 0; j < 3; ++j) { const int pi = l128 + 128 * j, stp = pi / 48, rem = pi % 48, vec = rem >> 3, c8 = rem & 7; woff[j] = (stp * 6 + vec) * 64 + c8 * 8; isw[j] = (vec == 1); }
    const int nround = (BATCH * NH * 16 + F.G * 4 - 1) / (F.G * 4);
    for (int rd = 0; rd < nround; ++rd) {
        const int item = (rd * F.G + F.bid) * 4 + pr;
        const bool act = item < BATCH * NH * 16;
        const int bh = item >> 4, ch = item & 15;
        const bf16_t* src = PK + ((size_t)bh * SEQ + ch * 128) * 384;
        f32x2 s[4][8];
#pragma unroll
        for (int i = 0; i < 4; ++i)
#pragma unroll
            for (int jp = 0; jp < 8; ++jp) s[i][jp] = (f32x2){(role && (4 * vg + i == 16 * kg + 2 * jp)) ? 1.f : 0.f, (role && (4 * vg + i == 16 * kg + 2 * jp + 1)) ? 1.f : 0.f};
        v4u rg[3];
#define WK_LOAD(sg) do { _Pragma("unroll") for (int j = 0; j < 3; ++j) rg[j] = *(const v4u*)(src + (size_t)(sg) * 8 * 384 + (size_t)(l128 + 128 * j) * 8); } while (0)
#define WK_WRITE(bf) do { _Pragma("unroll") for (int j = 0; j < 3; ++j) { float f[8]; f[0] = bflo(rg[j].x); f[1] = bfhi(rg[j].x); f[2] = bflo(rg[j].y); f[3] = bfhi(rg[j].y); f[4] = bflo(rg[j].z); f[5] = bfhi(rg[j].z); f[6] = bflo(rg[j].w); f[7] = bfhi(rg[j].w); \
            if (isw[j]) { _Pragma("unroll") for (int e = 0; e < 8; ++e) f[e] = __expf(f[e]); } \
            LAS float* d_ = pbuf + (bf) * 3072 + woff[j]; *(LAS f32x4*)d_ = (f32x4){f[0], f[1], f[2], f[3]}; *(LAS f32x4*)(d_ + 4) = (f32x4){f[4], f[5], f[6], f[7]}; } } while (0)
        __syncthreads();
        if (act) { WK_LOAD(0); WK_WRITE(0); WK_LOAD(1); }
        __syncthreads();
        float* yout = (float*)(F.ws + (role ? WS_QH : WS_YLOC)) + ((size_t)bh * SEQ + ch * 128) * 64 + vg * 4;
        for (int sg = 0; sg < 16; ++sg) {
            if (act) {
                if (role) wkv_steps8<true>(s, pbuf + (sg & 1) * 3072, yout + (size_t)sg * 8 * 64, vg, kg);
                else wkv_steps8<false>(s, pbuf + (sg & 1) * 3072, yout + (size_t)sg * 8 * 64, vg, kg);
                if (sg + 1 < 16) WK_WRITE((sg + 1) & 1);
                if (sg + 2 < 16) WK_LOAD(sg + 2);
            }
            __syncthreads();
        }
#undef WK_LOAD
#undef WK_WRITE
        if (act) { float* so = (float*)(F.ws + (role ? WS_PCH : WS_LCH)) + (size_t)item * 4096 + (size_t)(4 * vg) * 64 + 16 * kg;
#pragma unroll
            for (int i = 0; i < 4; ++i)
#pragma unroll
                for (int q = 0; q < 4; ++q) *(f32x4*)(so + i * 64 + 4 * q) = (f32x4){s[i][2 * q].x, s[i][2 * q].y, s[i][2 * q + 1].x, s[i][2 * q + 1].y}; }
    }
    __syncthreads();
}
namespace wk {
using pg8::bf16x8; using pg8::lds_byte;
typedef float f4 __attribute__((ext_vector_type(4)));
constexpr int AB = 8192;
constexpr int O_At = 0, O_Bt = AB, O_Kt = 2 * AB, O_Rt = 3 * AB, O_ATr = 4 * AB, O_BH = 5 * AB, O_KH = 6 * AB, O_VT = 7 * AB, O_N = 8 * AB, O_NT = 9 * AB, O_T0 = 10 * AB,
              O_Aak = 11 * AB, O_Arb = 12 * AB, O_Ark = 13 * AB, O_Z1T = 14 * AB, O_UT = 15 * AB, O_GT = 16 * AB, O_SEG = 17 * AB, O_WL = O_SEG + 4096, O_RAW = O_N;
struct Ctx { LAS unsigned char* lds; int am, fbase, d0, d1, ai, b0i; };
__device__ __forceinline__ void mm2(const Ctx& c, const int offA, const int offB, f4 (&acc)[2]) {
    const LAS unsigned char* pa = c.lds + offA + c.am * 2048 + c.fbase;
    const LAS unsigned char* pb = c.lds + offB + (c.b0i >> 4) * 2048 + c.fbase;
    const bf16x8 a0 = *(const LAS bf16x8*)pa, a1 = *(const LAS bf16x8*)(pa + 1024);
#pragma unroll
    for (int n = 0; n < 2; ++n) { const bf16x8 b0 = *(const LAS bf16x8*)(pb + n * 2048), b1 = *(const LAS bf16x8*)(pb + n * 2048 + 1024);
        acc[n] = __builtin_amdgcn_mfma_f32_16x16x32_bf16(a0, b0, acc[n], 0, 0, 0); acc[n] = __builtin_amdgcn_mfma_f32_16x16x32_bf16(a1, b1, acc[n], 0, 0, 0); }
}
__device__ __forceinline__ void zero2(f4 (&acc)[2]) { acc[0] = (f4){0.f, 0.f, 0.f, 0.f}; acc[1] = acc[0]; }
__device__ __forceinline__ void st_d(const Ctx& c, const int off, const int n, const f4 d) {
    *(LAS v2u*)(c.lds + off + (n ? c.d1 : c.d0)) = (v2u){pg8::cvt_pk_bf16(d[0], d[1]), pg8::cvt_pk_bf16(d[2], d[3])}; }
__device__ __forceinline__ f4 ld_d(const Ctx& c, const int off, const int n) {
    const v2u w = *(const LAS v2u*)(c.lds + off + (n ? c.d1 : c.d0)); return (f4){bflo(w.x), bfhi(w.x), bflo(w.y), bfhi(w.y)}; }
template <int MODE> __device__ __forceinline__ f4 tri(const Ctx& c, const int n, const f4 d) {
    const int b = c.b0i + 16 * n; f4 o;
#pragma unroll
    for (int r = 0; r < 4; ++r) { const int a = c.ai + r; const bool keep = MODE == 0 ? a < b : (MODE == 1 ? a <= b : a > b); o[r] = keep ? d[r] : 0.f; }
    return o; }
struct FA { bf16x8 v[2]; };
struct FB { bf16x8 v[2][2]; };
__device__ __forceinline__ FA lda(const Ctx& c, const int off) { const LAS unsigned char* p = c.lds + off + c.am * 2048 + c.fbase; FA f; f.v[0] = *(const LAS bf16x8*)p; f.v[1] = *(const LAS bf16x8*)(p + 1024); return f; }
__device__ __forceinline__ FB ldb(const Ctx& c, const int off) { const LAS unsigned char* p = c.lds + off + (c.b0i >> 4) * 2048 + c.fbase; FB f;
#pragma unroll
    for (int n = 0; n < 2; ++n) { f.v[n][0] = *(const LAS bf16x8*)(p + n * 2048); f.v[n][1] = *(const LAS bf16x8*)(p + n * 2048 + 1024); }
    return f; }
__device__ __forceinline__ void mmf(f4 (&acc)[2], const FA& a, const FB& b) {
#pragma unroll
    for (int n = 0; n < 2; ++n) acc[n] = __builtin_amdgcn_mfma_f32_16x16x32_bf16(a.v[0], b.v[n][0], acc[n], 0, 0, 0);
#pragma unroll
    for (int n = 0; n < 2; ++n) acc[n] = __builtin_amdgcn_mfma_f32_16x16x32_bf16(a.v[1], b.v[n][1], acc[n], 0, 0, 0); }
__device__ __forceinline__ void st2(const Ctx& c, const int off, const f4 (&d)[2]) { st_d(c, off, 0, d[0]); st_d(c, off, 1, d[1]); }
template <int MODE> __device__ __forceinline__ void st2tri(const Ctx& c, const int off, const f4 (&d)[2]) { st_d(c, off, 0, tri<MODE>(c, 0, d[0])); st_d(c, off, 1, tri<MODE>(c, 1, d[1])); }
__device__ __forceinline__ void chain_stage(const Ctx& c, const int Pin, const int PTin, const int Pout, const int PTout, const int Tin, const int Tout) {
    const FA aPT = lda(c, PTin), aP = lda(c, Pin); const FB bT = ldb(c, Tin), bP = ldb(c, Pin), bPT = ldb(c, PTin);
    f4 t[2], p[2], pt[2]; t[0] = ld_d(c, Tin, 0); t[1] = ld_d(c, Tin, 1); zero2(p); zero2(pt);
    __builtin_amdgcn_sched_barrier(0);
    mmf(t, aPT, bT); mmf(p, aPT, bP); mmf(pt, aP, bPT);
    st2(c, Tout, t); st2(c, Pout, p); st2(c, PTout, pt); }
}
__device__ __forceinline__ void ph_wkv_chunk(Frame& F) {
    using namespace wk;
    const bf16_t* PK = (const bf16_t*)(F.ws + WS_PK);
    bf16_t* YLOC = (bf16_t*)(F.ws + WS_YLOC); bf16_t* QH = (bf16_t*)(F.ws + WS_QH); bf16_t* PCH = (bf16_t*)(F.ws + WS_PCH); bf16_t* LCH = (bf16_t*)(F.ws + WS_LCH);
    LAS unsigned char* lds = F.lds;
    const int tid = F.tid, lane = F.lane, wave = F.wave, fr = lane & 15, fq = lane >> 4;
    Ctx c; c.lds = lds; c.am = wave >> 1; c.fbase = lds_byte(fr, 8 * fq); c.ai = 16 * (wave >> 1) + 4 * fq; c.b0i = 32 * (wave & 1) + fr;
    c.d0 = lds_byte(c.b0i, c.ai); c.d1 = lds_byte(c.b0i + 16, c.ai);
    constexpr int NIT = BATCH * NH * NCH;
    const LAS unsigned* raw32 = (const LAS unsigned*)(lds + O_RAW);
    LAS f32x2* segs2 = (LAS f32x2*)(lds + O_SEG);
    LAS float* wl = (LAS float*)(lds + O_WL);
    const int jp = tid & 31, sg = tid >> 5;
    v4u rg[6];
#define WC_LOAD(it_) do { const v4u* src_ = (const v4u*)(PK + (size_t)(it_) * 64 * 384); _Pragma("unroll") for (int q = 0; q < 6; ++q) rg[q] = src_[tid + NT * q]; } while (0)
    { const int i0 = F.bid < NIT ? F.bid : NIT - 1; WC_LOAD(i0); }
    __syncthreads();
#pragma unroll
    for (int q = 0; q < 6; ++q) *(LAS v4u*)(lds + O_RAW + (tid + NT * q) * 16) = rg[q];
    __syncthreads();
    for (int it = F.bid; it < NIT; it += F.G) {
        { const int nx = it + F.G < NIT ? it + F.G : it; WC_LOAD(nx); }
        f32x2 cs[4];
        { f32x2 run = (f32x2){0.f, 0.f};
#pragma unroll
          for (int i = 0; i < 4; ++i) { const unsigned w = raw32[(4 * sg + i) * 192 + 32 + jp]; run += (f32x2){bflo(w), bfhi(w)}; cs[i] = run; }
          segs2[sg * 32 + jp] = run; }
        __syncthreads();
        { unsigned rw[4], kw[4], aw[4], bw[4], vw[4];
#pragma unroll
          for (int i = 0; i < 4; ++i) { const LAS unsigned* rp = raw32 + (4 * sg + i) * 192 + jp; rw[i] = rp[0]; kw[i] = rp[64]; aw[i] = rp[96]; bw[i] = rp[128]; vw[i] = rp[160]; }
          f32x2 off = (f32x2){0.f, 0.f}, cl = off;
#pragma unroll
          for (int sgi = 0; sgi < 16; ++sgi) { const f32x2 v = segs2[sgi * 32 + jp]; cl += v; if (sgi < sg) off += v; }
          const f32x2 ecl = (f32x2){__expf(cl.x), __expf(cl.y)};
          if (sg == 0) *(LAS f32x2*)(wl + 2 * jp) = ecl;
          f32x2 ep = (f32x2){__expf(off.x), __expf(off.y)};
          f32x2 atv[4], bhv[4], khv[4];
          const int o0 = lds_byte(4 * sg, 2 * jp);
#pragma unroll
          for (int i = 0; i < 4; ++i) {
              const f32x2 cum = off + cs[i];
              const f32x2 eo = (f32x2){__expf(cum.x), __expf(cum.y)}, en = (f32x2){__builtin_amdgcn_rcpf(eo.x), __builtin_amdgcn_rcpf(eo.y)}, eh = ecl * en;
              const f32x2 r2 = (f32x2){bflo(rw[i]), bfhi(rw[i])}, k2 = (f32x2){bflo(kw[i]), bfhi(kw[i])}, a2 = (f32x2){bflo(aw[i]), bfhi(aw[i])}, b2 = (f32x2){bflo(bw[i]), bfhi(bw[i])};
              atv[i] = a2 * ep; bhv[i] = b2 * eh; khv[i] = k2 * eh; ep = eo;
              const f32x2 bt = b2 * en, kt = k2 * en, rt = r2 * eo;
              *(LAS unsigned*)(lds + O_At + o0 + 64 * i) = pg8::cvt_pk_bf16(atv[i].x, atv[i].y); *(LAS unsigned*)(lds + O_Bt + o0 + 64 * i) = pg8::cvt_pk_bf16(bt.x, bt.y);
              *(LAS unsigned*)(lds + O_Kt + o0 + 64 * i) = pg8::cvt_pk_bf16(kt.x, kt.y); *(LAS unsigned*)(lds + O_Rt + o0 + 64 * i) = pg8::cvt_pk_bf16(rt.x, rt.y); }
          const int ot = lds_byte(2 * jp, 4 * sg);
          *(LAS v2u*)(lds + O_ATr + ot) = (v2u){pg8::cvt_pk_bf16(atv[0].x, atv[1].x), pg8::cvt_pk_bf16(atv[2].x, atv[3].x)}; *(LAS v2u*)(lds + O_ATr + ot + 64) = (v2u){pg8::cvt_pk_bf16(atv[0].y, atv[1].y), pg8::cvt_pk_bf16(atv[2].y, atv[3].y)};
          *(LAS v2u*)(lds + O_BH + ot) = (v2u){pg8::cvt_pk_bf16(bhv[0].x, bhv[1].x), pg8::cvt_pk_bf16(bhv[2].x, bhv[3].x)}; *(LAS v2u*)(lds + O_BH + ot + 64) = (v2u){pg8::cvt_pk_bf16(bhv[0].y, bhv[1].y), pg8::cvt_pk_bf16(bhv[2].y, bhv[3].y)};
          *(LAS v2u*)(lds + O_KH + ot) = (v2u){pg8::cvt_pk_bf16(khv[0].x, khv[1].x), pg8::cvt_pk_bf16(khv[2].x, khv[3].x)}; *(LAS v2u*)(lds + O_KH + ot + 64) = (v2u){pg8::cvt_pk_bf16(khv[0].y, khv[1].y), pg8::cvt_pk_bf16(khv[2].y, khv[3].y)};
          *(LAS v2u*)(lds + O_VT + ot) = (v2u){(vw[0] & 0xffffu) | (vw[1] << 16), (vw[2] & 0xffffu) | (vw[3] << 16)}; *(LAS v2u*)(lds + O_VT + ot + 64) = (v2u){(vw[0] >> 16) | (vw[1] & 0xffff0000u), (vw[2] >> 16) | (vw[3] & 0xffff0000u)}; }
        __syncthreads();
        { const FA aB = lda(c, O_Bt), aA = lda(c, O_At), aK = lda(c, O_Kt); const FB bA = ldb(c, O_At), bB = ldb(c, O_Bt), bR = ldb(c, O_Rt);
          __builtin_amdgcn_sched_barrier(0);
          f4 nn[2], nt[2], ak[2], rb[2], rk[2]; zero2(nn); zero2(nt); zero2(ak); zero2(rb); zero2(rk);
          mmf(nn, aB, bA); mmf(nt, aA, bB); mmf(ak, aK, bA); mmf(rb, aB, bR); mmf(rk, aK, bR);
#pragma unroll
          for (int n = 0; n < 2; ++n) { const f4 m = tri<0>(c, n, nn[n]); st_d(c, O_N, n, m);
              const int b = c.b0i + 16 * n; f4 t1;
#pragma unroll
              for (int r = 0; r < 4; ++r) t1[r] = (c.ai + r == b) ? 1.f : m[r];
              st_d(c, O_T0, n, t1); }
          st2tri<2>(c, O_NT, nt); st2tri<0>(c, O_Aak, ak); st2tri<1>(c, O_Arb, rb); st2tri<1>(c, O_Ark, rk); }
        __syncthreads();
        { const FA aNT = lda(c, O_NT), aN = lda(c, O_N), aAk = lda(c, O_Aak); const FB bN = ldb(c, O_N), bNT = ldb(c, O_NT), bV = ldb(c, O_VT);
          __builtin_amdgcn_sched_barrier(0);
          f4 p[2], pt[2], z[2]; zero2(p); zero2(pt); zero2(z);
          mmf(p, aNT, bN); mmf(pt, aN, bNT); mmf(z, aAk, bV);
          st2(c, O_At, p); st2(c, O_Bt, pt); st2(c, O_Z1T, z); }
        __syncthreads();
        chain_stage(c, O_At, O_Bt, O_N, O_NT, O_T0, O_Kt);
        __syncthreads();
        chain_stage(c, O_N, O_NT, O_At, O_Bt, O_Kt, O_T0);
        __syncthreads();
        chain_stage(c, O_At, O_Bt, O_N, O_NT, O_T0, O_Kt);
        __syncthreads();
        { const FA aPT = lda(c, O_NT), aP = lda(c, O_N); const FB bT = ldb(c, O_Kt), bPT = ldb(c, O_NT);
          f4 t[2], pt[2]; t[0] = ld_d(c, O_Kt, 0); t[1] = ld_d(c, O_Kt, 1); zero2(pt);
          __builtin_amdgcn_sched_barrier(0);
          mmf(t, aPT, bT); mmf(pt, aP, bPT);
          st2(c, O_T0, t); st2(c, O_Bt, pt); }
        __syncthreads();
        { const FA aPT = lda(c, O_Bt); const FB bT = ldb(c, O_T0); f4 t[2]; t[0] = ld_d(c, O_T0, 0); t[1] = ld_d(c, O_T0, 1);
          mmf(t, aPT, bT); st2(c, O_Kt, t); }
        __syncthreads();
        { const FA aT = lda(c, O_Kt); const FB bZ = ldb(c, O_Z1T), bAT = ldb(c, O_ATr);
          f4 u[2], g[2]; zero2(u); zero2(g);
          mmf(u, aT, bZ); mmf(g, aT, bAT);
          st2(c, O_UT, u); st2(c, O_GT, g); }
        __syncthreads();
        { const int bh = it >> 5, ch = it & 31;
          const size_t row0 = (size_t)bh * SEQ + ch * 64;
          const FA aG = lda(c, O_GT), aU = lda(c, O_UT), aV = lda(c, O_VT), aBH = lda(c, O_BH), aKH = lda(c, O_KH);
          const FB bRb = ldb(c, O_Arb), bRk = ldb(c, O_Ark), bBH = ldb(c, O_BH), bU = ldb(c, O_UT), bV = ldb(c, O_VT);
          f4 q[2], y[2], pm[2], lc[2]; q[0] = ld_d(c, O_Rt, 0); q[1] = ld_d(c, O_Rt, 1); zero2(y); zero2(pm); zero2(lc);
          const float w0 = wl[c.b0i], w1 = wl[c.b0i + 16];
          __builtin_amdgcn_sched_barrier(0);
          mmf(q, aG, bRb);
          mmf(y, aU, bRb); mmf(y, aV, bRk);
          mmf(pm, aG, bBH);
          mmf(lc, aBH, bU); mmf(lc, aKH, bV);
#pragma unroll
          for (int n = 0; n < 2; ++n) { const int b = c.b0i + 16 * n;
              *(v2u*)(QH + (row0 + b) * 64 + c.ai) = (v2u){pg8::cvt_pk_bf16(q[n][0], q[n][1]), pg8::cvt_pk_bf16(q[n][2], q[n][3])};
              *(v2u*)(YLOC + (row0 + b) * 64 + c.ai) = (v2u){pg8::cvt_pk_bf16(y[n][0], y[n][1]), pg8::cvt_pk_bf16(y[n][2], y[n][3])};
              f4 o = pm[n]; const float wd = n ? w1 : w0;
#pragma unroll
              for (int r = 0; r < 4; ++r) o[r] += (c.ai + r == b) ? wd : 0.f;
              *(v2u*)(PCH + (size_t)it * 4096 + b * 64 + c.ai) = (v2u){pg8::cvt_pk_bf16(o[0], o[1]), pg8::cvt_pk_bf16(o[2], o[3])};
              *(v2u*)(LCH + (size_t)it * 4096 + b * 64 + c.ai) = (v2u){pg8::cvt_pk_bf16(lc[n][0], lc[n][1]), pg8::cvt_pk_bf16(lc[n][2], lc[n][3])}; } }
        __syncthreads();
#pragma unroll
        for (int q = 0; q < 6; ++q) *(LAS v4u*)(lds + O_RAW + (tid + NT * q) * 16) = rg[q];
        __syncthreads();
    }
#undef WC_LOAD
    __syncthreads();
}
__device__ __forceinline__ void wkv_carry_bh(Frame& F, const int bh) {
    using namespace wk;
    const bf16_t* PT = (const bf16_t*)(F.ws + WS_PCH) + (size_t)bh * NCH * 4096;
    const bf16_t* LC = (const bf16_t*)(F.ws + WS_LCH) + (size_t)bh * NCH * 4096;
    bf16_t* SST = (bf16_t*)(F.ws + WS_SST) + (size_t)bh * NCH * 4096;
    const int lane = F.lane, wave = F.wave, fr = lane & 15, fq = lane >> 4;
    Ctx c; c.lds = F.lds; c.am = wave >> 1; c.fbase = lds_byte(fr, 8 * fq); c.ai = 16 * (wave >> 1) + 4 * fq; c.b0i = 32 * (wave & 1) + fr;
    c.d0 = lds_byte(c.b0i, c.ai); c.d1 = lds_byte(c.b0i + 16, c.ai);
    __syncthreads();
    { const f4 z = (f4){0.f, 0.f, 0.f, 0.f};
#pragma unroll
      for (int n = 0; n < 2; ++n) { st_d(c, 0, n, z); st_d(c, AB, n, z); *(v2u*)(SST + (c.b0i + 16 * n) * 64 + c.ai) = (v2u){0u, 0u}; } }
    const int pofs = (16 * c.am + fr) * 64 + 8 * fq;
    bf16x8 pa0 = *(const bf16x8*)(PT + pofs), pa1 = *(const bf16x8*)(PT + pofs + 32);
    v2u lv0 = *(const v2u*)(LC + c.b0i * 64 + c.ai), lv1 = *(const v2u*)(LC + (c.b0i + 16) * 64 + c.ai);
    __syncthreads();
    for (int ch = 0; ch < NCH - 1; ++ch) {
        const int cur = (ch & 1) * 2 * AB, nxt = 2 * AB - cur;
        const FB sh = ldb(c, cur), sl = ldb(c, cur + AB);
        FA a; a.v[0] = pa0; a.v[1] = pa1;
        f4 acc[2]; acc[0] = (f4){bflo(lv0.x), bfhi(lv0.x), bflo(lv0.y), bfhi(lv0.y)}; acc[1] = (f4){bflo(lv1.x), bfhi(lv1.x), bflo(lv1.y), bfhi(lv1.y)};
        { const int cn = ch + 1 < NCH - 1 ? ch + 1 : NCH - 2;
          const bf16_t* pn = PT + (size_t)cn * 4096; const bf16_t* ln = LC + (size_t)cn * 4096;
          pa0 = *(const bf16x8*)(pn + pofs); pa1 = *(const bf16x8*)(pn + pofs + 32);
          lv0 = *(const v2u*)(ln + c.b0i * 64 + c.ai); lv1 = *(const v2u*)(ln + (c.b0i + 16) * 64 + c.ai); }
        mmf(acc, a, sh); mmf(acc, a, sl);
        bf16_t* so = SST + (size_t)(ch + 1) * 4096;
#pragma unroll
        for (int n = 0; n < 2; ++n) { const f4 d = acc[n];
            const v2u hi = (v2u){pg8::cvt_pk_bf16(d[0], d[1]), pg8::cvt_pk_bf16(d[2], d[3])};
            const f4 lo = (f4){d[0] - bflo(hi.x), d[1] - bfhi(hi.x), d[2] - bflo(hi.y), d[3] - bfhi(hi.y)};
            *(LAS v2u*)(c.lds + nxt + (n ? c.d1 : c.d0)) = hi; st_d(c, nxt + AB, n, lo);
            *(v2u*)(so + (c.b0i + 16 * n) * 64 + c.ai) = hi; }
        __syncthreads();
    }
    __syncthreads();
}
struct PostIn { pg8::bf16x8 qf[2], sf[4][2]; v2u yw[4], rr[4], kk[4], vv[4], gg[4]; };
__device__ __forceinline__ void ph_wkv_post(Frame& F) {
    using pg8::bf16x8;
    typedef float f4 __attribute__((ext_vector_type(4)));
    const bf16_t* PK = (const bf16_t*)(F.ws + WS_PK);
    const bf16_t* GB = (const bf16_t*)(F.ws + WS_G);
    const bf16_t* YLOC = (const bf16_t*)(F.ws + WS_YLOC);
    const bf16_t* QH = (const bf16_t*)(F.ws + WS_QH);
    const bf16_t* SST = (const bf16_t*)(F.ws + WS_SST);
    bf16_t* YC = (bf16_t*)(F.ws + WS_YCAT);
    const int lane = F.lane, wave = F.wave, fr = lane & 15, fq = lane >> 4;
    constexpr int NI = BATCH * NH * 16;
#define POST_LOAD(R, item_) do { const int it_ = (item_); const int bh_ = it_ >> 4, ch_ = it_ & 15, b_ = bh_ / NH, h_ = bh_ % NH; const int tl_ = ch_ * 128 + 16 * wave + fr; \
        const size_t ro_ = (size_t)bh_ * SEQ + tl_, tg_ = (size_t)b_ * SEQ + tl_; const bf16_t* pk_ = PK + ro_ * 384 + 4 * fq; \
        _Pragma("unroll") for (int ks = 0; ks < 2; ++ks) R.qf[ks] = *(const bf16x8*)(QH + ro_ * 64 + 32 * ks + 8 * fq); \
        _Pragma("unroll") for (int m = 0; m < 4; ++m) { \
            _Pragma("unroll") for (int ks = 0; ks < 2; ++ks) R.sf[m][ks] = *(const bf16x8*)(SST + ((size_t)it_ * 2 + (wave >> 2)) * 4096 + (16 * m + fr) * 64 + 32 * ks + 8 * fq); \
            R.yw[m] = *(const v2u*)(YLOC + ro_ * 64 + 16 * m + 4 * fq); R.rr[m] = *(const v2u*)(pk_ + 16 * m); R.kk[m] = *(const v2u*)(pk_ + 128 + 16 * m); R.vv[m] = *(const v2u*)(pk_ + 320 + 16 * m); \
            R.gg[m] = *(const v2u*)(GB + tg_ * C + h_ * HD + 16 * m + 4 * fq); } } while (0)
    PostIn cur;
    { const int i0 = F.bid < NI ? F.bid : NI - 1; POST_LOAD(cur, i0); }
    for (int item = F.bid; item < NI; item += F.G) {
        const int bh = item >> 4, ch = item & 15, b = bh / NH, h = bh % NH;
        const int tl = ch * 128 + 16 * wave + fr;
        const size_t tg = (size_t)b * SEQ + tl;
        PostIn nx;
        { const int nxi = item + F.G < NI ? item + F.G : item; POST_LOAD(nx, nxi); }
        f4 yv[4], lg[4], lb[4], rkv[4];
#pragma unroll
        for (int m = 0; m < 4; ++m) { const int c0 = h * HD + 16 * m + 4 * fq;
            yv[m] = (f4){bflo(cur.yw[m].x), bfhi(cur.yw[m].x), bflo(cur.yw[m].y), bfhi(cur.yw[m].y)};
            lg[m] = *(const f4*)(F.a->in[I_LNXG] + c0); lb[m] = *(const f4*)(F.a->in[I_LNXB] + c0); rkv[m] = *(const f4*)(F.a->in[I_RK] + c0); }
#pragma unroll
        for (int m = 0; m < 4; ++m) { f4 acc = (f4){0.f, 0.f, 0.f, 0.f};
#pragma unroll
            for (int ks = 0; ks < 2; ++ks) acc = __builtin_amdgcn_mfma_f32_16x16x32_bf16(cur.sf[m][ks], cur.qf[ks], acc, 0, 0, 0);
            yv[m] += acc; }
        float sm = 0.f;
#pragma unroll
        for (int m = 0; m < 4; ++m) sm += (yv[m].x + yv[m].y) + (yv[m].z + yv[m].w);
        sm += __shfl_xor(sm, 16); sm += __shfl_xor(sm, 32);
        const float mu = sm * (1.f / HD);
        float s2 = 0.f, bn = 0.f;
#pragma unroll
        for (int m = 0; m < 4; ++m) { yv[m] = yv[m] - mu; s2 += (yv[m].x * yv[m].x + yv[m].y * yv[m].y) + (yv[m].z * yv[m].z + yv[m].w * yv[m].w);
            bn += bflo(cur.rr[m].x) * bflo(cur.kk[m].x) * rkv[m].x + bfhi(cur.rr[m].x) * bfhi(cur.kk[m].x) * rkv[m].y + bflo(cur.rr[m].y) * bflo(cur.kk[m].y) * rkv[m].z + bfhi(cur.rr[m].y) * bfhi(cur.kk[m].y) * rkv[m].w; }
        s2 += __shfl_xor(s2, 16); s2 += __shfl_xor(s2, 32);
        bn += __shfl_xor(bn, 16); bn += __shfl_xor(bn, 32);
        const float rstd = 1.f / sqrtf(s2 * (1.f / HD) + GN_EPS);
#pragma unroll
        for (int m = 0; m < 4; ++m) { const int c0 = h * HD + 16 * m + 4 * fq;
            const float o0 = (yv[m].x * rstd * lg[m].x + lb[m].x + bn * bflo(cur.vv[m].x)) * bflo(cur.gg[m].x), o1 = (yv[m].y * rstd * lg[m].y + lb[m].y + bn * bfhi(cur.vv[m].x)) * bfhi(cur.gg[m].x);
            const float o2 = (yv[m].z * rstd * lg[m].z + lb[m].z + bn * bflo(cur.vv[m].y)) * bflo(cur.gg[m].y), o3 = (yv[m].w * rstd * lg[m].w + lb[m].w + bn * bfhi(cur.vv[m].y)) * bfhi(cur.gg[m].y);
            *(v2u*)(YC + tg * D + c0) = (v2u){pg8::cvt_pk_bf16(o0, o1), pg8::cvt_pk_bf16(o2, o3)}; }
        cur = nx;
    }
#undef POST_LOAD
    __syncthreads();
}
__device__ __forceinline__ void ph_sb_attn_naive(Frame& F) {
    const bf16_t* P = (const bf16_t*)(F.ws + WS_PROJ);
    bf16_t* YC = (bf16_t*)(F.ws + WS_YCAT);
    LAS float* qs = (LAS float*)F.lds + F.wave * 256;
    LAS float* as = qs + 128;
    const int gw = F.bid * NWAVES + F.wave, NGW = F.G * NWAVES, lane = F.lane;
    const float scale = 0.08838834764831845f;
    for (int it = gw; it < T * SBH; it += NGW) {
        const int t = it >> 2, hh = it & 3, b = t / SEQ, tl = t % SEQ;
        const bf16_t* qp = P + (size_t)t * PLD + COL_SBQ + hh * SBD;
        wave_lds_sync();
        qs[lane] = bf2f(qp[lane]); qs[64 + lane] = bf2f(qp[64 + lane]);
        wave_lds_sync();
        float o0 = 0.f, o1 = 0.f, carry = 0.f;
        const int nkb = (tl + 63) >> 6;
        for (int kb = nkb - 1; kb >= 0; --kb) {
            const int s = kb * 64 + lane; const bool valid = s < tl;
            float z = 0.f;
            if (valid) {
                const bf16_t* kp = P + (size_t)(b * SEQ + s) * PLD + COL_SBK + hh * SBD;
#pragma unroll 4
                for (int d = 0; d < SBD; d += 8) { const v4u kv = *(const v4u*)(kp + d); const f32x4 q0 = *(const LAS f32x4*)(qs + d), q1 = *(const LAS f32x4*)(qs + d + 4);
                    z += q0.x * bflo(kv.x) + q0.y * bfhi(kv.x) + q0.z * bflo(kv.y) + q0.w * bfhi(kv.y) + q1.x * bflo(kv.z) + q1.y * bfhi(kv.z) + q1.z * bflo(kv.w) + q1.w * bfhi(kv.w); }
            }
            z *= scale;
            const float sp = softplusf(z);
            const float lk = valid ? -sp : 0.f;
            float x = lk;
#pragma unroll
            for (int o = 1; o < 64; o <<= 1) { const float y = __shfl_down(x, o); if (lane + o < 64) x += y; }
            const float excl = x - lk;
            const float attn = valid ? expf(z - sp + carry + excl) : 0.f;
            carry += __shfl(x, 0);
            wave_lds_sync();
            as[lane] = attn;
            wave_lds_sync();
            const bf16_t* vp = P + (size_t)(b * SEQ + kb * 64) * PLD + COL_SBV + hh * SBD + 2 * lane;
            const int nv = min(64, tl - kb * 64);
            for (int j = 0; j < nv; ++j) { const float a = as[j]; const unsigned vv = *(const unsigned*)(vp + (size_t)j * PLD); o0 += a * bflo(vv); o1 += a * bfhi(vv); }
        }
        *(unsigned*)(YC + (size_t)t * D + C + hh * SBD + 2 * lane) = pk2(o0, o1);
    }
}
__device__ __forceinline__ void vt_tile(const bf16_t* src, int ld, bf16_t* dst, int dld, LAS bf16_t* tl, int lane) {
    constexpr int RS = 136;
#pragma unroll 4
    for (int i = 0; i < 16; ++i) { const int row = i * 4 + (lane >> 4), ch = lane & 15;
        *(LAS v4u*)(tl + row * RS + ch * 8) = *(const v4u*)(src + (size_t)row * ld + ch * 8); }
    wave_lds_sync();
#pragma unroll 4
    for (int it = 0; it < 16; ++it) { const int o = it * 64 + lane, d = o >> 3, ch = o & 7, sgrp = ch >> 2, fqq = ch & 3;
        const LAS bf16_t* c0 = tl + (32 * sgrp + 4 * fqq) * RS + d;
        v4u w;
        w.x = (unsigned)c0[0 * RS] | ((unsigned)c0[1 * RS] << 16); w.y = (unsigned)c0[2 * RS] | ((unsigned)c0[3 * RS] << 16);
        w.z = (unsigned)c0[16 * RS] | ((unsigned)c0[17 * RS] << 16); w.w = (unsigned)c0[18 * RS] | ((unsigned)c0[19 * RS] << 16);
        *(v4u*)(dst + (size_t)d * dld + 8 * ch) = w; }
    wave_lds_sync();
}
__device__ __forceinline__ void ph_vt(Frame& F) {
    const bf16_t* P = (const bf16_t*)(F.ws + WS_PROJ);
    const bf16_t* MKV = (const bf16_t*)(F.ws + WS_MEMKV);
    bf16_t* VTSB = (bf16_t*)(F.ws + WS_VTSB);
    bf16_t* VTMEM = (bf16_t*)(F.ws + WS_VTMEM);
    LAS bf16_t* tl = (LAS bf16_t*)(F.lds + F.wave * 17408);
    const int gw = F.bid * NWAVES + F.wave, NGW = F.G * NWAVES;
    constexpr int N_SB = BATCH * SBH * (SEQ / 64), N_MEM = BATCH * MEMH * (MEML / 64);
    for (int it = gw; it < N_SB + N_MEM; it += NGW) {
        if (it < N_SB) { const int kt = it % (SEQ / 64), bh = it / (SEQ / 64), b = bh / SBH, h = bh % SBH;
            vt_tile(P + (size_t)(b * SEQ + kt * 64) * PLD + COL_SBV + h * SBD, PLD, VTSB + (size_t)bh * SBD * SEQ + kt * 64, SEQ, tl, F.lane); }
        else { const int j = it - N_SB, kt = j % (MEML / 64), bh = j / (MEML / 64), b = bh / MEMH, h = bh % MEMH;
            vt_tile(MKV + (size_t)(b * MEML + kt * 64) * (2 * MEMW) + MEMW + h * MEMD, 2 * MEMW, VTMEM + (size_t)bh * MEMD * MEML + kt * 64, MEML, tl, F.lane); }
    }
    __syncthreads();
}
__device__ __forceinline__ void sb_item(Frame& F, const int b, const int h, const int jq, bf16_t* OUT, const int old_, const int ocol) {
    using pg8::bf16x8; using pg8::lds_byte;
    typedef float f4 __attribute__((ext_vector_type(4)));
    const bf16_t* P = (const bf16_t*)(F.ws + WS_PROJ);
    const bf16_t* VT = (const bf16_t*)(F.ws + WS_VTSB) + (size_t)(b * SBH + h) * SBD * SEQ;
    LAS unsigned char* lds = F.lds;
    const int tid = F.tid, lane = F.lane, wave = F.wave, hf = wave >> 2, qg = wave & 3, fr = lane & 15, fq = lane >> 4, ht = tid & 255;
    const int nt = jq + 1, nh = (nt + 1) >> 1, nl = nt - nh;
    const int my_n = hf ? nl : nh, kt0 = hf ? (jq - nh) : jq;
    const float scale = 0.08838834764831845f * 1.4426950408889634f;
    const bf16_t* kbase = P + (size_t)(b * SEQ) * PLD + COL_SBK + h * SBD;
    int kwoff[4], vwoff[4]; size_t ksrc[4], vsrc[4];
#pragma unroll
    for (int i = 0; i < 4; ++i) { const int pp = ht + 256 * i, r = pp >> 4, c = pp & 15;
        kwoff[i] = (c >> 3) * 8192 + lds_byte(r, (c & 7) * 8); ksrc[i] = (size_t)r * PLD + 8 * c;
        const int d = pp >> 3, c2 = pp & 7;
        vwoff[i] = lds_byte(d, 8 * c2); vsrc[i] = (size_t)d * SEQ + 8 * c2; }
    const int fbase = lds_byte(fr, 8 * fq);
    bf16x8 qf[4];
    { const bf16_t* qp = P + (size_t)(b * SEQ + 64 * jq + 16 * qg + fr) * PLD + COL_SBQ + h * SBD + 8 * fq;
#pragma unroll
      for (int kk = 0; kk < 4; ++kk) qf[kk] = *(const bf16x8*)(qp + 32 * kk); }
    f4 acc_o[8];
#pragma unroll
    for (int i = 0; i < 8; ++i) acc_o[i] = (f4){0.f, 0.f, 0.f, 0.f};
    float carry = 0.f;
    v4u rk[4], rv[4];
#define SB_LOAD(stp) do { const int _kt = kt0 - (stp); _Pragma("unroll") for (int i = 0; i < 4; ++i) { rk[i] = *(const v4u*)(kbase + (size_t)_kt * 64 * PLD + ksrc[i]); rv[i] = *(const v4u*)(VT + (size_t)_kt * 64 + vsrc[i]); } } while (0)
#define SB_WRITE(stg) do { LAS unsigned char* _b = lds + ((stg) * 2 + hf) * 32768; _Pragma("unroll") for (int i = 0; i < 4; ++i) { *(LAS v4u*)(_b + kwoff[i]) = rk[i]; *(LAS v4u*)(_b + 16384 + vwoff[i]) = rv[i]; } } while (0)
    if (0 < my_n) { SB_LOAD(0); SB_WRITE(0); }
    if (1 < my_n) SB_LOAD(1);
    __syncthreads();
    for (int st = 0; st < nh; ++st) {
        if (st < my_n) {
            const LAS unsigned char* kb = lds + ((st & 1) * 2 + hf) * 32768;
            const LAS unsigned char* vb = kb + 16384;
            f4 sc[4];
#pragma unroll
            for (int i = 0; i < 4; ++i) { sc[i] = (f4){0.f, 0.f, 0.f, 0.f};
#pragma unroll
                for (int kk = 0; kk < 4; ++kk) { const bf16x8 kf = *(const LAS bf16x8*)(kb + fbase + i * 2048 + (kk & 1) * 1024 + (kk >> 1) * 8192);
                    sc[i] = __builtin_amdgcn_mfma_f32_16x16x32_bf16(kf, qf[kk], sc[i], 0, 0, 0); } }
            const bool diag = (hf == 0) && (st == 0);
            float av[4][4], tt[4], xx[4];
#pragma unroll
            for (int i = 0; i < 4; ++i) {
                float lk[4];
#pragma unroll
                for (int r = 0; r < 4; ++r) { float z = sc[i][r] * scale; const float e = __builtin_amdgcn_exp2f(-fabsf(z)); float l = -(fmaxf(z, 0.f) + __builtin_amdgcn_logf(1.f + e));
                    if (diag && !((16 * i + 4 * fq + r) < (16 * qg + fr))) { l = 0.f; z = -1.0e30f; }
                    lk[r] = l; sc[i][r] = z; }
                av[i][3] = lk[3]; av[i][2] = lk[2] + av[i][3]; av[i][1] = lk[1] + av[i][2]; av[i][0] = lk[0] + av[i][1];
                const float tot = av[i][0], u = __shfl_xor(tot, 16), t1 = tot + u, v = __shfl_xor(t1, 32);
                tt[i] = t1 + v; xx[i] = ((fq & 1) ? 0.f : u) + ((fq & 2) ? 0.f : v);
            }
            const float y2 = tt[3], y1 = y2 + tt[2], y0 = y1 + tt[1], total = y0 + tt[0];
            xx[0] += y0 + carry; xx[1] += y1 + carry; xx[2] += y2 + carry; xx[3] += carry;
            carry += total;
            bf16x8 pf[2];
#pragma unroll
            for (int sg2 = 0; sg2 < 2; ++sg2) {
                float pv[8];
#pragma unroll
                for (int a = 0; a < 2; ++a)
#pragma unroll
                    for (int r = 0; r < 4; ++r) pv[4 * a + r] = __builtin_amdgcn_exp2f(sc[2 * sg2 + a][r] + av[2 * sg2 + a][r] + xx[2 * sg2 + a]);
                v4u w; w.x = pg8::cvt_pk_bf16(pv[0], pv[1]); w.y = pg8::cvt_pk_bf16(pv[2], pv[3]); w.z = pg8::cvt_pk_bf16(pv[4], pv[5]); w.w = pg8::cvt_pk_bf16(pv[6], pv[7]);
                pf[sg2] = __builtin_bit_cast(bf16x8, w);
            }
#pragma unroll
            for (int ds = 0; ds < 8; ++ds)
#pragma unroll
                for (int sg2 = 0; sg2 < 2; ++sg2) { const bf16x8 vf = *(const LAS bf16x8*)(vb + fbase + ds * 2048 + sg2 * 1024);
                    acc_o[ds] = __builtin_amdgcn_mfma_f32_16x16x32_bf16(vf, pf[sg2], acc_o[ds], 0, 0, 0); }
        }
        if (st + 1 < my_n) SB_WRITE((st + 1) & 1);
        if (st + 2 < my_n) SB_LOAD(st + 2);
        __syncthreads();
    }
#undef SB_LOAD
#undef SB_WRITE
    LAS float* xb = (LAS float*)lds + qg * 2048;
    if (hf) {
#pragma unroll
        for (int ds = 0; ds < 8; ++ds)
#pragma unroll
            for (int r = 0; r < 4; ++r) xb[(ds * 4 + r) * 64 + lane] = acc_o[ds][r];
    }
    __syncthreads();
    if (!hf) {
        const float ec = __builtin_amdgcn_exp2f(carry);
        bf16_t* op = OUT + (size_t)(b * SEQ + 64 * jq + 16 * qg + fr) * old_ + ocol + h * SBD + 4 * fq;
#pragma unroll
        for (int ds = 0; ds < 8; ++ds) { float o[4];
#pragma unroll
            for (int r = 0; r < 4; ++r) o[r] = acc_o[ds][r] + ec * xb[(ds * 4 + r) * 64 + lane];
            *(v2u*)(op + 16 * ds) = (v2u){pg8::cvt_pk_bf16(o[0], o[1]), pg8::cvt_pk_bf16(o[2], o[3])}; }
    }
    __syncthreads();
}
#if DBG
__device__ __forceinline__ void dbg_max(Frame& F, int slot, float v) { if (v > 0.f) atomicMax(F.ctl + CW_DBG + slot, __builtin_bit_cast(unsigned, v)); }
__device__ __forceinline__ void ph_dbg_check(Frame& F) {
    const bf16_t* P = (const bf16_t*)(F.ws + WS_PROJ);
    const bf16_t* VTSB = (const bf16_t*)(F.ws + WS_VTSB);
    const bf16_t* YC = (const bf16_t*)(F.ws + WS_YCAT);
    const bf16_t* DB = (const bf16_t*)(F.ws + WS_DBG);
    const size_t gt = (size_t)F.bid * NT + F.tid, GT = (size_t)F.G * NT;
    float ea = 0.f;
    for (size_t i = gt; i < (size_t)BATCH * SBH * SBD * SEQ; i += GT) {
        const int pos = (int)(i % SEQ), d = (int)((i / SEQ) % SBD), bh = (int)(i / ((size_t)SEQ * SBD)), b = bh / SBH, h = bh % SBH;
        const int s32 = pos >> 5, q = pos & 31, fqq = q >> 3, a = (q >> 2) & 1, r = q & 3, key = 32 * s32 + 16 * a + 4 * fqq + r;
        const float e = fabsf(bf2f(VTSB[i]) - bf2f(P[(size_t)(b * SEQ + key) * PLD + COL_SBV + h * SBD + d]));
        ea = fmaxf(ea, e);
    }
    dbg_max(F, 0, ea);
    float eb = 0.f, ec = 0.f, ed = 0.f, ee = 0.f;
    for (size_t i = gt; i < (size_t)T * SBW; i += GT) {
        const int t = (int)(i / SBW), c = (int)(i % SBW), jq = (t % SEQ) >> 6;
        const float e = fabsf(bf2f(DB[i]) - bf2f(YC[(size_t)t * D + C + c]));
        if (jq == 0) eb = fmaxf(eb, e); else if (jq == 1) ec = fmaxf(ec, e); else if (jq < 4) ed = fmaxf(ed, e); else ee = fmaxf(ee, e);
    }
    dbg_max(F, 1, eb); dbg_max(F, 2, ec); dbg_max(F, 3, ed); dbg_max(F, 4, ee);
}
#endif
__device__ __forceinline__ void mem_item(Frame& F, const int it) {
    using pg8::bf16x8; using pg8::lds_byte;
    typedef float f4 __attribute__((ext_vector_type(4)));
    const bf16_t* P = (const bf16_t*)(F.ws + WS_PROJ);
    const bf16_t* MKV = (const bf16_t*)(F.ws + WS_MEMKV);
    const bf16_t* VTM = (const bf16_t*)(F.ws + WS_VTMEM);
    bf16_t* YC = (bf16_t*)(F.ws + WS_YCAT);
    LAS unsigned char* lds = F.lds;
    const int tid = F.tid, lane = F.lane, wave = F.wave, fr = lane & 15, fq = lane >> 4;
    const float scale = 0.08838834764831845f;
    const int fbase = lds_byte(fr, 8 * fq);
    {
        const int qt = it & 15, bh = it >> 4, b = bh / MEMH, h = bh % MEMH;
        __syncthreads();
#pragma unroll
        for (int t = 0; t < 4; ++t)
#pragma unroll
            for (int i = 0; i < 2; ++i) { const int pp = tid + 512 * i, r = pp >> 4, c = pp & 15, d = pp >> 3, c2 = pp & 7;
                const v4u kv = *(const v4u*)(MKV + (size_t)(b * MEML + 64 * t + r) * (2 * MEMW) + h * MEMD + 8 * c);
                const v4u vv = *(const v4u*)(VTM + ((size_t)bh * MEMD + d) * MEML + 64 * t + 8 * c2);
                *(LAS v4u*)(lds + t * 16384 + (c >> 3) * 8192 + lds_byte(r, (c & 7) * 8)) = kv;
                *(LAS v4u*)(lds + 65536 + t * 16384 + lds_byte(d, 8 * c2)) = vv; }
        bf16x8 qf[4];
        const int q = b * SEQ + 128 * qt + 16 * wave + fr;
        { const bf16_t* qp = P + (size_t)q * PLD + COL_QM + h * MEMD + 8 * fq;
#pragma unroll
          for (int kk = 0; kk < 4; ++kk) qf[kk] = *(const bf16x8*)(qp + 32 * kk); }
        __syncthreads();
        f4 sc[16];
#pragma unroll
        for (int ti = 0; ti < 16; ++ti) { sc[ti] = (f4){0.f, 0.f, 0.f, 0.f};
#pragma unroll
            for (int kk = 0; kk < 4; ++kk) { const bf16x8 kf = *(const LAS bf16x8*)(lds + (ti >> 2) * 16384 + fbase + (ti & 3) * 2048 + (kk & 1) * 1024 + (kk >> 1) * 8192);
                sc[ti] = __builtin_amdgcn_mfma_f32_16x16x32_bf16(kf, qf[kk], sc[ti], 0, 0, 0); } }
        float mx = -3.0e38f;
#pragma unroll
        for (int ti = 0; ti < 16; ++ti)
#pragma unroll
            for (int r = 0; r < 4; ++r) { sc[ti][r] *= scale * 1.4426950408889634f; mx = fmaxf(mx, sc[ti][r]); }
        mx = fmaxf(mx, __shfl_xor(mx, 16)); mx = fmaxf(mx, __shfl_xor(mx, 32));
        float sum = 0.f;
#pragma unroll
        for (int ti = 0; ti < 16; ++ti)
#pragma unroll
            for (int r = 0; r < 4; ++r) { sc[ti][r] = __builtin_amdgcn_exp2f(sc[ti][r] - mx); sum += sc[ti][r]; }
        sum += __shfl_xor(sum, 16); sum += __shfl_xor(sum, 32);
        const float inv = 1.f / sum;
        f4 acc_o[8];
#pragma unroll
        for (int ds = 0; ds < 8; ++ds) acc_o[ds] = (f4){0.f, 0.f, 0.f, 0.f};
#pragma unroll
        for (int ks = 0; ks < 8; ++ks) {
            v4u w; w.x = pg8::cvt_pk_bf16(sc[2 * ks][0], sc[2 * ks][1]); w.y = pg8::cvt_pk_bf16(sc[2 * ks][2], sc[2 * ks][3]);
            w.z = pg8::cvt_pk_bf16(sc[2 * ks + 1][0], sc[2 * ks + 1][1]); w.w = pg8::cvt_pk_bf16(sc[2 * ks + 1][2], sc[2 * ks + 1][3]);
            const bf16x8 pf = __builtin_bit_cast(bf16x8, w);
#pragma unroll
            for (int ds = 0; ds < 8; ++ds) { const bf16x8 vf = *(const LAS bf16x8*)(lds + 65536 + (ks >> 1) * 16384 + fbase + ds * 2048 + (ks & 1) * 1024);
                acc_o[ds] = __builtin_amdgcn_mfma_f32_16x16x32_bf16(vf, pf, acc_o[ds], 0, 0, 0); }
        }
        bf16_t* op = YC + (size_t)q * D + C + SBW + h * MEMD + 4 * fq;
#pragma unroll
        for (int ds = 0; ds < 8; ++ds)
            *(v2u*)(op + 16 * ds) = (v2u){pg8::cvt_pk_bf16(acc_o[ds][0] * inv, acc_o[ds][1] * inv), pg8::cvt_pk_bf16(acc_o[ds][2] * inv, acc_o[ds][3] * inv)};
    }
    __syncthreads();
}
__device__ __forceinline__ void sb128_item(Frame& F, const int b, const int h, const int jt) {
    using pg8::bf16x8; using pg8::lds_byte;
    typedef float f4 __attribute__((ext_vector_type(4)));
    const bf16_t* P = (const bf16_t*)(F.ws + WS_PROJ);
    const bf16_t* VT = (const bf16_t*)(F.ws + WS_VTSB) + (size_t)(b * SBH + h) * SBD * SEQ;
    bf16_t* YC = (bf16_t*)(F.ws + WS_YCAT);
    LAS unsigned char* lds = F.lds;
    volatile LAS float* cmax = (volatile LAS float*)(lds + 65536);
    const int tid = F.tid, lane = F.lane, wave = F.wave, fr = lane & 15, fq = lane >> 4;
    const float scale = 0.08838834764831845f * 1.4426950408889634f;
    const bf16_t* kbase = P + (size_t)(b * SEQ) * PLD + COL_SBK + h * SBD;
    int kwoff[2], vwoff[2]; size_t ksrc[2], vsrc[2];
#pragma unroll
    for (int i = 0; i < 2; ++i) { const int pp = tid + 512 * i, r = pp >> 4, c = pp & 15;
        kwoff[i] = (c >> 3) * 8192 + lds_byte(r, (c & 7) * 8); ksrc[i] = (size_t)r * PLD + 8 * c;
        const int d = pp >> 3, c2 = pp & 7;
        vwoff[i] = lds_byte(d, 8 * c2); vsrc[i] = (size_t)d * SEQ + 8 * c2; }
    const int fbase = lds_byte(fr, 8 * fq);
    bf16x8 qf[4];
    { const bf16_t* qp = P + (size_t)(b * SEQ + 128 * jt + 16 * wave + fr) * PLD + COL_SBQ + h * SBD + 8 * fq;
#pragma unroll
      for (int kk = 0; kk < 4; ++kk) qf[kk] = *(const bf16x8*)(qp + 32 * kk); }
    f4 acc_o[8];
#pragma unroll
    for (int i = 0; i < 8; ++i) acc_o[i] = (f4){0.f, 0.f, 0.f, 0.f};
    float carry = 0.f;
    v4u rk[2], rv[2];
    const int ktop = 2 * jt + 1;
#define S8_LOAD(kt_) do { const int _kt = (kt_) > 0 ? (kt_) : 0; _Pragma("unroll") for (int i = 0; i < 2; ++i) { rk[i] = *(const v4u*)(kbase + (size_t)_kt * 64 * PLD + ksrc[i]); rv[i] = *(const v4u*)(VT + (size_t)_kt * 64 + vsrc[i]); } } while (0)
#define S8_WRITE(stg) do { LAS unsigned char* _b = lds + (stg) * 32768; _Pragma("unroll") for (int i = 0; i < 2; ++i) { *(LAS v4u*)(_b + kwoff[i]) = rk[i]; *(LAS v4u*)(_b + 16384 + vwoff[i]) = rv[i]; } } while (0)
    __syncthreads();
    S8_LOAD(ktop); S8_WRITE(0); S8_LOAD(ktop - 1);
    __syncthreads();
    for (int st = 0; st <= ktop; ++st) {
        const int kt = ktop - st;
        const int rel = kt - 2 * jt;
        const bool active = !(rel == 1 && wave < 4);
        if (active) {
            const LAS unsigned char* kb = lds + (st & 1) * 32768;
            const LAS unsigned char* vb = kb + 16384;
            f4 sc[4];
#pragma unroll
            for (int i = 0; i < 4; ++i) { sc[i] = (f4){0.f, 0.f, 0.f, 0.f};
#pragma unroll
                for (int kk = 0; kk < 4; ++kk) { const bf16x8 kf = *(const LAS bf16x8*)(kb + fbase + i * 2048 + (kk & 1) * 1024 + (kk >> 1) * 8192);
                    sc[i] = __builtin_amdgcn_mfma_f32_16x16x32_bf16(kf, qf[kk], sc[i], 0, 0, 0); } }
            const bool diag = rel >= 0;
            float av[4][4], tt[4], xx[4];
#pragma unroll
            for (int i = 0; i < 4; ++i) {
                float lk[4];
#pragma unroll
                for (int r = 0; r < 4; ++r) { float z = sc[i][r] * scale; const float e = __builtin_amdgcn_exp2f(-fabsf(z)); float l = -(fmaxf(z, 0.f) + __builtin_amdgcn_logf(1.f + e));
                    if (diag && !((64 * rel + 16 * i + 4 * fq + r) < (16 * wave + fr))) { l = 0.f; z = -1.0e30f; }
                    lk[r] = l; sc[i][r] = z; }
                av[i][3] = lk[3]; av[i][2] = lk[2] + av[i][3]; av[i][1] = lk[1] + av[i][2]; av[i][0] = lk[0] + av[i][1];
                const float tot = av[i][0], u = __shfl_xor(tot, 16), t1 = tot + u, v = __shfl_xor(t1, 32);
                tt[i] = t1 + v; xx[i] = ((fq & 1) ? 0.f : u) + ((fq & 2) ? 0.f : v);
            }
            const float y2 = tt[3], y1 = y2 + tt[2], y0 = y1 + tt[1], total = y0 + tt[0];
            xx[0] += y0 + carry; xx[1] += y1 + carry; xx[2] += y2 + carry; xx[3] += carry;
            carry += total;
            bf16x8 pf[2];
#pragma unroll
            for (int sg2 = 0; sg2 < 2; ++sg2) {
                float pv[8];
#pragma unroll
                for (int a = 0; a < 2; ++a)
#pragma unroll
                    for (int r = 0; r < 4; ++r) pv[4 * a + r] = __builtin_amdgcn_exp2f(sc[2 * sg2 + a][r] + av[2 * sg2 + a][r] + xx[2 * sg2 + a]);
                v4u w; w.x = pg8::cvt_pk_bf16(pv[0], pv[1]); w.y = pg8::cvt_pk_bf16(pv[2], pv[3]); w.z = pg8::cvt_pk_bf16(pv[4], pv[5]); w.w = pg8::cvt_pk_bf16(pv[6], pv[7]);
                pf[sg2] = __builtin_bit_cast(bf16x8, w);
            }
#pragma unroll
            for (int ds = 0; ds < 8; ++ds)
#pragma unroll
                for (int sg2 = 0; sg2 < 2; ++sg2) { const bf16x8 vf = *(const LAS bf16x8*)(vb + fbase + ds * 2048 + sg2 * 1024);
                    acc_o[ds] = __builtin_amdgcn_mfma_f32_16x16x32_bf16(vf, pf[sg2], acc_o[ds], 0, 0, 0); }
        }
        { float cm = (128 * jt + 16 * wave + fr == 0) ? -1.0e30f : carry;
          cm = wave_max(cm);
          if (lane == 0) cmax[(st & 1) * 8 + wave] = cm; }
        S8_WRITE((st + 1) & 1);
        S8_LOAD(kt - 2);
        __syncthreads();
        float gm = cmax[(st & 1) * 8];
#pragma unroll
        for (int w = 1; w < 8; ++w) gm = fmaxf(gm, cmax[(st & 1) * 8 + w]);
        if (gm <= -140.f) break;
    }
#undef S8_LOAD
#undef S8_WRITE
    bf16_t* op = YC + (size_t)(b * SEQ + 128 * jt + 16 * wave + fr) * D + C + h * SBD + 4 * fq;
#pragma unroll
    for (int ds = 0; ds < 8; ++ds)
        *(v2u*)(op + 16 * ds) = (v2u){pg8::cvt_pk_bf16(acc_o[ds][0], acc_o[ds][1]), pg8::cvt_pk_bf16(acc_o[ds][2], acc_o[ds][3])};
}
__device__ __forceinline__ void ph_mix(Frame& F) {
    for (int bh = F.bid; bh < BATCH * NH; bh += F.G) wkv_carry_bh(F, bh);
    volatile LAS int* qslot = (volatile LAS int*)(F.lds + 139264);
    constexpr int N_SB = BATCH * SBH * 16, N_MEM = BATCH * MEMH * (SEQ / 128);
    int nxt = 0;
    if (F.tid == 0) nxt = (int)atomicAdd(F.ctl + CW_Q, 1u);
    for (;;) {
        __syncthreads();
        if (F.tid == 0) *qslot = nxt;
        __syncthreads();
        const int i = *qslot;
        if (i >= N_SB + N_MEM) break;
        if (F.tid == 0) nxt = (int)atomicAdd(F.ctl + CW_Q, 1u);
        if (i < N_SB) { const int jt = 15 - (i >> 4), bh = i & 15;
            sb128_item(F, bh / SBH, bh % SBH, jt); }
        else mem_item(F, i - N_SB);
    }
    __syncthreads();
}
struct EpiOut {
    static constexpr bool PERM = false, AFTER_DRAIN = false;
    bf16_t* Z; const bf16_t* H;
    __device__ __forceinline__ void operator()(const pg8::f32x4 (&acc)[2][2][4][2], const pg8::Unit& u, int wr, int wc, int fr, int fq) const {
        const int row0 = u.pm * 256 + wr * 64 + fr, col0 = u.pn * 256 + wc * 32 + 4 * fq;
#pragma unroll
        for (int ai = 0; ai < 2; ++ai)
#pragma unroll
            for (int m = 0; m < 4; ++m) { const size_t ro = (size_t)(row0 + ai * 128 + m * 16) * D + col0;
#pragma unroll
                for (int bj = 0; bj < 2; ++bj)
#pragma unroll
                    for (int n = 0; n < 2; ++n) { const v2u hb = *(const v2u*)(H + ro + bj * 128 + n * 16); const f32x4 h = (f32x4){bflo(hb.x), bfhi(hb.x), bflo(hb.y), bfhi(hb.y)}; const f32x4 z = h * ALPHA + acc[ai][bj][m][n]; *(v2u*)(Z + ro + bj * 128 + n * 16) = (v2u){pg8::cvt_pk_bf16(z[0], z[1]), pg8::cvt_pk_bf16(z[2], z[3])}; } }
    }
};
__device__ __forceinline__ void ph_outproj(Frame& F) {
    pg8::Gemm g{(const bf16_t*)(F.ws + WS_YCAT), (const bf16_t*)(F.ws + WS_WOUTT), T, D, D};
    pg8::StaticOrder S; S.init(T, D, F.G, F.bid);
    EpiOut E{(bf16_t*)(F.ws + WS_Z1), (const bf16_t*)(F.ws + WS_HB)};
    pg8::gemm_phase<EpiOut, pg8::StaticOrder, false>(F.lds, g, S, E, nullptr);
    __syncthreads();
}
__device__ __forceinline__ void ph_ln1_router(Frame& F) {
    using pg8::bf16x8;
    typedef float f4 __attribute__((ext_vector_type(4)));
    constexpr int TI = 32, RS2 = 1024 + 8;
    const bf16_t* Z1 = (const bf16_t*)(F.ws + WS_Z1);
    bf16_t* H1B = (bf16_t*)(F.ws + WS_H1B);
    const bf16_t* WR = (const bf16_t*)(F.ws + WS_WRT);
    int* LIST = (int*)(F.ws + WS_LIST);
    float* LISTW = (float*)(F.ws + WS_LISTW);
    LAS bf16_t* Ahi = (LAS bf16_t*)F.lds;
    LAS bf16_t* Alo = Ahi + TI * RS2;
    LAS float* red = (LAS float*)F.lds;
    LAS float* lg = red + 8 * 5 * 2 * 4 * 64;
    const int tid = F.tid, lane = F.lane, wave = F.wave, fr = lane & 15, fq = lane >> 4;
    const float* G1 = F.a->in[I_LN1G]; const float* B1 = F.a->in[I_LN1B];
    for (int item = F.bid; item < T / TI; item += F.G) {
        const int t0 = item * TI;
        __syncthreads();
        bf16x8 wq[2][10];
        const char* wb = (const char*)WR + (size_t)__builtin_amdgcn_readfirstlane(wave) * (4 * 5 * 1024);
        int lz = lane; asm volatile("" : "+v"(lz));
        const unsigned lo16 = (unsigned)lz * 16u;
        const unsigned lo8 = (unsigned)lz * 8u;
        const size_t rowb = (size_t)(t0 + 4 * __builtin_amdgcn_readfirstlane(wave)) * (D * 2);
        const char* zb = (const char*)Z1 + rowb; char* hb = (char*)H1B + rowb;
#define RT_WLOAD(slot, s_) do { _Pragma("unroll") for (int n = 0; n < 5; ++n) { const int co_ = ((32 * ((s_) >> 2) + ((s_) & 3)) * 5 + n) * 1024; \
            wq[slot][2 * n] = *(const bf16x8*)(wb + co_ + lo16); wq[slot][2 * n + 1] = *(const bf16x8*)(wb + 80 * D * 2 + co_ + lo16); } } while (0)
        float mean[4], rstd[4]; v2u zh[4][4];
        {   v2u zc[4][8];
#pragma unroll
            for (int rr = 0; rr < 4; ++rr)
#pragma unroll
                for (int j = 0; j < 8; ++j) zc[rr][j] = *(const v2u*)(zb + rr * (D * 2) + j * 512 + lo8);
#pragma unroll
            for (int rr = 0; rr < 4; ++rr) { float sm = 0.f;
#pragma unroll
                for (int j = 0; j < 8; ++j) sm += (bflo(zc[rr][j].x) + bfhi(zc[rr][j].x)) + (bflo(zc[rr][j].y) + bfhi(zc[rr][j].y));
                mean[rr] = wave_sum(sm) * (1.f / D);
                float s2 = 0.f;
#pragma unroll
                for (int j = 0; j < 8; ++j) { const float a0 = bflo(zc[rr][j].x) - mean[rr], a1 = bfhi(zc[rr][j].x) - mean[rr], a2 = bflo(zc[rr][j].y) - mean[rr], a3 = bfhi(zc[rr][j].y) - mean[rr]; s2 += (a0 * a0 + a1 * a1) + (a2 * a2 + a3 * a3); }
                rstd[rr] = 1.f / sqrtf(wave_sum(s2) * (1.f / D) + LN_EPS);
#pragma unroll
                for (int j = 0; j < 4; ++j) zh[rr][j] = zc[rr][j]; }
        }
        __builtin_amdgcn_sched_barrier(0);
        RT_WLOAD(0, 0); RT_WLOAD(1, 1);
        f4 acc[5][2];
#pragma unroll
        for (int hf = 0; hf < 2; ++hf) {
            if (hf) {
#pragma unroll
                for (int rr = 0; rr < 4; ++rr)
#pragma unroll
                    for (int j = 0; j < 4; ++j) zh[rr][j] = *(const v2u*)(zb + rr * (D * 2) + 2048 + j * 512 + lo8);
                __syncthreads();
            }
#pragma unroll
            for (int j = 0; j < 4; ++j) {
                const f32x4 gg = *(const f32x4*)((const char*)G1 + (4 * hf + j) * 1024 + lo16), bb = *(const f32x4*)((const char*)B1 + (4 * hf + j) * 1024 + lo16);
#pragma unroll
                for (int rr = 0; rr < 4; ++rr) { const int row = 4 * wave + rr; const v2u z = zh[rr][j];
                    const f32x4 v = ((f32x4){bflo(z.x), bfhi(z.x), bflo(z.y), bfhi(z.y)} - mean[rr]) * rstd[rr] * gg + bb;
                    const v2u hi = (v2u){pg8::cvt_pk_bf16(v.x, v.y), pg8::cvt_pk_bf16(v.z, v.w)};
                    const v2u lo = (v2u){pg8::cvt_pk_bf16(v.x - bflo(hi.x), v.y - bfhi(hi.x)), pg8::cvt_pk_bf16(v.z - bflo(hi.y), v.w - bfhi(hi.y))};
                    *(v2u*)(hb + rr * (D * 2) + (4 * hf + j) * 512 + lo8) = hi;
                    *(LAS v2u*)(Ahi + row * RS2 + 4 * (lane + 64 * j)) = hi;
                    *(LAS v2u*)(Alo + row * RS2 + 4 * (lane + 64 * j)) = lo; }
            }
            __syncthreads();
            if (hf == 0) {
#pragma unroll
                for (int n = 0; n < 5; ++n) { acc[n][0] = (f4){0.f, 0.f, 0.f, 0.f}; acc[n][1] = acc[n][0]; } }
#pragma unroll
            for (int ks = 0; ks < 4; ++ks) {
                const int s_ = 4 * hf + ks, k = 128 * wave + 32 * ks + 8 * fq;
                bf16x8 bh[2], bl[2];
#pragma unroll
                for (int tt = 0; tt < 2; ++tt) { bh[tt] = *(const LAS bf16x8*)(Ahi + (16 * tt + fr) * RS2 + k); bl[tt] = *(const LAS bf16x8*)(Alo + (16 * tt + fr) * RS2 + k); }
#pragma unroll
                for (int n = 0; n < 5; ++n) { const bf16x8 wh = wq[s_ & 1][2 * n], wl = wq[s_ & 1][2 * n + 1];
#pragma unroll
                    for (int tt = 0; tt < 2; ++tt) {
                        acc[n][tt] = __builtin_amdgcn_mfma_f32_16x16x32_bf16(wh, bh[tt], acc[n][tt], 0, 0, 0);
                        acc[n][tt] = __builtin_amdgcn_mfma_f32_16x16x32_bf16(wl, bh[tt], acc[n][tt], 0, 0, 0);
                        acc[n][tt] = __builtin_amdgcn_mfma_f32_16x16x32_bf16(wh, bl[tt], acc[n][tt], 0, 0, 0); } }
                __builtin_amdgcn_sched_barrier(0);
                if (s_ + 2 < 8) { if ((s_ & 1) == 0) RT_WLOAD(0, s_ + 2); else RT_WLOAD(1, s_ + 2); }
                __builtin_amdgcn_sched_barrier(0);
            }
        }
#undef RT_WLOAD
        __syncthreads();
#pragma unroll
        for (int n = 0; n < 5; ++n)
#pragma unroll
            for (int tt = 0; tt < 2; ++tt)
#pragma unroll
                for (int r = 0; r < 4; ++r) red[(((wave * 5 + n) * 2 + tt) * 4 + r) * 64 + lane] = acc[n][tt][r];
        __syncthreads();
        for (int idx = tid; idx < 5 * 2 * 4 * 64; idx += NT) {
            const int l = idx & 63, q = idx >> 6, r = q & 3, tt = (q >> 2) & 1, n = q >> 3;
            float sm = 0.f;
#pragma unroll
            for (int w = 0; w < 8; ++w) sm += red[(((w * 5 + n) * 2 + tt) * 4 + r) * 64 + l];
            lg[(16 * tt + (l & 15)) * 80 + 16 * n + 4 * (l >> 4) + r] = sm;
        }
        __syncthreads();
        if (tid < TI) {
            const int t = t0 + tid;
            const LAS float* lp = lg + tid * 80;
            float gl[NG];
            { const f32x4 g0 = *(const f32x4*)(F.a->in[I_RGB]), g1 = *(const f32x4*)(F.a->in[I_RGB] + 4);
              const float gb[NG] = {g0.x, g0.y, g0.z, g0.w, g1.x, g1.y, g1.z, g1.w};
#pragma unroll
              for (int j = 0; j < NG; ++j) gl[j] = lp[j] + gb[j]; }
            int gi = 0; float gm = gl[0];
#pragma unroll
            for (int j = 1; j < NG; ++j) if (gl[j] > gm) { gm = gl[j]; gi = j; }
            float gs = 0.f;
#pragma unroll
            for (int j = 0; j < NG; ++j) gs += expf(gl[j] - gm);
            const float gw_ = 1.f / gs;
            float v0 = -3.0e38f, v1 = -3.0e38f; int i0 = 0, i1 = 0;
            const f32x4 e0 = *(const f32x4*)(F.a->in[I_REB] + gi * EPG), e1v = *(const f32x4*)(F.a->in[I_REB] + gi * EPG + 4);
            const float eb[EPG] = {e0.x, e0.y, e0.z, e0.w, e1v.x, e1v.y, e1v.z, e1v.w};
#pragma unroll
            for (int j = 0; j < EPG; ++j) {
                const float l = lp[NG + gi * EPG + j] + eb[j];
                if (l > v0) { v1 = v0; i1 = i0; v0 = l; i0 = j; } else if (l > v1) { v1 = l; i1 = j; }
            }
            const float e1 = expf(v1 - v0);
            const float w0 = gw_ / (1.f + e1), w1 = gw_ * e1 / (1.f + e1);
            const int ex0 = gi * EPG + i0, ex1 = gi * EPG + i1;
            const unsigned p0 = atomicAdd(F.ctl + CW_CNT + ex0, 1u);
            LIST[ex0 * LISTCAP + p0] = t * 2; LISTW[ex0 * LISTCAP + p0] = w0;
            const unsigned p1 = atomicAdd(F.ctl + CW_CNT + ex1, 1u);
            LIST[ex1 * LISTCAP + p1] = t * 2 + 1; LISTW[ex1 * LISTCAP + p1] = w1;
        }
    }
    __syncthreads();
}
namespace sg {
using pg8::bf16x8; using pg8::lds_byte;
typedef float acc_t __attribute__((ext_vector_type(4)));
constexpr int MT = 5;
constexpr int A_BUF = 4 * MT * 2048, B_BUF = 16384, A_OFF = 0, B_OFF = 2 * A_BUF;

template <class Maker, int LDB>
__device__ __forceinline__ void run_units(LAS unsigned char* lds, const Maker& mk, const int nk, const int nrounds, const int tid) {
    typedef typename Maker::AP AP; typedef typename Maker::BP BP; typedef typename Maker::Epi Epi;
    AP ap; BP bp; Epi ep;
    int r = 0;
    bool has = false;
    while (r < nrounds && !(has = mk(r, ap, bp, ep))) ++r;
    if (!has) return;
    const int wid = __builtin_amdgcn_readfirstlane(tid >> 6), lane = tid & 63, wr = wid >> 1, wc = wid & 1, fr = lane & 15, fq = lane >> 4;
    const int awoff = (tid >> 7) * 2048 + lds_byte((tid >> 3) & 15, 8 * (tid & 7));
    const int kq = tid >> 5, nq = tid & 31;
    const int bwoff0 = lds_byte(bp.rho(4 * nq), 4 * kq);
    const int aoff = wr * 2048 + lds_byte(fr, fq * 8);
    const int boff = lds_byte(wc * 64 + fr, fq * 8);
    unsigned aoffs[MT];
    const bf16_t* abase; const float* bsrc; constexpr size_t ldb = LDB;
#define SG_SETUP(ap_, bp_) do { _Pragma("unroll") for (int i = 0; i < MT; ++i) aoffs[i] = (ap_).row((tid >> 3) + 64 * i) + 8 * (tid & 7); \
        abase = (ap_).base(); bsrc = (bp_).ptr(4 * nq) + (size_t)(4 * kq) * ldb; } while (0)
    SG_SETUP(ap, bp);
    acc_t acc[MT][4];
#pragma unroll
    for (int m = 0; m < MT; ++m)
#pragma unroll
        for (int n = 0; n < 4; ++n) acc[m][n] = (acc_t){0.f, 0.f, 0.f, 0.f};
    v4u ra0[MT]; f32x4 rb0[4], rb1[4];
#define SG_LOADA(ra, kt) do { _Pragma("unroll") for (int i = 0; i < MT; ++i) ra[i] = *(const v4u*)(abase + aoffs[i] + (size_t)(kt) * 64); } while (0)
#define SG_LOADB(rb, kt) do { _Pragma("unroll") for (int j = 0; j < 4; ++j) rb[j] = __builtin_nontemporal_load((const f32x4*)(bsrc + ((size_t)(kt) * 64 + j) * ldb)); } while (0)
#define SG_WRITEA(ra, buf, w5) do { _Pragma("unroll") for (int i = 0; i < MT - 1; ++i) *(LAS v4u*)(lds + A_OFF + (buf) * A_BUF + i * 8192 + awoff) = ra[i]; \
        if (w5) *(LAS v4u*)(lds + A_OFF + (buf) * A_BUF + (MT - 1) * 8192 + awoff) = ra[MT - 1]; } while (0)
#define SG_WRITEB(rb, buf) do { _Pragma("unroll") for (int c = 0; c < 4; ++c) { v2u w; w.x = pg8::cvt_pk_bf16(rb[0][c], rb[1][c]); w.y = pg8::cvt_pk_bf16(rb[2][c], rb[3][c]); \
            *(LAS v2u*)(lds + B_OFF + (buf) * B_BUF + bwoff0 + 64 * c) = w; } } while (0)
#define SG_COMPUTE(buf) do { _Pragma("unroll") for (int k = 0; k < 2; ++k) { bf16x8 bfr[4]; \
        _Pragma("unroll") for (int n = 0; n < 4; ++n) bfr[n] = *(const LAS bf16x8*)(lds + B_OFF + (buf) * B_BUF + boff + n * 2048 + k * 1024); \
        _Pragma("unroll") for (int m = 0; m < MT - 1; ++m) { const bf16x8 af = *(const LAS bf16x8*)(lds + A_OFF + (buf) * A_BUF + aoff + m * 8192 + k * 1024); \
            _Pragma("unroll") for (int n = 0; n < 4; ++n) acc[m][n] = __builtin_amdgcn_mfma_f32_16x16x32_bf16(bfr[n], af, acc[m][n], 0, 0, 0); } \
        if (h5) { const bf16x8 af = *(const LAS bf16x8*)(lds + A_OFF + (buf) * A_BUF + aoff + (MT - 1) * 8192 + k * 1024); \
            _Pragma("unroll") for (int n = 0; n < 4; ++n) acc[MT - 1][n] = __builtin_amdgcn_mfma_f32_16x16x32_bf16(bfr[n], af, acc[MT - 1][n], 0, 0, 0); } \
        __builtin_amdgcn_sched_barrier(0); } } while (0)
#define SG_FLAGS(ap_, w5_, h5_) do { const int nv_ = __builtin_amdgcn_readfirstlane((ap_).nvalid); w5_ = nv_ > 64 * (MT - 1); h5_ = nv_ > 16 * (wr + 4 * (MT - 1)); } while (0)
    bool w5, h5; SG_FLAGS(ap, w5, h5);
    SG_LOADA(ra0, 0); SG_LOADB(rb0, 0); SG_LOADB(rb1, 1);
    SG_WRITEA(ra0, 0, w5); SG_WRITEB(rb0, 0);
    SG_LOADA(ra0, 1);
    __syncthreads();
    for (;;) {
        int kt = 0;
        for (; kt + 4 < nk; kt += 2) {
            SG_LOADB(rb0, kt + 2); SG_COMPUTE(0); SG_WRITEA(ra0, 1, w5); SG_WRITEB(rb1, 1); SG_LOADA(ra0, kt + 2); __syncthreads();
            SG_LOADB(rb1, kt + 3); SG_COMPUTE(1); SG_WRITEA(ra0, 0, w5); SG_WRITEB(rb0, 0); SG_LOADA(ra0, kt + 3); __syncthreads();
        }
        SG_LOADB(rb0, kt + 2); SG_COMPUTE(0); SG_WRITEA(ra0, 1, w5); SG_WRITEB(rb1, 1); SG_LOADA(ra0, kt + 2); __syncthreads();
        SG_LOADB(rb1, kt + 3); SG_COMPUTE(1); SG_WRITEA(ra0, 0, w5); SG_WRITEB(rb0, 0); SG_LOADA(ra0, kt + 3); __syncthreads();
        AP apn; BP bpn; Epi epn; int rn = r + 1; bool hasn = false;
        while (rn < nrounds && !(hasn = mk(rn, apn, bpn, epn))) ++rn;
        if (!hasn) { apn = ap; bpn = bp; }
        bool w5n, h5n; SG_FLAGS(apn, w5n, h5n);
        unsigned nrow[MT];
#pragma unroll
        for (int i = 0; i < MT; ++i) nrow[i] = apn.row((tid >> 3) + 64 * i);
        int pe[MT]; float pw[MT];
        { int tz = tid; asm volatile("" : "+v"(tz)); ep.pre(pe, pw, __builtin_amdgcn_readfirstlane(tz >> 7), tz & 15); }
        __builtin_amdgcn_sched_barrier(0);
        SG_COMPUTE(0); SG_WRITEA(ra0, 1, w5); SG_WRITEB(rb1, 1);
        __builtin_amdgcn_sched_barrier(0);
#pragma unroll
        for (int i = 0; i < MT; ++i) aoffs[i] = nrow[i] + 8 * (tid & 7);
        abase = apn.base(); bsrc = bpn.ptr(4 * nq) + (size_t)(4 * kq) * ldb;
        __builtin_amdgcn_sched_barrier(0);
        SG_LOADA(ra0, 0); SG_LOADB(rb0, 0); __syncthreads();
        SG_LOADB(rb1, 1); SG_COMPUTE(1); SG_WRITEA(ra0, 0, w5n); SG_WRITEB(rb0, 0); SG_LOADA(ra0, 1);
        { int tz = tid; asm volatile("" : "+v"(tz));
          const int wz = __builtin_amdgcn_readfirstlane(tz >> 6), lz = tz & 63;
          ep.fin(acc, pe, pw, wz >> 1, wz & 1, lz & 15, lz >> 4); }
        __syncthreads();
        if (!hasn) break;
#pragma unroll
        for (int m = 0; m < MT; ++m)
#pragma unroll
            for (int n = 0; n < 4; ++n) acc[m][n] = (acc_t){0.f, 0.f, 0.f, 0.f};
        ap = apn; bp = bpn; ep = epn; r = rn; w5 = w5n; h5 = h5n;
    }
#undef SG_FLAGS
#undef SG_SETUP
#undef SG_LOADA
#undef SG_LOADB
#undef SG_WRITEA
#undef SG_WRITEB
#undef SG_COMPUTE
}
}

constexpr int MT_ROWS = 64 * sg::MT;
__device__ __forceinline__ void moe_build_tab(Frame& F, LAS int* tab) {
    __syncthreads();
    if (F.wave == 0) {
        const int e = F.lane, n = (int)F.ctl[CW_CNT + e], ns = (n + MT_ROWS - 1) / MT_ROWS;
        int off = n, so = ns;
#pragma unroll
        for (int d = 1; d < 64; d <<= 1) { const int a = __shfl_up(off, d), b = __shfl_up(so, d); if (e >= d) { off += a; so += b; } }
        tab[e] = n; tab[NE + e] = off - n;
        for (int mt = 0; mt < ns; ++mt) tab[129 + so - ns + mt] = e | (mt << 8);
        if (e == 63) tab[128] = so;
    }
    __syncthreads();
}
__device__ __forceinline__ bool moe_unit(const int G, const int bid, const LAS int* tab, int r, int& e, int& mt, int& nt) {
    int slot;
    if (G == 256) { const int x = bid & 7, j = bid >> 3; slot = r * 16 + (j >> 4) * 8 + x; nt = j & 15; }
    else { const int u = r * G + bid; slot = u >> 4; nt = u & 15; }
    if (slot >= tab[128]) return false;
    const int sv = tab[129 + slot]; e = sv & 255; mt = sv >> 8; return true;
}
struct APGather { const bf16_t* X; const int* list; int nvalid;
    __device__ __forceinline__ const bf16_t* base() const { return X; }
    __device__ __forceinline__ unsigned row(int r) const { const int rr = r < nvalid ? r : nvalid - 1; return (unsigned)(list[rr] >> 1) * (unsigned)D; } };
struct APPlain { const bf16_t* X; int ld; int nvalid;
    __device__ __forceinline__ const bf16_t* base() const { return X; }
    __device__ __forceinline__ unsigned row(int r) const { const int rr = r < nvalid ? r : nvalid - 1; return (unsigned)rr * (unsigned)ld; } };
struct BPUp { const float* Wg; const float* Wu; int ldb;
    __device__ __forceinline__ const float* ptr(int nu4) const { return nu4 < 64 ? Wg + nu4 : Wu + (nu4 - 64); }
    __device__ __forceinline__ int rho(int nu) const { const int j = nu & 63, h = nu >> 6; return 64 * (j >> 5) + 32 * h + (j & 31); } };
struct BPDown { const float* W; int ldb;
    __device__ __forceinline__ const float* ptr(int nu4) const { return W + nu4; }
    __device__ __forceinline__ int rho(int nu) const { return nu; } };
struct EpiUp { bf16_t* H; int nvalid;
    __device__ __forceinline__ void pre(int (&)[sg::MT], float (&)[sg::MT], int, int) const {}
    __device__ __forceinline__ void fin(const sg::acc_t (&acc)[sg::MT][4], const int (&)[sg::MT], const float (&)[sg::MT], int wr, int wc, int fr, int fq) const { (*this)(acc, wr, wc, fr, fq); }
    template <int NM> __device__ __forceinline__ void runi(const sg::acc_t (&acc)[sg::MT][4], int wr, int wc, int fr, int fq) const {
#pragma unroll
        for (int m = 0; m < NM; ++m) { const int row = 16 * (wr + 4 * m) + fr;
            if (row < nvalid) {
#pragma unroll
                for (int n = 0; n < 2; ++n) { const sg::acc_t g = acc[m][n], u = acc[m][n + 2]; float h[4];
#pragma unroll
                    for (int j = 0; j < 4; ++j) h[j] = g[j] * __builtin_amdgcn_rcpf(1.f + __expf(-g[j])) * u[j];
                    *(v2u*)(H + (size_t)row * DE + 32 * wc + 16 * n + 4 * fq) = (v2u){pg8::cvt_pk_bf16(h[0], h[1]), pg8::cvt_pk_bf16(h[2], h[3])}; } } }
    }
    __device__ __forceinline__ void operator()(const sg::acc_t (&acc)[sg::MT][4], int wr, int wc, int fr, int fq) const {
#pragma unroll
        for (int m = 0; m < sg::MT; ++m) { const int row = 16 * (wr + 4 * m) + fr;
            if (row < nvalid) {
#pragma unroll
                for (int n = 0; n < 2; ++n) { const sg::acc_t g = acc[m][n], u = acc[m][n + 2]; float h[4];
#pragma unroll
                    for (int j = 0; j < 4; ++j) h[j] = g[j] * __builtin_amdgcn_rcpf(1.f + __expf(-g[j])) * u[j];
                    *(v2u*)(H + (size_t)row * DE + 32 * wc + 16 * n + 4 * fq) = (v2u){pg8::cvt_pk_bf16(h[0], h[1]), pg8::cvt_pk_bf16(h[2], h[3])}; } } }
    }
};
struct EpiDown { bf16_t* YS; const int* list; const float* lw; int nvalid, n0;
    template <int NM> __device__ __forceinline__ void runi(const sg::acc_t (&acc)[sg::MT][4], int wr, int wc, int fr, int fq) const {
#pragma unroll
        for (int m = 0; m < NM; ++m) { const int row = 16 * (wr + 4 * m) + fr;
            if (row < nvalid) { const int e = list[row]; const float w = lw[row]; bf16_t* dst = YS + (size_t)e * D + n0 + 64 * wc + 4 * fq;
#pragma unroll
                for (int n = 0; n < 4; ++n) *(v2u*)(dst + 16 * n) = (v2u){pg8::cvt_pk_bf16(acc[m][n][0] * w, acc[m][n][1] * w), pg8::cvt_pk_bf16(acc[m][n][2] * w, acc[m][n][3] * w)}; } }
    }
    __device__ __forceinline__ void pre(int (&pe)[sg::MT], float (&pw)[sg::MT], int wr, int fr) const {
#pragma unroll
        for (int m = 0; m < sg::MT; ++m) { const int row = 16 * (wr + 4 * m) + fr, rr = row < nvalid ? row : nvalid - 1; pe[m] = list[rr]; pw[m] = lw[rr]; } }
    __device__ __forceinline__ void fin(const sg::acc_t (&acc)[sg::MT][4], const int (&pe)[sg::MT], const float (&pw)[sg::MT], int wr, int wc, int fr, int fq) const {
#pragma unroll
        for (int m = 0; m < sg::MT; ++m) { const int row = 16 * (wr + 4 * m) + fr;
            if (row < nvalid) { const float w = pw[m]; bf16_t* dst = YS + (size_t)pe[m] * D + n0 + 64 * wc + 4 * fq;
#pragma unroll
                for (int n = 0; n < 4; ++n) *(v2u*)(dst + 16 * n) = (v2u){pg8::cvt_pk_bf16(acc[m][n][0] * w, acc[m][n][1] * w), pg8::cvt_pk_bf16(acc[m][n][2] * w, acc[m][n][3] * w)}; } } }
    __device__ __forceinline__ void operator()(const sg::acc_t (&acc)[sg::MT][4], int wr, int wc, int fr, int fq) const {
#pragma unroll
        for (int m = 0; m < sg::MT; ++m) { const int row = 16 * (wr + 4 * m) + fr;
            if (row < nvalid) { const int e = list[row]; const float w = lw[row]; bf16_t* dst = YS + (size_t)e * D + n0 + 64 * wc + 4 * fq;
#pragma unroll
                for (int n = 0; n < 4; ++n) *(v2u*)(dst + 16 * n) = (v2u){pg8::cvt_pk_bf16(acc[m][n][0] * w, acc[m][n][1] * w), pg8::cvt_pk_bf16(acc[m][n][2] * w, acc[m][n][3] * w)}; } }
    }
};
struct MakerUp { typedef APGather AP; typedef BPUp BP; typedef EpiUp Epi;
    const LAS int* tab; int G, bid; const bf16_t* H1B; const int* LIST; bf16_t* HID; const float* WEG; const float* WEU;
    __device__ __forceinline__ bool operator()(int r, AP& ap, BP& bp, Epi& ep) const {
        int e, mt, nt; if (!moe_unit(G, bid, tab, r, e, mt, nt)) return false;
        const int cnt = tab[e], off = tab[NE + e], nvalid = min(MT_ROWS, cnt - mt * MT_ROWS), n0 = nt * 64;
        ap = AP{H1B, LIST + e * LISTCAP + mt * MT_ROWS, nvalid};
        bp = BP{WEG + (size_t)e * D * DE + n0, WEU + (size_t)e * D * DE + n0, DE};
        ep = Epi{HID + (size_t)(off + mt * MT_ROWS) * DE + n0, nvalid};
        return true; } };
__device__ __forceinline__ void ph_moe_up(Frame& F) {
    LAS int* tab = (LAS int*)(F.lds + 131072);
    moe_build_tab(F, tab);
    const MakerUp mk{tab, F.G, F.bid, (const bf16_t*)(F.ws + WS_H1B), (const int*)(F.ws + WS_LIST), (bf16_t*)(F.ws + WS_HID), F.a->in[I_WEG], F.a->in[I_WEU]};
    sg::run_units<MakerUp, DE>(F.lds, mk, D / 64, (tab[128] * 16 + F.G - 1) / F.G + 1, F.tid);
    __syncthreads();
}
struct MakerDown { typedef APPlain AP; typedef BPDown BP; typedef EpiDown Epi;
    const LAS int* tab; int G, bid; const bf16_t* HID; const int* LIST; const float* LISTW; bf16_t* YS; const float* WED;
    __device__ __forceinline__ bool operator()(int r, AP& ap, BP& bp, Epi& ep) const {
        int e, mt, nt; if (!moe_unit(G, bid, tab, r, e, mt, nt)) return false;
        const int cnt = tab[e], off = tab[NE + e], nvalid = min(MT_ROWS, cnt - mt * MT_ROWS), n0 = nt * 128;
        ap = AP{HID + (size_t)(off + mt * MT_ROWS) * DE, DE, nvalid};
        bp = BP{WED + (size_t)e * DE * D + n0, D};
        ep = Epi{YS, LIST + e * LISTCAP + mt * MT_ROWS, LISTW + e * LISTCAP + mt * MT_ROWS, nvalid, n0};
        return true; } };
__device__ __forceinline__ void ph_moe_down(Frame& F) {
    LAS int* tab = (LAS int*)(F.lds + 131072);
    moe_build_tab(F, tab);
    const MakerDown mk{tab, F.G, F.bid, (const bf16_t*)(F.ws + WS_HID), (const int*)(F.ws + WS_LIST), (const float*)(F.ws + WS_LISTW), (bf16_t*)(F.ws + WS_YS), F.a->in[I_WED]};
    sg::run_units<MakerDown, D>(F.lds, mk, DE / 64, (tab[128] * 16 + F.G - 1) / F.G + 1, F.tid);
    __syncthreads();
}
__device__ __forceinline__ void ph_ln2(Frame& F) {
    const bf16_t* H1B = (const bf16_t*)(F.ws + WS_H1B);
    const bf16_t* YS = (const bf16_t*)(F.ws + WS_YS);
    const int gw = F.bid * NWAVES + F.wave, NGW = F.G * NWAVES;
    v2u hc[8], ac[8], cc[8];
#define LN2_LOAD(row_) do { const v2u* hr_ = (const v2u*)(H1B + (size_t)(row_) * D); const v2u* y0_ = (const v2u*)(YS + (size_t)(row_) * 2 * D); const v2u* y1_ = y0_ + D / 4; \
        _Pragma("unroll") for (int j = 0; j < 8; ++j) { hc[j] = hr_[F.lane + 64 * j]; ac[j] = y0_[F.lane + 64 * j]; cc[j] = y1_[F.lane + 64 * j]; } } while (0)
    { const int r0 = gw < T ? gw : T - 1; LN2_LOAD(r0); }
    for (int row = gw; row < T; row += NGW) {
        f32x4 v[8];
#pragma unroll
        for (int j = 0; j < 8; ++j) { const v2u h = hc[j], a = ac[j], c = cc[j];
            v[j] = (f32x4){bflo(h.x) * ALPHA + (bflo(a.x) + bflo(c.x)), bfhi(h.x) * ALPHA + (bfhi(a.x) + bfhi(c.x)), bflo(h.y) * ALPHA + (bflo(a.y) + bflo(c.y)), bfhi(h.y) * ALPHA + (bfhi(a.y) + bfhi(c.y))}; }
        { const int nr = row + NGW < T ? row + NGW : row; LN2_LOAD(nr); }
        ln_core(v, F.a->in[I_LN2G], F.a->in[I_LN2B], F.out + (size_t)row * D, F.lane);
    }
#undef LN2_LOAD
}

constexpr int N_PHASES = 13;
__global__ void __launch_bounds__(NT, 2) fwd(Args args) {
    extern __shared__ __attribute__((aligned(16))) unsigned char lds[];
    Frame F;
    F.lds = (LAS unsigned char*)lds;
    F.tid = threadIdx.x; F.lane = (int)__builtin_amdgcn_mbcnt_hi(~0u, __builtin_amdgcn_mbcnt_lo(~0u, 0u)); F.wave = __builtin_amdgcn_readfirstlane(F.tid >> 6);
    F.bid = blockIdx.x; F.G = gridDim.x;
    F.ws = args.ws; F.ctl = (unsigned*)(args.ws + WS_CTL); F.out = args.out;
    F.a = &args;
    volatile LAS unsigned* xbw = (volatile LAS unsigned*)(F.lds + LDS_BYTES - 16);
    if (F.tid == 0) { xbw[0] = 0u; xbw[1] = 0u; xbw[2] = 0u; xbw[3] = 0u; }
    __syncthreads();
    const int lo = args.ph_lo, hi = args.ph_hi;
    XcdBarrier bar; bar.bar = F.ctl + CW_BAR; bar.x = 0; bar.st = xbw;
    if (hi - lo > 1) bar = xcd_barrier_post(F.ctl + CW_BAR, xbw);
#define IN(k) (lo <= (k) && (k) < hi)
#define SEAM(k) do { if (IN(k) && IN((k) + 1)) xcd_barrier(bar); } while (0)
    if (IN(0)) { ph_prologue(F); } SEAM(0);
    if (IN(1)) { ph_proj(F); } SEAM(1);
    if (IN(2)) { ph_rwkv_prep(F); ph_vt(F); } SEAM(2);
    if (IN(3)) { ph_wkv_chunk(F); } SEAM(3);
    if (IN(4)) { ph_mix(F); }
    if (IN(5)) { }
    if (IN(6)) { } SEAM(6);
    if (IN(7)) { ph_wkv_post(F); } SEAM(7);
    if (IN(8)) { ph_outproj(F); } SEAM(8);
    if (IN(9)) { ph_ln1_router(F); } SEAM(9);
    if (IN(10)) { ph_moe_up(F); } SEAM(10);
    if (IN(11)) { ph_moe_down(F); } SEAM(11);
    if (IN(12)) { ph_ln2(F); }
#undef IN
#undef SEAM
}

extern "C" void kernel_launch(void* const* d_in, const int* in_sizes, int n_in, void* d_out, int out_size, void* d_ws, size_t ws_size, hipStream_t stream) {
    static int grid = 0;
    if (grid == 0) {
        if (n_in != 29 || out_size != T * D || ws_size < WS_END) { fprintf(stderr, "kernel_launch: unexpected shapes n_in %d out %d ws %zu (need %zu)\n", n_in, out_size, ws_size, (size_t)WS_END); grid = -1; return; }
        int dev = 0, cus = 0;
        if (hipGetDevice(&dev) != hipSuccess || hipDeviceGetAttribute(&cus, hipDeviceAttributeMultiprocessorCount, dev) != hipSuccess) { grid = -1; return; }
        if (hipFuncSetAttribute((const void*)fwd, hipFuncAttributeMaxDynamicSharedMemorySize, LDS_BYTES) != hipSuccess) { fprintf(stderr, "kernel_launch: hipFuncSetAttribute failed\n"); grid = -1; return; }
        int per_cu = 0;
        if (hipOccupancyMaxActiveBlocksPerMultiprocessor(&per_cu, (const void*)fwd, NT, LDS_BYTES) != hipSuccess || per_cu < 1) fprintf(stderr, "kernel_launch: occupancy query says %d\n", per_cu);
        (void)hipGetLastError();
        grid = cus;
    }
    if (grid < 0) return;
    (void)hipMemsetAsync((char*)d_ws + WS_CTL, 0, CTL_ZERO_BYTES, stream);
    Args a{};
    for (int i = 0; i < 29; ++i) a.in[i] = (const float*)d_in[i];
    a.out = (float*)d_out; a.ws = (unsigned char*)d_ws;
#if MK_N_LAUNCHES == 1
    a.ph_lo = 0; a.ph_hi = N_PHASES;
    hipLaunchKernelGGL(fwd, dim3(grid), dim3(NT), LDS_BYTES, stream, a);
#else
    const int cuts[] = {0, 1, 2, 3, 4, 7, 8, 9, 10, 11, 12, 13};
    for (int i = 0; i + 1 < (int)(sizeof(cuts) / sizeof(int)); ++i) {
        a.ph_lo = cuts[i]; a.ph_hi = cuts[i + 1];
        hipLaunchKernelGGL(fwd, dim3(grid), dim3(NT), LDS_BYTES, stream, a);
    }
#endif
    const hipError_t le = hipPeekAtLastError();
    if (le != hipSuccess) fprintf(stderr, "kernel_launch: launch failed: %s\n", hipGetErrorName(le));
}
```
